# Optimizing an MI355X kernel written in HIP

```python
import jax, jax.numpy as jnp
from jax import lax
import numpy as np

D_MODEL = 1024
BATCH = 8
SEQ = 4096
DEPTH = 2

MLA_HEADS = 8
QK_NOPE_DIM = 64
QK_ROPE_DIM = 32
V_HEAD_DIM = 64
QK_HEAD_DIM = QK_NOPE_DIM + QK_ROPE_DIM
Q_LORA_RANK = D_MODEL // 4
KV_LORA_RANK = D_MODEL // 8
ROPE_BASE = 10000.0
Q_BLOCK = 128
LRU_WIDTH = D_MODEL // 2
LRU_HEADS = 8
LRU_HEAD_DIM = LRU_WIDTH // LRU_HEADS
CONV_WIDTH = 4
LRU_C = 8.0
IN_SPLITS = (Q_LORA_RANK, KV_LORA_RANK, QK_ROPE_DIM, LRU_WIDTH, LRU_WIDTH, D_MODEL, D_MODEL)
D_IN = sum(IN_SPLITS)
D_FF = 11 * D_MODEL // 4
N_EXPERTS = 8
TOP_K = 2
D_FF_EXPERT = 7 * D_MODEL // 2
MOE_BLOCK = 256
N_DENSE = (DEPTH + 1) // 2
N_MOE = DEPTH // 2
RMS_EPS = 1e-6

kernel_name = 'hybrid_mla_rglru_moe_block'


def rms_norm(x, g):
    xf = x.astype(jnp.float32)
    y = xf * lax.rsqrt(jnp.mean(xf * xf, axis=-1, keepdims=True) + RMS_EPS)
    return (y * g.astype(jnp.float32)).astype(x.dtype)


def rope_tables(positions):
    inv_freq = ROPE_BASE ** (-jnp.arange(0, QK_ROPE_DIM, 2, dtype=jnp.float32) / QK_ROPE_DIM)
    ang = positions.astype(jnp.float32)[..., None] * inv_freq
    return jnp.cos(ang)[:, :, None, :], jnp.sin(ang)[:, :, None, :]


def apply_rope(x, cos, sin):
    x1, x2 = jnp.split(x.astype(jnp.float32), 2, axis=-1)
    return jnp.concatenate([x1 * cos - x2 * sin, x2 * cos + x1 * sin], axis=-1).astype(x.dtype)


def causal_block_attention(q, k, v):
    b, s, h, dq = q.shape
    n_blk = s // Q_BLOCK
    scale = QK_HEAD_DIM ** -0.5
    q_blocks = q.reshape(b, n_blk, Q_BLOCK, h, dq).transpose(1, 0, 2, 3, 4)
    key_idx = jnp.arange(s)

    def one_block(args):
        q_blk, i = args
        sc = jnp.einsum('bqhd,bkhd->bhqk', q_blk, k, preferred_element_type=jnp.float32) * scale
        q_idx = i * Q_BLOCK + jnp.arange(Q_BLOCK)
        sc = jnp.where(key_idx[None, :] <= q_idx[:, None], sc, -jnp.inf)
        p = jax.nn.softmax(sc, axis=-1).astype(v.dtype)
        return jnp.einsum('bhqk,bkhd->bqhd', p, v)

    o = lax.map(one_block, (q_blocks, jnp.arange(n_blk)))
    return o.transpose(1, 0, 2, 3, 4).reshape(b, s, h, v.shape[-1])


def linear_recurrence(a, b):
    def combine(left, right):
        a_l, b_l = left
        a_r, b_r = right
        return a_l * a_r, a_r * b_l + b_r
    _, h = lax.associative_scan(combine, (a, b), axis=1)
    return h


def hybrid_mixer(h, cos, sin, w_in, q_norm_g, w_uq, kv_norm_g, w_ukv, qk_q_g, qk_k_g, w_up_attn,
                 conv_w, conv_b, w_rg, b_rg, w_ig, b_ig, lru_lambda, w_up_lru, w_o):
    b, s, _ = h.shape
    proj = h @ w_in
    c_q, c_kv, k_r, x_lru, g_lru, gate_a, gate_b = jnp.split(
        proj, list(np.cumsum(IN_SPLITS)[:-1]), axis=-1)

    q = (rms_norm(c_q, q_norm_g) @ w_uq).reshape(b, s, MLA_HEADS, QK_HEAD_DIM)
    kv = (rms_norm(c_kv, kv_norm_g) @ w_ukv).reshape(b, s, MLA_HEADS, QK_NOPE_DIM + V_HEAD_DIM)
    k_nope, v = jnp.split(kv, [QK_NOPE_DIM], axis=-1)
    k_rope = jnp.broadcast_to(k_r[:, :, None, :], (b, s, MLA_HEADS, QK_ROPE_DIM))
    k = jnp.concatenate([k_nope, k_rope], axis=-1)
    q = rms_norm(q, qk_q_g)
    k = rms_norm(k, qk_k_g)
    q = jnp.concatenate([q[..., :QK_NOPE_DIM], apply_rope(q[..., QK_NOPE_DIM:], cos, sin)], axis=-1)
    k = jnp.concatenate([k[..., :QK_NOPE_DIM], apply_rope(k[..., QK_NOPE_DIM:], cos, sin)], axis=-1)
    o_attn = causal_block_attention(q, k, v).reshape(b, s, MLA_HEADS * V_HEAD_DIM)
    u_a = o_attn @ w_up_attn

    xc = lax.conv_general_dilated(
        x_lru, conv_w[:, None, :], window_strides=(1,), padding=[(CONV_WIDTH - 1, 0)],
        dimension_numbers=('NWC', 'WIO', 'NWC'), feature_group_count=LRU_WIDTH) + conv_b
    xh = xc.reshape(b, s, LRU_HEADS, LRU_HEAD_DIM)
    r = jax.nn.sigmoid((jnp.einsum('bshi,hij->bshj', xh, w_rg).reshape(b, s, LRU_WIDTH) + b_rg).astype(jnp.float32))
    i = jax.nn.sigmoid((jnp.einsum('bshi,hij->bshj', xh, w_ig).reshape(b, s, LRU_WIDTH) + b_ig).astype(jnp.float32))
    log_a = -LRU_C * r * jax.nn.softplus(-lru_lambda.astype(jnp.float32))
    a = jnp.exp(log_a)
    mult = jnp.sqrt(-jnp.expm1(2.0 * log_a))
    hs = linear_recurrence(a, mult * i * xc.astype(jnp.float32))
    y_lru = (hs * jax.nn.gelu(g_lru.astype(jnp.float32), approximate=True)).astype(h.dtype)
    u_b = y_lru @ w_up_lru

    merged = jax.nn.sigmoid(gate_a) * u_a + jax.nn.sigmoid(gate_b) * u_b
    return merged @ w_o


def swiglu(h, wg, wu, wd):
    return (jax.nn.silu(h @ wg) * (h @ wu)) @ wd


def moe_swiglu(h2, router, wg, wu, wd):
    n_tok, d = h2.shape
    n_assign = n_tok * TOP_K
    logits = jnp.matmul(h2, router, preferred_element_type=jnp.float32)
    top_logit, top_e = lax.top_k(logits, TOP_K)
    top_w = jax.nn.softmax(top_logit, axis=-1)
    flat_e = top_e.reshape(-1).astype(jnp.int32)
    flat_tok = jnp.repeat(jnp.arange(n_tok, dtype=jnp.int32), TOP_K)
    flat_w = top_w.reshape(-1)
    se, stok, sw = lax.sort((flat_e, flat_tok, flat_w), num_keys=1, is_stable=True)
    counts = jnp.bincount(flat_e, length=N_EXPERTS)
    padded = (counts + MOE_BLOCK - 1) // MOE_BLOCK * MOE_BLOCK
    start = jnp.cumsum(counts) - counts
    pstart = jnp.cumsum(padded) - padded
    pend = pstart + padded
    dest = pstart[se] + jnp.arange(n_assign, dtype=jnp.int32) - start[se]
    n_blocks = -(-(n_assign + N_EXPERTS * (MOE_BLOCK - 1)) // MOE_BLOCK)
    n_rows = n_blocks * MOE_BLOCK
    tok_buf = jnp.full((n_rows,), n_tok, jnp.int32).at[dest].set(stok)
    w_buf = jnp.zeros((n_rows,), jnp.float32).at[dest].set(sw)
    block_rows = jnp.arange(n_blocks, dtype=jnp.int32) * MOE_BLOCK
    block_e = jnp.minimum(jnp.sum(block_rows[:, None] >= pend[None, :], axis=1), N_EXPERTS - 1)
    xg = jnp.take(h2, tok_buf, axis=0, mode='fill', fill_value=0)

    def expert_block(args):
        xb, e = args
        return swiglu(xb, wg[e], wu[e], wd[e])

    yb = lax.map(expert_block, (xg.reshape(n_blocks, MOE_BLOCK, d), block_e)).reshape(n_rows, d)
    return jnp.zeros_like(h2).at[tok_buf].add(yb * w_buf[:, None].astype(h2.dtype), mode='drop')


def setup_inputs(seed: int = 0) -> dict:
    key = jax.random.key(seed)
    ks = jax.random.split(key, 32)
    f32 = jnp.float32
    nrm = lambda k, shape, fan_in: jax.random.normal(k, shape, f32) * (fan_in ** -0.5)
    gain = lambda k, shape: 1.0 + 0.01 * jax.random.normal(k, shape, f32)
    small = lambda k, shape: 0.01 * jax.random.normal(k, shape, f32)
    res_scale = (2 * DEPTH) ** -0.5
    x = jax.random.normal(ks[0], (BATCH, SEQ, D_MODEL), f32)
    offsets = jax.random.randint(ks[1], (BATCH, 1), 0, 1024, dtype=jnp.int32)
    positions = offsets + jnp.arange(SEQ, dtype=jnp.int32)[None, :]
    u = jax.random.uniform(ks[2], (DEPTH, LRU_WIDTH), f32, minval=0.9, maxval=0.999)
    a0 = u ** (1.0 / LRU_C)
    lru_lambda = jnp.log(a0) - jnp.log1p(-a0)
    return {
        'x': x,
        'positions': positions,
        'norm1_g': gain(ks[3], (DEPTH, D_MODEL)),
        'w_in': nrm(ks[4], (DEPTH, D_MODEL, D_IN), D_MODEL),
        'q_norm_g': gain(ks[5], (DEPTH, Q_LORA_RANK)),
        'w_uq': nrm(ks[6], (DEPTH, Q_LORA_RANK, MLA_HEADS * QK_HEAD_DIM), Q_LORA_RANK),
        'kv_norm_g': gain(ks[7], (DEPTH, KV_LORA_RANK)),
        'w_ukv': nrm(ks[8], (DEPTH, KV_LORA_RANK, MLA_HEADS * (QK_NOPE_DIM + V_HEAD_DIM)), KV_LORA_RANK),
        'qk_q_g': gain(ks[9], (DEPTH, QK_HEAD_DIM)),
        'qk_k_g': gain(ks[10], (DEPTH, QK_HEAD_DIM)),
        'w_up_attn': nrm(ks[11], (DEPTH, MLA_HEADS * V_HEAD_DIM, D_MODEL), MLA_HEADS * V_HEAD_DIM),
        'conv_w': nrm(ks[12], (DEPTH, CONV_WIDTH, LRU_WIDTH), CONV_WIDTH),
        'conv_b': small(ks[13], (DEPTH, LRU_WIDTH)),
        'w_rg': nrm(ks[14], (DEPTH, LRU_HEADS, LRU_HEAD_DIM, LRU_HEAD_DIM), LRU_HEAD_DIM),
        'b_rg': small(ks[15], (DEPTH, LRU_WIDTH)),
        'w_ig': nrm(ks[16], (DEPTH, LRU_HEADS, LRU_HEAD_DIM, LRU_HEAD_DIM), LRU_HEAD_DIM),
        'b_ig': small(ks[17], (DEPTH, LRU_WIDTH)),
        'lru_lambda': lru_lambda,
        'w_up_lru': nrm(ks[18], (DEPTH, LRU_WIDTH, D_MODEL), LRU_WIDTH),
        'w_o': nrm(ks[19], (DEPTH, D_MODEL, D_MODEL), D_MODEL) * res_scale,
        'norm2_g': gain(ks[20], (DEPTH, D_MODEL)),
        'ffn_w_gate': nrm(ks[21], (N_DENSE, D_MODEL, D_FF), D_MODEL),
        'ffn_w_up': nrm(ks[22], (N_DENSE, D_MODEL, D_FF), D_MODEL),
        'ffn_w_down': nrm(ks[23], (N_DENSE, D_FF, D_MODEL), D_FF) * res_scale,
        'moe_router': nrm(ks[24], (N_MOE, D_MODEL, N_EXPERTS), D_MODEL),
        'moe_w_gate': nrm(ks[25], (N_MOE, N_EXPERTS, D_MODEL, D_FF_EXPERT), D_MODEL),
        'moe_w_up': nrm(ks[26], (N_MOE, N_EXPERTS, D_MODEL, D_FF_EXPERT), D_MODEL),
        'moe_w_down': nrm(ks[27], (N_MOE, N_EXPERTS, D_FF_EXPERT, D_MODEL), D_FF_EXPERT) * res_scale,
    }


def reference(x, positions, norm1_g, w_in, q_norm_g, w_uq, kv_norm_g, w_ukv, qk_q_g, qk_k_g,
              w_up_attn, conv_w, conv_b, w_rg, b_rg, w_ig, b_ig, lru_lambda, w_up_lru, w_o,
              norm2_g, ffn_w_gate, ffn_w_up, ffn_w_down, moe_router, moe_w_gate, moe_w_up,
              moe_w_down):
    cos, sin = rope_tables(positions)
    for layer in range(DEPTH):
        h = rms_norm(x, norm1_g[layer])
        x = x + hybrid_mixer(
            h, cos, sin, w_in[layer], q_norm_g[layer], w_uq[layer], kv_norm_g[layer], w_ukv[layer],
            qk_q_g[layer], qk_k_g[layer], w_up_attn[layer], conv_w[layer], conv_b[layer],
            w_rg[layer], b_rg[layer], w_ig[layer], b_ig[layer], lru_lambda[layer],
            w_up_lru[layer], w_o[layer])
        h = rms_norm(x, norm2_g[layer])
        j = layer // 2
        if layer % 2 == 0:
            x = x + swiglu(h, ffn_w_gate[j], ffn_w_up[j], ffn_w_down[j])
        else:
            y = moe_swiglu(h.reshape(-1, D_MODEL), moe_router[j], moe_w_gate[j], moe_w_up[j], moe_w_down[j])
            x = x + y.reshape(x.shape)
    return x
```

```cpp
#include <hip/hip_runtime.h>
#include <cstdio>
#include <cstdint>
namespace cfg {
constexpr int BATCH = 8, SEQ = 4096, NTOK = BATCH * SEQ, DM = 1024, DEPTH = 2;
constexpr int NH = 8, DQK = 96, DNOPE = 64, DROPE = 32, DVH = 64, QLR = 256, KVLR = 128;
constexpr int LW = 512, LHD = 64;
constexpr int DIN = 3488, DINP = 3584;
constexpr int DFF = 2816, NEXP = 8, DFE = 3584;
constexpr float EPS = 1e-6f;
constexpr float QSCALE = 0.14724444602590306f;
}
using namespace cfg;
constexpr int NWAVES = 8;
#ifndef MK_PER_PHASE
#define MK_PER_PHASE 1
#endif
constexpr size_t MiB = 1u << 20;
constexpr size_t WS_CTL = 0, CTL_ZERO_BYTES = 64 * 1024;
constexpr size_t WS_ROPE = 2 * MiB;
constexpr size_t WS_WDENSE = 6 * MiB;
constexpr size_t WS_CARRY = 7 * MiB;
constexpr size_t WS_W = 10 * MiB;
constexpr size_t WL_STRIDE = 12 * MiB;
constexpr size_t WL_IN = 0, WL_UQ = 7 * MiB, WL_UK = WL_UQ + 512 * 1024, WL_UV = WL_UK + 128 * 1024, WL_UPA = WL_UV + 128 * 1024, WL_UPL = WL_UPA + MiB, WL_O = WL_UPL + MiB, WL_GT = WL_O + 2 * MiB;
static_assert(WL_GT + 128 * 1024 <= WL_STRIDE, "layer weights");
constexpr size_t WS_FGU = WS_W + 2 * WL_STRIDE, WS_FD = WS_FGU + 11 * MiB;
constexpr size_t WS_R1 = 52 * MiB;
constexpr size_t WS_R2 = 116 * MiB;
constexpr size_t WS_R3 = 340 * MiB;
constexpr size_t WS_R4 = 468 * MiB;
constexpr size_t WS_END = 532 * MiB;
static_assert(WS_FD + (size_t)DM * DFF * 2 <= WS_R1, "weights region");
constexpr size_t R2_CQ = 0, R2_CKV = 16 * MiB, R2_XL = 32 * MiB, R2_GL = 64 * MiB, R2_GA = 96 * MiB, R2_GB = 160 * MiB;
constexpr size_t R3_Q = 0, R3_K = 48 * MiB, R3_VT = 96 * MiB;
constexpr size_t R4_O = 0, R4_Y = 32 * MiB;
constexpr size_t MOE_WGU = WS_R2, MOE_WD = WS_R2 + 112 * MiB, MOE_ACT = WS_R2 + 168 * MiB;
static_assert(MOE_ACT + (size_t)NTOK * DFE * 2 <= WS_END, "moe act");
constexpr int CW_BAR = 4096;
constexpr int RING_BYTES = 131072, MISC_OFF = RING_BYTES + 320, LDS_BYTES = 147456;
namespace pg8 {
#define PG8_LAS __attribute__((address_space(3)))
typedef unsigned short bf16_t;
typedef short bf16x8 __attribute__((ext_vector_type(8)));
typedef float f32x4 __attribute__((ext_vector_type(4)));
typedef unsigned u32x4 __attribute__((ext_vector_type(4)));
constexpr int BM = 256, BK = 64, HALF = 128, HTB = HALF * BK * 2  , STAGE_BYTES = 8 * HTB, NXCD = 8, WGM = 8;

__host__ __device__ __forceinline__ int lds_byte(int r, int c) { const int st = (r >> 4) * 2 + (c >> 5), rr = r & 15, cc = c & 31, ob = rr * 64 + cc * 2; return st * 1024 + (ob ^ (((ob >> 9) & 1) << 5)); }
__host__ __device__ __forceinline__ void stage_rc(int b, int& R, int& C) { const int st = b / 1024, sb = b % 1024, swz = sb ^ (((sb >> 9) & 1) << 5); R = (st >> 1) * 16 + swz / 64; C = (st & 1) * 32 + (swz % 64) / 2; }
__host__ __device__ __forceinline__ int perm32(int rho) { const int n = rho >> 4, i = rho & 15; return 8 * (i >> 2) + 4 * n + (i & 3); }

struct Unit { int pm, pn; };
struct Gemm { const bf16_t* A; const bf16_t* Bt; int M, N, K, lda, ldb; };

struct StaticOrder {
    int nM, nN, nwg, G, c;
    __host__ __device__ void init(int M, int N, int G_, int c_) { nM = M / BM; nN = N / BM; nwg = nM * nN; G = G_; c = c_; }
    __host__ __device__ bool next(int i, Unit& u) const {
        const long L = (long)i * G + c; if (L >= nwg) return false;
        int wgid = (int)L; { const int q = nwg / NXCD, r = nwg % NXCD, xcd = wgid % NXCD, off = wgid / NXCD; wgid = (xcd < r ? xcd * (q + 1) : r * (q + 1) + (xcd - r) * q) + off; }
        const int nig = WGM * nN, gid = wgid / nig, fm = gid * WGM, gsz = (nM - fm) < WGM ? (nM - fm) : WGM;
        u.pm = fm + ((wgid % nig) % gsz); u.pn = (wgid % nig) / gsz; return true;
    }
    __device__ __forceinline__ void a_ready(const Unit&) const {}
    __device__ __forceinline__ void done(const Unit&) const {}
};

__device__ __forceinline__ unsigned cvt_pk_bf16(float lo, float hi) { unsigned r; asm volatile("v_cvt_pk_bf16_f32 %0, %1, %2" : "=v"(r) : "v"(lo), "v"(hi)); return r; }
typedef float f32x2 __attribute__((ext_vector_type(2)));
__device__ __forceinline__ f32x2 gelu_pk(f32x2 v) {
    const f32x2 av = __builtin_elementwise_abs(v), d = av * 0.2316418882f + 1.0f;
    f32x2 t; t.x = __builtin_amdgcn_rcpf(d.x); t.y = __builtin_amdgcn_rcpf(d.y);
    f32x2 q = t * 0.5307027145f + (-0.7265760135f); q = q * t + 0.7107068705f; q = q * t + (-0.142248368f); q = q * t + 0.127414796f; q = q * t;
    const f32x2 s = (v * v) * (-0.72134752044f);
    f32x2 e; e.x = __builtin_amdgcn_exp2f(s.x); e.y = __builtin_amdgcn_exp2f(s.y);
    const f32x2 m = v * (q * e), r = v - m;
    f32x2 o; o.x = v.x < 0.f ? m.x : r.x; o.y = v.y < 0.f ? m.y : r.y; return o;
}

template <int ACT  > struct EpiBf16 {
    static constexpr bool PERM = true, AFTER_DRAIN = false; static_assert(ACT == 0 || ACT == 1, "EpiBf16: ACT is 0 (none) or 1 (gelu_pk)");
    bf16_t* O; int ldc; const float* bias; int split_cols; size_t split_stride; float scale0;
    __device__ __forceinline__ void operator()(const f32x4 (&acc)[2][2][4][2], const Unit& u, int wr, int wc, int fr, int fq) const {
        const int row0 = u.pm * BM + wr * 64 + fr; int colt = u.pn * BM; bf16_t* base = O;
        float sc = 1.f; if (split_cols) { const int t = colt / split_cols; base += (size_t)t * split_stride; colt -= t * split_cols; if (t == 0) sc = scale0; }
        const int col0 = colt + wc * 32 + 8 * fq, bcol0 = u.pn * BM + wc * 32 + 8 * fq;
        f32x4 bv[2][2];
#pragma unroll
        for (int bj = 0; bj < 2; ++bj)
#pragma unroll
            for (int n = 0; n < 2; ++n) bv[bj][n] = bias ? *(const f32x4*)(bias + bcol0 + bj * HALF + 4 * n) : (f32x4){0.f, 0.f, 0.f, 0.f};
#pragma unroll
        for (int ai = 0; ai < 2; ++ai)
#pragma unroll
            for (int m = 0; m < 4; ++m) { bf16_t* rowp = base + (size_t)(row0 + ai * HALF + m * 16) * ldc + col0;
#pragma unroll
                for (int bj = 0; bj < 2; ++bj) { f32x4 v0 = acc[ai][bj][m][0] + bv[bj][0], v1 = acc[ai][bj][m][1] + bv[bj][1];
                    if (ACT == 1) { f32x2 a = gelu_pk((f32x2){v0[0], v0[1]}), b = gelu_pk((f32x2){v0[2], v0[3]}), c = gelu_pk((f32x2){v1[0], v1[1]}), d = gelu_pk((f32x2){v1[2], v1[3]});
                        v0 = (f32x4){a.x, a.y, b.x, b.y}; v1 = (f32x4){c.x, c.y, d.x, d.y}; }
                    v0 = v0 * sc; v1 = v1 * sc; u32x4 w; w.x = cvt_pk_bf16(v0[0], v0[1]); w.y = cvt_pk_bf16(v0[2], v0[3]); w.z = cvt_pk_bf16(v1[0], v1[1]); w.w = cvt_pk_bf16(v1[2], v1[3]);
                    *(u32x4*)(rowp + bj * HALF) = w; } }
    }
};

template <class Epi, class Sched, bool ALIGN_EPI = false, bool SP2 = false>
__device__ __forceinline__ void gemm_phase(PG8_LAS unsigned char* lds, const Gemm g, const Sched& S, const Epi& E) {
    int tid_ = threadIdx.x; asm volatile("" : "+v"(tid_));
    const int tid = tid_, wid = __builtin_amdgcn_readfirstlane(tid >> 6), lane = tid & 63, wr = wid >> 2, wc = wid & 3, fr = lane & 15, fq = lane >> 4;
    const int K = g.K, nt = K / BK;
    unsigned voffA[2], voffB[2];
#pragma unroll
    for (int i = 0; i < 2; ++i) { int R, C; stage_rc(tid * 16 + i * 8192, R, C); const int Rb = Epi::PERM ? ((R & ~31) + perm32(R & 31)) : R;
        voffA[i] = (unsigned)(R * g.lda + C) * 2u; voffB[i] = (unsigned)(Rb * g.ldb + C) * 2u; }
    const size_t kstep = (size_t)(BK * 2);
    const size_t hstepA = (size_t)HALF * g.lda * 2, hstepB = (size_t)HALF * g.ldb * 2;
    const size_t tstepA = 2 * hstepA, tstepB = 2 * hstepB;
    const unsigned ldsw = (unsigned)wid * 1024u;
    const int aoff = lds_byte(wr * 64 + fr, fq * 8), boff = lds_byte(wc * 32 + fr, fq * 8);
#define PG8_SA(b, h) (((b) * 2 + (h)) * HTB)
#define PG8_SB(b, h) ((4 + (b) * 2 + (h)) * HTB)
#define PG8_STAGE(bufoff, gbase, voff) do { _Pragma("unroll") for (int _i = 0; _i < 2; ++_i) \
        __builtin_amdgcn_global_load_lds((const unsigned*)((const char*)(gbase) + (voff)[_i]), (PG8_LAS unsigned*)(lds + (bufoff) + ldsw + _i * 8192), 16, 0, 0); } while (0)
#define PG8_LDA(dst, b, h) do { _Pragma("unroll") for (int m = 0; m < 4; ++m) _Pragma("unroll") for (int k = 0; k < 2; ++k) dst[m][k] = *(const PG8_LAS bf16x8*)(lds + PG8_SA(b, h) + aoff + m * 2048 + k * 1024); } while (0)
#define PG8_LDB(dst, b, h) do { _Pragma("unroll") for (int n = 0; n < 2; ++n) _Pragma("unroll") for (int k = 0; k < 2; ++k) dst[n][k] = *(const PG8_LAS bf16x8*)(lds + PG8_SB(b, h) + boff + n * 2048 + k * 1024); } while (0)
#define PG8_MMA(ai, bj, At, Bt) do { __builtin_amdgcn_s_setprio(1); _Pragma("unroll") for (int m = 0; m < 4; ++m) _Pragma("unroll") for (int n = 0; n < 2; ++n) _Pragma("unroll") for (int k = 0; k < 2; ++k) \
        acc[ai][bj][m][n] = __builtin_amdgcn_mfma_f32_16x16x32_bf16(Bt[n][k], At[m][k], acc[ai][bj][m][n], 0, 0, 0); __builtin_amdgcn_s_setprio(0); } while (0)
#define PG8_WAIT_V(n) asm volatile("s_waitcnt vmcnt(" #n ")" ::: "memory")
#define PG8_WAIT_L(n) asm volatile("s_waitcnt lgkmcnt(" #n ")" ::: "memory")
#define PG8_BAR __builtin_amdgcn_s_barrier()
#define PG8_SCHED __builtin_amdgcn_sched_barrier(0)
    Unit cur, nxt; int ui = 0;
    if (!S.next(0, cur)) return;
    f32x4 acc[2][2][4][2];
#pragma unroll
    for (int a = 0; a < 2; ++a)
#pragma unroll
        for (int b = 0; b < 2; ++b)
#pragma unroll
            for (int m = 0; m < 4; ++m)
#pragma unroll
                for (int n = 0; n < 2; ++n) acc[a][b][m][n] = (f32x4){0.f, 0.f, 0.f, 0.f};
    bf16x8 At[4][2], B0[2][2], B1[2][2];
    const char* cA = (const char*)g.A + (size_t)cur.pm * tstepA; const char* cB = (const char*)g.Bt + (size_t)cur.pn * tstepB;
    S.a_ready(cur);
    if constexpr (SP2) {
        PG8_STAGE(PG8_SB(0, 0), cB, voffB); PG8_STAGE(PG8_SB(0, 1), cB + hstepB, voffB); PG8_STAGE(PG8_SA(0, 0), cA, voffA); PG8_STAGE(PG8_SA(0, 1), cA + hstepA, voffA);
        if (wr == 1) PG8_BAR;
        PG8_WAIT_V(2); PG8_BAR;
        PG8_STAGE(PG8_SB(1, 0), cB + kstep, voffB); PG8_STAGE(PG8_SA(1, 0), cA + kstep, voffA); PG8_STAGE(PG8_SB(1, 1), cB + hstepB + kstep, voffB);
        PG8_WAIT_V(6); PG8_BAR;
    } else {
        PG8_STAGE(PG8_SB(0, 0), cB, voffB); PG8_STAGE(PG8_SA(0, 0), cA, voffA); PG8_STAGE(PG8_SB(0, 1), cB + hstepB, voffB); PG8_STAGE(PG8_SA(0, 1), cA + hstepA, voffA);
        if (wr == 1) PG8_BAR;
        PG8_WAIT_V(4); PG8_BAR;
        PG8_STAGE(PG8_SB(1, 0), cB + kstep, voffB); PG8_STAGE(PG8_SA(1, 0), cA + kstep, voffA); PG8_STAGE(PG8_SB(1, 1), cB + hstepB + kstep, voffB);
        PG8_WAIT_V(6); PG8_BAR;
    }
    for (;;) {
        const bool has_next = S.next(ui + 1, nxt);
        const char* nA = has_next ? (const char*)g.A + (size_t)nxt.pm * tstepA : cA; const char* nB = has_next ? (const char*)g.Bt + (size_t)nxt.pn * tstepB : cB;
        for (int t = 0; t < nt; t += 2) {
            const bool last = (t == nt - 2);
            const char* a1 = cA + (size_t)(t + 1) * kstep;
            const char* a2 = last ? nA : cA + (size_t)(t + 2) * kstep; const char* b2 = last ? nB : cB + (size_t)(t + 2) * kstep;
            const char* a3 = a2 + kstep; const char* b3 = b2 + kstep;
            if (last && has_next) S.a_ready(nxt);
            if constexpr (SP2) {
            PG8_LDB(B0, 0, 0); PG8_LDB(B1, 0, 1); PG8_SCHED; PG8_LDA(At, 0, 0); PG8_STAGE(PG8_SA(1, 1), a1 + hstepA, voffA);
            PG8_WAIT_V(8); PG8_WAIT_L(0); PG8_BAR; PG8_MMA(0, 0, At, B0); PG8_MMA(0, 1, At, B1); PG8_BAR; PG8_SCHED;
            PG8_LDA(At, 0, 1); PG8_STAGE(PG8_SB(0, 0), b2, voffB); PG8_STAGE(PG8_SB(0, 1), b2 + hstepB, voffB); PG8_STAGE(PG8_SA(0, 0), a2, voffA);
            PG8_WAIT_V(8); PG8_WAIT_L(0); PG8_BAR; PG8_MMA(1, 0, At, B0); PG8_MMA(1, 1, At, B1); PG8_BAR; PG8_SCHED;
            PG8_LDB(B0, 1, 0); PG8_LDB(B1, 1, 1); PG8_SCHED; PG8_LDA(At, 1, 0); PG8_STAGE(PG8_SA(0, 1), a2 + hstepA, voffA);
            PG8_WAIT_V(8); PG8_WAIT_L(0); PG8_BAR; PG8_MMA(0, 0, At, B0); PG8_MMA(0, 1, At, B1); PG8_BAR; PG8_SCHED;
            PG8_LDA(At, 1, 1); PG8_STAGE(PG8_SB(1, 0), b3, voffB); PG8_STAGE(PG8_SB(1, 1), b3 + hstepB, voffB); PG8_STAGE(PG8_SA(1, 0), a3, voffA);
            PG8_WAIT_V(8); PG8_WAIT_L(0); PG8_BAR; PG8_MMA(1, 0, At, B0); PG8_MMA(1, 1, At, B1); PG8_BAR; PG8_SCHED;
            } else {
            PG8_LDB(B0, 0, 0); PG8_SCHED; PG8_LDA(At, 0, 0); PG8_STAGE(PG8_SA(1, 1), a1 + hstepA, voffA);
            PG8_WAIT_L(8); PG8_BAR; PG8_WAIT_L(0); PG8_MMA(0, 0, At, B0); PG8_BAR; PG8_SCHED;
            PG8_LDB(B1, 0, 1); PG8_STAGE(PG8_SB(0, 0), b2, voffB);
            PG8_BAR; PG8_WAIT_L(0); PG8_MMA(0, 1, At, B1); PG8_BAR;
            PG8_LDA(At, 0, 1); PG8_STAGE(PG8_SA(0, 0), a2, voffA);
            PG8_BAR; PG8_WAIT_L(0); PG8_MMA(1, 0, At, B0); PG8_BAR; PG8_SCHED;
            PG8_STAGE(PG8_SB(0, 1), b2 + hstepB, voffB);
            PG8_WAIT_V(6); PG8_BAR; PG8_MMA(1, 1, At, B1); PG8_BAR;
            PG8_LDB(B0, 1, 0); PG8_SCHED; PG8_LDA(At, 1, 0); PG8_STAGE(PG8_SA(0, 1), a2 + hstepA, voffA);
            PG8_WAIT_L(8); PG8_BAR; PG8_WAIT_L(0); PG8_MMA(0, 0, At, B0); PG8_BAR; PG8_SCHED;
            PG8_LDB(B1, 1, 1); PG8_STAGE(PG8_SB(1, 0), b3, voffB);
            PG8_BAR; PG8_WAIT_L(0); PG8_MMA(0, 1, At, B1); PG8_BAR;
            PG8_LDA(At, 1, 1); PG8_STAGE(PG8_SA(1, 0), a3, voffA);
            PG8_BAR; PG8_WAIT_L(0); PG8_MMA(1, 0, At, B0); PG8_BAR; PG8_SCHED;
            PG8_STAGE(PG8_SB(1, 1), b3 + hstepB, voffB);
            PG8_WAIT_V(6); PG8_BAR; PG8_MMA(1, 1, At, B1); PG8_BAR;
            }
        }
        if constexpr (ALIGN_EPI) { if (wr == 0) PG8_BAR; }
        if constexpr (!Epi::AFTER_DRAIN) { E(acc, cur, wr, wc, fr, fq); S.done(cur); }
        if (!has_next) break;
#pragma unroll
        for (int a = 0; a < 2; ++a)
#pragma unroll
            for (int b = 0; b < 2; ++b)
#pragma unroll
                for (int m = 0; m < 4; ++m)
#pragma unroll
                    for (int n = 0; n < 2; ++n) acc[a][b][m][n] = (f32x4){0.f, 0.f, 0.f, 0.f};
        cur = nxt; cA = nA; cB = nB; ++ui;
        if constexpr (ALIGN_EPI) { if (wr == 1) PG8_BAR; }
    }
    PG8_WAIT_V(0);
    if constexpr (!ALIGN_EPI) { if (wr == 0) PG8_BAR; }
    PG8_BAR;
    if constexpr (Epi::AFTER_DRAIN) { E.fused(acc, cur, wr, wc, fr, fq, lds, wid, lane); S.done(cur); }
#undef PG8_SA
#undef PG8_SB
#undef PG8_STAGE
#undef PG8_LDA
#undef PG8_LDB
#undef PG8_MMA
#undef PG8_WAIT_V
#undef PG8_WAIT_L
#undef PG8_BAR
#undef PG8_SCHED
}
}

namespace pg8 {
__device__ __forceinline__ float fsigmoid(float x) { return __builtin_amdgcn_rcpf(1.0f + __builtin_amdgcn_exp2f(-1.4426950408889634f * x)); }
__device__ __forceinline__ float bflo(unsigned w) { return __uint_as_float(w << 16); }
__device__ __forceinline__ float bfhi(unsigned w) { return __uint_as_float(w & 0xffff0000u); }
__device__ __forceinline__ u32x4 pack8(const f32x4 a, const f32x4 b) { u32x4 w; w.x = cvt_pk_bf16(a[0], a[1]); w.y = cvt_pk_bf16(a[2], a[3]); w.z = cvt_pk_bf16(b[0], b[1]); w.w = cvt_pk_bf16(b[2], b[3]); return w; }

struct EpiStore {
    static constexpr bool PERM = true, AFTER_DRAIN = false;
    bf16_t* O; int ldc;
    __device__ __forceinline__ void operator()(const f32x4 (&acc)[2][2][4][2], const Unit& u, int wr, int wc, int fr, int fq) const {
        const int row0 = u.pm * BM + wr * 64 + fr, col0 = u.pn * BM + wc * 32 + 8 * fq;
#pragma unroll
        for (int ai = 0; ai < 2; ++ai)
#pragma unroll
            for (int m = 0; m < 4; ++m) { bf16_t* rowp = O + (size_t)(row0 + ai * HALF + m * 16) * ldc + col0;
#pragma unroll
                for (int bj = 0; bj < 2; ++bj) *(u32x4*)(rowp + bj * HALF) = pack8(acc[ai][bj][m][0], acc[ai][bj][m][1]); }
    }
};
struct EpiProj {
    static constexpr bool PERM = true, AFTER_DRAIN = false;
    bf16_t* R2;
    __device__ __forceinline__ void operator()(const f32x4 (&acc)[2][2][4][2], const Unit& u, int wr, int wc, int fr, int fq) const {
        const int pn = u.pn; size_t off; int ldc, ct; bool sg = false;
        if (pn == 0)      { off = 0;               ldc = 256;  ct = 0; }
        else if (pn == 1) { off = (size_t)8 << 20;  ldc = 256;  ct = 0; }
        else if (pn < 4)  { off = (size_t)16 << 20; ldc = 512;  ct = pn - 2; }
        else if (pn < 6)  { off = (size_t)32 << 20; ldc = 512;  ct = pn - 4; }
        else if (pn < 10) { off = (size_t)48 << 20; ldc = 1024; ct = pn - 6; sg = true; }
        else              { off = (size_t)80 << 20; ldc = 1024; ct = pn - 10; sg = true; }
        const int row0 = u.pm * BM + wr * 64 + fr, col0 = ct * BM + wc * 32 + 8 * fq;
        bf16_t* O = R2 + off;
#pragma unroll
        for (int ai = 0; ai < 2; ++ai)
#pragma unroll
            for (int m = 0; m < 4; ++m) { bf16_t* rowp = O + (size_t)(row0 + ai * HALF + m * 16) * ldc + col0;
#pragma unroll
                for (int bj = 0; bj < 2; ++bj) { f32x4 v0 = acc[ai][bj][m][0], v1 = acc[ai][bj][m][1];
                    if (sg) {
#pragma unroll
                        for (int k = 0; k < 4; ++k) { v0[k] = fsigmoid(v0[k]); v1[k] = fsigmoid(v1[k]); } }
                    *(u32x4*)(rowp + bj * HALF) = pack8(v0, v1); } }
    }
};
struct EpiMerge {
    static constexpr bool PERM = true, AFTER_DRAIN = false;
    const bf16_t* G; bf16_t* O; int accum;
    __device__ __forceinline__ void operator()(const f32x4 (&acc)[2][2][4][2], const Unit& u, int wr, int wc, int fr, int fq) const {
        const int row0 = u.pm * BM + wr * 64 + fr, col0 = u.pn * BM + wc * 32 + 8 * fq;
#pragma unroll
        for (int ai = 0; ai < 2; ++ai)
#pragma unroll
            for (int m = 0; m < 4; ++m) { const size_t ro = (size_t)(row0 + ai * HALF + m * 16) * 1024 + col0;
#pragma unroll
                for (int bj = 0; bj < 2; ++bj) { const u32x4 g = *(const u32x4*)(G + ro + bj * HALF); f32x4 v0 = acc[ai][bj][m][0], v1 = acc[ai][bj][m][1];
                    v0[0] *= bflo(g.x); v0[1] *= bfhi(g.x); v0[2] *= bflo(g.y); v0[3] *= bfhi(g.y); v1[0] *= bflo(g.z); v1[1] *= bfhi(g.z); v1[2] *= bflo(g.w); v1[3] *= bfhi(g.w);
                    if (accum) { const u32x4 p = *(const u32x4*)(O + ro + bj * HALF);
                        v0[0] += bflo(p.x); v0[1] += bfhi(p.x); v0[2] += bflo(p.y); v0[3] += bfhi(p.y); v1[0] += bflo(p.z); v1[1] += bfhi(p.z); v1[2] += bflo(p.w); v1[3] += bfhi(p.w); }
                    *(u32x4*)(O + ro + bj * HALF) = pack8(v0, v1); } }
    }
};
struct EpiResid {
    static constexpr bool PERM = true, AFTER_DRAIN = false;
    const float* base; float* out; const float* rowscale; int rs_ld;
    __device__ __forceinline__ void operator()(const f32x4 (&acc)[2][2][4][2], const Unit& u, int wr, int wc, int fr, int fq) const {
        const int row0 = u.pm * BM + wr * 64 + fr, col0 = u.pn * BM + wc * 32 + 8 * fq;
#pragma unroll
        for (int ai = 0; ai < 2; ++ai)
#pragma unroll
            for (int m = 0; m < 4; ++m) { const int row = row0 + ai * HALF + m * 16; const size_t ro = (size_t)row * 1024 + col0;
                const float rs = rowscale ? rowscale[(size_t)row * rs_ld] : 1.0f;
#pragma unroll
                for (int bj = 0; bj < 2; ++bj) { const f32x4 b0 = *(const f32x4*)(base + ro + bj * HALF), b1 = *(const f32x4*)(base + ro + bj * HALF + 4);
                    *(f32x4*)(out + ro + bj * HALF) = b0 + acc[ai][bj][m][0] * rs; *(f32x4*)(out + ro + bj * HALF + 4) = b1 + acc[ai][bj][m][1] * rs; } }
    }
};
struct EpiSwiglu {
    static constexpr bool PERM = true, AFTER_DRAIN = false;
    bf16_t* O; int ldc;
    __device__ __forceinline__ void operator()(const f32x4 (&acc)[2][2][4][2], const Unit& u, int wr, int wc, int fr, int fq) const {
        const int row0 = u.pm * BM + wr * 64 + fr, col0 = u.pn * HALF + wc * 32 + 8 * fq;
#pragma unroll
        for (int ai = 0; ai < 2; ++ai)
#pragma unroll
            for (int m = 0; m < 4; ++m) { bf16_t* rowp = O + (size_t)(row0 + ai * HALF + m * 16) * ldc + col0;
                f32x4 v0, v1;
#pragma unroll
                for (int k = 0; k < 4; ++k) { const float g0 = acc[ai][0][m][0][k], g1 = acc[ai][0][m][1][k];
                    v0[k] = g0 * fsigmoid(g0) * acc[ai][1][m][0][k]; v1[k] = g1 * fsigmoid(g1) * acc[ai][1][m][1][k]; }
                *(u32x4*)rowp = pack8(v0, v1); }
    }
};
}
#define GAS __attribute__((address_space(1)))
#define LAS __attribute__((address_space(3)))
typedef unsigned short bf16;
typedef unsigned v4u __attribute__((ext_vector_type(4)));
typedef float f32x4 __attribute__((ext_vector_type(4)));
typedef short bf16x8 __attribute__((ext_vector_type(8)));
typedef GAS unsigned gu32;
typedef GAS unsigned long long gu64;
#define RLX_AGENT __ATOMIC_RELAXED, __HIP_MEMORY_SCOPE_AGENT
#define LDS_WAIT() asm volatile("s_waitcnt lgkmcnt(0)" ::: "memory")
#define VM_WAIT() asm volatile("s_waitcnt vmcnt(0)" ::: "memory")
__device__ __forceinline__ unsigned long long rt() { return __builtin_amdgcn_s_memrealtime(); }
__device__ __forceinline__ unsigned f2bf(float f) { unsigned u = __builtin_bit_cast(unsigned, f); return (u + 0x7fffu + ((u >> 16) & 1u)) >> 16; }
__device__ __forceinline__ unsigned pk2(float lo, float hi) { return f2bf(lo) | (f2bf(hi) << 16); }

#define XB_TMO      128
#define XB_XCNT(j)  (256  + 64 * (j))
#define XB_XSUB(j)  (1280 + 64 * (j))
#define XB_XGEN(j)  (2304 + 64 * (j))
#define XB_TOP      3328
#define XB_TOPGEN   3392
#define XCD_BAR_WORDS 3456
#define XB_SPIN_CAP (1u << 18)

__device__ __forceinline__ unsigned xb_ld(unsigned* p)              { return __hip_atomic_load(p, __ATOMIC_RELAXED, __HIP_MEMORY_SCOPE_AGENT); }
__device__ __forceinline__ unsigned xb_add(unsigned* p, unsigned v) { return __hip_atomic_fetch_add(p, v, __ATOMIC_RELAXED, __HIP_MEMORY_SCOPE_AGENT); }
__device__ __forceinline__ unsigned xb_xcc_id() { return (unsigned)__builtin_amdgcn_s_getreg((3 << 11) | 20) & 0xFu; }
#define XB_SPIN(cond, bar) do { unsigned _sp = 0; while (cond) { __builtin_amdgcn_s_sleep(1); \
    if ((++_sp & 255u) == 0u) { if (xb_ld(&(bar)[XB_TMO])) break; if (_sp > XB_SPIN_CAP) { atomicAdd(&(bar)[XB_TMO], 1u); break; } } } } while (0)

struct XcdBarrier {
    unsigned* bar; unsigned x;
    volatile LAS unsigned* st;
};

__device__ __forceinline__ XcdBarrier xcd_barrier_post(unsigned* bar, volatile LAS unsigned* st) {
    XcdBarrier b; b.bar = bar; b.x = xb_xcc_id(); b.st = st;
    if (threadIdx.x == 0) (void)xb_add(&bar[XB_XCNT(b.x)], 1u);
    return b;
}
__device__ __forceinline__ void xcd_barrier_complete(unsigned* bar, unsigned x, unsigned& nloc, unsigned& nx) {
    const unsigned G = gridDim.x * gridDim.y * gridDim.z;
    unsigned sum, cnt, mine, sp = 0u;
    for (;;) {
        sum = 0u; cnt = 0u; mine = 0u;
#pragma unroll
        for (unsigned j = 0; j < 16; ++j) { const unsigned c = xb_ld(&bar[XB_XCNT(j)]); sum += c; cnt += (c > 0u) ? 1u : 0u; mine = (j == x) ? c : mine; }
        if (sum == G) break;
        __builtin_amdgcn_s_sleep(1);
        if ((++sp & 255u) == 0u) { if (xb_ld(&bar[XB_TMO])) break; if (sp > XB_SPIN_CAP) { atomicAdd(&bar[XB_TMO], 1u); break; } }
    }
    nloc = mine > 0u ? mine : 1u; nx = cnt > 0u ? cnt : 1u;
}

__device__ __forceinline__ void xcd_barrier(const XcdBarrier& b) {
    asm volatile("s_waitcnt vmcnt(0)" ::: "memory");
    __syncthreads();
    if (threadIdx.x == 0) {
        unsigned* bar = b.bar;
        __builtin_amdgcn_s_waitcnt(0);
        unsigned nloc = b.st[0], nx = b.st[1];
        if (nloc == 0u) { xcd_barrier_complete(bar, b.x, nloc, nx); b.st[0] = nloc; b.st[1] = nx; }
        const unsigned old = xb_add(&bar[XB_XSUB(b.x)], 1u);
        const unsigned gen = old / nloc;
        if (old + 1u == (gen + 1u) * nloc) {
            __builtin_amdgcn_fence(__ATOMIC_RELEASE, "agent");
            asm volatile("s_waitcnt vmcnt(0)" ::: "memory");
            const unsigned og = xb_add(&bar[XB_TOP], 1u);
            const unsigned tg = og / nx;
            if (og + 1u == (tg + 1u) * nx) xb_add(&bar[XB_TOPGEN], 1u);
            else XB_SPIN(xb_ld(&bar[XB_TOPGEN]) == tg, bar);
            __builtin_amdgcn_fence(__ATOMIC_ACQUIRE, "agent");
            xb_add(&bar[XB_XGEN(b.x)], 1u);
            asm volatile("s_waitcnt vmcnt(0)" ::: "memory");
        } else {
            XB_SPIN(xb_ld(&bar[XB_XGEN(b.x)]) == gen, bar);
            __builtin_amdgcn_fence(__ATOMIC_ACQUIRE, "agent");
            asm volatile("s_waitcnt vmcnt(0)" ::: "memory");
        }
    }
    __syncthreads();
}

typedef unsigned v2u __attribute__((ext_vector_type(2)));
typedef float f32x2v __attribute__((ext_vector_type(2)));
struct Frame {
    LAS unsigned char* lds;
    int tid, lane, wave;
    int vcu, G;
    int gw, ngw;
};
__device__ __forceinline__ float wave_sum(float v) {
#pragma unroll
    for (int o = 1; o < 64; o <<= 1) v += __shfl_xor(v, o);
    return v;
}
__device__ __forceinline__ float bf2f(unsigned short b) { return __uint_as_float((unsigned)b << 16); }
__device__ __forceinline__ float bflo(unsigned w) { return __uint_as_float(w << 16); }
__device__ __forceinline__ float bfhi(unsigned w) { return __uint_as_float(w & 0xffff0000u); }
__device__ __forceinline__ float fsigmoid(float x) { return __builtin_amdgcn_rcpf(1.0f + __builtin_amdgcn_exp2f(-1.4426950408889634f * x)); }

__device__ __forceinline__ void tr_item(const float* W, int ldw, int k0, int c0, bf16* WTrow0, int ldt, LAS float* scr, int lane) {
#pragma unroll 8
    for (int i = 0; i < 32; ++i) { const int kk = 2 * i + (lane >> 5); scr[kk * 33 + (lane & 31)] = W[(size_t)(k0 + kk) * ldw + c0 + (lane & 31)]; }
    LDS_WAIT(); asm volatile("" ::: "memory");
    const int c = lane & 7;
#pragma unroll
    for (int j = 0; j < 4; ++j) { const int n = (lane >> 3) + 8 * j; const LAS float* s = scr + (8 * c) * 33 + n;
        v4u o; o.x = pk2(s[0 * 33], s[1 * 33]); o.y = pk2(s[2 * 33], s[3 * 33]); o.z = pk2(s[4 * 33], s[5 * 33]); o.w = pk2(s[6 * 33], s[7 * 33]);
        *(GAS v4u*)(WTrow0 + (size_t)n * ldt + k0 + 8 * c) = o; }
    LDS_WAIT(); asm volatile("" ::: "memory");
}
template <class Map> __device__ __forceinline__ void convert_matrix(const Frame& F, const float* W, int ldw, int K, int ncb, bf16* WT, int ldt, Map map) {
    LAS float* scr = (LAS float*)(F.lds + F.wave * 16384);
    const int nkb = K / 64, nitems = nkb * ncb;
    for (int it = F.gw; it < nitems; it += F.ngw) { const int kb = it / ncb, cb = it % ncb; const int r0 = map(cb); if (r0 < 0) continue;
        tr_item(W, ldw, 64 * kb, 32 * cb, WT + (size_t)r0 * ldt, ldt, scr, F.lane); }
}
__device__ __forceinline__ void zero_rows(const Frame& F, bf16* WT, int ldt, int r0, int nrows) {
    const int per_row = ldt / 8; const int n = nrows * per_row;
    for (int i = F.gw * 64 + F.lane; i < n; i += F.ngw * 64) { const int r = i / per_row, c = i % per_row; *(GAS v4u*)(WT + (size_t)(r0 + r) * ldt + c * 8) = (v4u){0u, 0u, 0u, 0u}; }
}
__constant__ double ROPE_INVF[16] = {1.0, 0.5623413251903491, 0.31622776601683794, 0.1778279410038923, 0.1, 0.05623413251903491, 0.03162277660168379, 0.01778279410038923,
    0.01, 0.005623413251903491, 0.0031622776601683794, 0.0017782794100389228, 0.001, 0.0005623413251903491, 0.00031622776601683794, 0.00017782794100389227};

template <bool ROUTER> __device__ __forceinline__ void norm_rows(const Frame& F, const float* x, const float* g, bf16* out, const float* router, float* wdense) {
    for (int m = F.gw; m < NTOK; m += F.ngw) {
        const GAS f32x4* xr = (const GAS f32x4*)(x + (size_t)m * DM) + F.lane;
        f32x4 v[4]; float s = 0.f;
#pragma unroll
        for (int j = 0; j < 4; ++j) { v[j] = xr[64 * j]; s += (v[j].x * v[j].x + v[j].y * v[j].y) + (v[j].z * v[j].z + v[j].w * v[j].w); }
        const float rstd = 1.0f / sqrtf(wave_sum(s) * (1.0f / DM) + EPS);
        GAS unsigned long long* o8 = (GAS unsigned long long*)(out + (size_t)m * DM) + F.lane;
#pragma unroll
        for (int j = 0; j < 4; ++j) { const f32x4 gg = *((const GAS f32x4*)g + 64 * j + F.lane); v[j] = v[j] * rstd * gg;
            o8[64 * j] = (unsigned long long)pk2(v[j].x, v[j].y) | ((unsigned long long)pk2(v[j].z, v[j].w) << 32); }
        if constexpr (ROUTER) {
            float lg[8];
#pragma unroll
            for (int e = 0; e < 8; ++e) lg[e] = 0.f;
#pragma unroll
            for (int j = 0; j < 4; ++j)
#pragma unroll
                for (int k = 0; k < 4; ++k) { const int c = 4 * F.lane + 256 * j + k; const f32x4 r0 = *(const GAS f32x4*)(router + (size_t)c * 8), r1 = *(const GAS f32x4*)(router + (size_t)c * 8 + 4);
                    const float hv = v[j][k];
                    lg[0] += hv * r0.x; lg[1] += hv * r0.y; lg[2] += hv * r0.z; lg[3] += hv * r0.w; lg[4] += hv * r1.x; lg[5] += hv * r1.y; lg[6] += hv * r1.z; lg[7] += hv * r1.w; }
#pragma unroll
            for (int e = 0; e < 8; ++e) lg[e] = wave_sum(lg[e]);
            int e0 = 0; float v0 = lg[0];
#pragma unroll
            for (int e = 1; e < 8; ++e) if (lg[e] > v0) { v0 = lg[e]; e0 = e; }
            int e1 = -1; float v1 = -INFINITY;
#pragma unroll
            for (int e = 0; e < 8; ++e) if (e != e0 && lg[e] > v1) { v1 = lg[e]; e1 = e; }
            const float w1 = 1.0f / (1.0f + expf(v0 - v1)), w0 = 1.0f - w1;
            if (F.lane < 8) wdense[(size_t)m * 8 + F.lane] = (F.lane == e0) ? w0 : (F.lane == e1) ? w1 : 0.f;
        }
    }
}

__device__ __forceinline__ void qkv_prep(const Frame& F, bf16* cq, bf16* ckv, const float* gq, const float* gkv) {
    for (int m = F.gw; m < NTOK; m += F.ngw) {
        { GAS v2u* p = (GAS v2u*)(cq + (size_t)m * 256) + F.lane; const v2u w = *p;
          float a = bflo(w.x), b = bfhi(w.x), c = bflo(w.y), d = bfhi(w.y);
          const float rstd = 1.0f / sqrtf(wave_sum((a * a + b * b) + (c * c + d * d)) * (1.0f / 256.0f) + EPS);
          const f32x4 gg = *((const GAS f32x4*)gq + F.lane);
          v2u o; o.x = pk2(a * rstd * gg.x, b * rstd * gg.y); o.y = pk2(c * rstd * gg.z, d * rstd * gg.w); *p = o; }
        { GAS v2u* p = (GAS v2u*)(ckv + (size_t)m * 256) + (F.lane & 31); const v2u w = *p;
          float a = bflo(w.x), b = bfhi(w.x), c = bflo(w.y), d = bfhi(w.y);
          const float ss = (F.lane < 32) ? (a * a + b * b) + (c * c + d * d) : 0.f;
          const float rstd = 1.0f / sqrtf(wave_sum(ss) * (1.0f / 128.0f) + EPS);
          const f32x4 gg = *((const GAS f32x4*)gkv + (F.lane & 31));
          v2u o; o.x = pk2(a * rstd * gg.x, b * rstd * gg.y); o.y = pk2(c * rstd * gg.z, d * rstd * gg.w); if (F.lane < 32) *p = o; }
    }
}

__device__ __forceinline__ void headnorm_rope_store(float (&v)[96], const float* g, const float* cs, float scale, bf16* dst) {
    float ss = 0.f;
#pragma unroll
    for (int d = 0; d < 96; ++d) ss += v[d] * v[d];
    const float rstd = 1.0f / sqrtf(ss * (1.0f / 96.0f) + EPS);
#pragma unroll
    for (int d = 0; d < 96; ++d) v[d] = v[d] * rstd * g[d];
#pragma unroll
    for (int i = 0; i < 16; ++i) { const float c = cs[i], s = cs[16 + i], x1 = v[64 + i], x2 = v[80 + i]; v[64 + i] = x1 * c - x2 * s; v[80 + i] = x2 * c + x1 * s; }
#pragma unroll
    for (int c = 0; c < 12; ++c) { v4u o; o.x = pk2(v[8 * c] * scale, v[8 * c + 1] * scale); o.y = pk2(v[8 * c + 2] * scale, v[8 * c + 3] * scale);
        o.z = pk2(v[8 * c + 4] * scale, v[8 * c + 5] * scale); o.w = pk2(v[8 * c + 6] * scale, v[8 * c + 7] * scale); *(GAS v4u*)(dst + 8 * c) = o; }
}
__device__ __forceinline__ void unpack8(const v4u w, float* f) { f[0] = bflo(w.x); f[1] = bfhi(w.x); f[2] = bflo(w.y); f[3] = bfhi(w.y); f[4] = bflo(w.z); f[5] = bfhi(w.z); f[6] = bflo(w.w); f[7] = bfhi(w.w); }
__device__ __forceinline__ void qk_post(const Frame& F, const bf16* qraw, const bf16* knope, const bf16* ckv, const float* rope, const float* gq, const float* gk, bf16* Qh, bf16* Kh) {
    const int nthr = F.G * NWAVES * 64;
    for (int idx = blockIdx.x * (NWAVES * 64) + F.tid; idx < NTOK * NH; idx += nthr) {
        const int tok = idx >> 3, h = idx & 7, b = tok >> 12, s = tok & (SEQ - 1);
        const float* cs = rope + (size_t)tok * 32;
        const size_t dsto = ((size_t)(b * NH + h) * SEQ + s) * DQK;
        float v[96];
#pragma unroll
        for (int c = 0; c < 12; ++c) unpack8(*(const GAS v4u*)(qraw + (size_t)tok * 1024 + 128 * h + 8 * c), &v[8 * c]);
        headnorm_rope_store(v, gq, cs, QSCALE, Qh + dsto);
#pragma unroll
        for (int c = 0; c < 8; ++c) unpack8(*(const GAS v4u*)(knope + (size_t)tok * 512 + 64 * h + 8 * c), &v[8 * c]);
#pragma unroll
        for (int c = 0; c < 4; ++c) unpack8(*(const GAS v4u*)(ckv + (size_t)tok * 256 + 128 + 8 * c), &v[64 + 8 * c]);
        headnorm_rope_store(v, gk, cs, 1.0f, Kh + dsto);
    }
}
namespace att {
typedef short bf16x8 __attribute__((ext_vector_type(8)));
typedef float f32x16 __attribute__((ext_vector_type(16)));
constexpr int KP = 208, VP = 144, KBUF = 64 * KP, VBUF = 64 * VP;
constexpr int OFF_K = 0, OFF_V = 2 * KBUF, OFF_L = OFF_V + 2 * VBUF, LDS_NEED = OFF_L + NWAVES * 32 * 4;
static_assert(LDS_NEED <= RING_BYTES, "attention LDS");
__device__ __forceinline__ void attn_unit(LAS unsigned char* lds, const bf16* Qh, const bf16* Kh, const bf16* Vt, bf16* O, int bh, int qb, int tid) {
    const int lane = tid & 63, wid = __builtin_amdgcn_readfirstlane(tid >> 6), i32 = lane & 31, hi = lane >> 5;
    const int b = bh >> 3, h = bh & 7, q0 = qb * 256, qw0 = q0 + wid * 32;
    bf16x8 qf[6];
    { const bf16* Qp = Qh + ((size_t)bh * SEQ + qw0 + i32) * DQK + hi * 8;
#pragma unroll
      for (int d0 = 0; d0 < 6; ++d0) qf[d0] = *(const GAS bf16x8*)(Qp + 16 * d0); }
    const unsigned char* Kb = (const unsigned char*)(Kh + (size_t)bh * SEQ * DQK);
    const bf16* Vb = Vt + (size_t)(h * 64 + (tid >> 3)) * NTOK + (size_t)b * SEQ + (tid & 7) * 8;
    const int kl0 = (tid / 12) * KP + (tid % 12) * 16, kl1 = ((512 + tid) / 12) * KP + ((512 + tid) % 12) * 16, vl = (tid >> 3) * VP + (tid & 7) * 16;
    const int ntiles = 4 * (qb + 1);
    const int krow = (i32 & ~12) | ((i32 & 4) << 1) | ((i32 & 8) >> 1);
    const int koff = OFF_K + krow * KP + hi * 16, voff = OFF_V + i32 * VP + hi * 16;
    f32x16 o0, o1;
#pragma unroll
    for (int r = 0; r < 16; ++r) { o0[r] = 0.f; o1[r] = 0.f; }
    float lsum = 0.f;
    v4u r0, r1, rv;
    r0 = *(const GAS v4u*)(Kb + tid * 16); r1 = (tid < 256) ? *(const GAS v4u*)(Kb + (512 + tid) * 16) : (v4u){0u, 0u, 0u, 0u}; rv = *(const GAS v4u*)(Vb);
    *(LAS v4u*)(lds + OFF_K + kl0) = r0; if (tid < 256) *(LAS v4u*)(lds + OFF_K + kl1) = r1; *(LAS v4u*)(lds + OFF_V + vl) = rv;
    __syncthreads();
    for (int t = 0; t < ntiles; ++t) {
        const int cur = t & 1; const bool more = (t + 1 < ntiles);
        if (more) { const unsigned char* kt_ = Kb + (size_t)(t + 1) * (64 * DQK * 2);
            r0 = *(const GAS v4u*)(kt_ + tid * 16); if (tid < 256) r1 = *(const GAS v4u*)(kt_ + (512 + tid) * 16); rv = *(const GAS v4u*)(Vb + (t + 1) * 64); }
        if (64 * t <= qw0 + 31) {
            const bool diag = (64 * t + 63 > qw0);
#pragma unroll
            for (int kt = 0; kt < 2; ++kt) {
                f32x16 s;
#pragma unroll
                for (int r = 0; r < 16; ++r) s[r] = 0.f;
#pragma unroll
                for (int d0 = 0; d0 < 6; ++d0) { const bf16x8 kf = *(const LAS bf16x8*)(lds + cur * KBUF + kt * 32 * KP + koff + d0 * 32);
                    s = __builtin_amdgcn_mfma_f32_32x32x16_bf16(kf, qf[d0], s, 0, 0, 0); }
                float p[16];
#pragma unroll
                for (int r = 0; r < 16; ++r) p[r] = __builtin_amdgcn_exp2f(s[r]);
                if (diag) { const int q = qw0 + i32, kb_ = 64 * t + 32 * kt + 8 * hi;
#pragma unroll
                    for (int r = 0; r < 16; ++r) { const int key = kb_ + 16 * (r >> 3) + (r & 7); if (key > q) p[r] = 0.f; } }
                float ps = 0.f;
#pragma unroll
                for (int r = 0; r < 16; ++r) ps += p[r];
                lsum += ps;
#pragma unroll
                for (int k = 0; k < 2; ++k) { v4u pw; pw.x = pg8::cvt_pk_bf16(p[8 * k], p[8 * k + 1]); pw.y = pg8::cvt_pk_bf16(p[8 * k + 2], p[8 * k + 3]); pw.z = pg8::cvt_pk_bf16(p[8 * k + 4], p[8 * k + 5]); pw.w = pg8::cvt_pk_bf16(p[8 * k + 6], p[8 * k + 7]);
                    const bf16x8 pa = __builtin_bit_cast(bf16x8, pw);
                    const bf16x8 vf0 = *(const LAS bf16x8*)(lds + cur * VBUF + voff + (kt * 32 + k * 16) * 2);
                    const bf16x8 vf1 = *(const LAS bf16x8*)(lds + cur * VBUF + voff + 32 * VP + (kt * 32 + k * 16) * 2);
                    o0 = __builtin_amdgcn_mfma_f32_32x32x16_bf16(pa, vf0, o0, 0, 0, 0); o1 = __builtin_amdgcn_mfma_f32_32x32x16_bf16(pa, vf1, o1, 0, 0, 0); }
            }
        }
        if (more) { const int nb = cur ^ 1; *(LAS v4u*)(lds + OFF_K + nb * KBUF + kl0) = r0; if (tid < 256) *(LAS v4u*)(lds + OFF_K + nb * KBUF + kl1) = r1; *(LAS v4u*)(lds + OFF_V + nb * VBUF + vl) = rv; }
        __syncthreads();
    }
    lsum += __shfl_xor(lsum, 32);
    LAS float* lsc = (LAS float*)(lds + OFF_L) + wid * 32;
    if (hi == 0) lsc[i32] = lsum;
    LDS_WAIT(); asm volatile("" ::: "memory");
    bf16* Op = O + ((size_t)b * SEQ + qw0) * 512 + h * 64 + i32;
#pragma unroll
    for (int r = 0; r < 16; ++r) { const int qr = (r & 3) + 8 * (r >> 2) + 4 * hi; const float inv = 1.0f / lsc[qr];
        Op[(size_t)qr * 512] = (bf16)f2bf(o0[r] * inv); Op[(size_t)qr * 512 + 32] = (bf16)f2bf(o1[r] * inv); }
    LDS_WAIT(); asm volatile("" ::: "memory");
}
__device__ __forceinline__ void attn_phase(const Frame& F, const bf16* Qh, const bf16* Kh, const bf16* Vt, bf16* O) {
    for (int P = F.vcu; P < BATCH * NH * 8; P += F.G) { const int bh = P >> 3, s = P & 7;
        attn_unit(F.lds, Qh, Kh, Vt, O, bh, s, F.tid); attn_unit(F.lds, Qh, Kh, Vt, O, bh, 15 - s, F.tid); }
}
}
namespace lru {
__device__ __forceinline__ float neg_expm1(float x) {
    const float t = x * (1.0f + x * (0.5f + x * (0.16666667f + x * (0.041666668f + x * (0.0083333338f + x * 0.0013888889f)))));
    const float e = 1.0f - __builtin_amdgcn_exp2f(1.4426950408889634f * x);
    return (x > -0.25f) ? -t : e;
}
typedef short bf16x8 __attribute__((ext_vector_type(8)));
typedef float f32x16 __attribute__((ext_vector_type(16)));
constexpr int CHUNK = 128, NCHUNK = SEQ / CHUNK, XP = 144;
constexpr int WAVE_LDS = 32 * XP;
template <int PASS> __device__ __forceinline__ void lru_unit(LAS unsigned char* wl, int lane, int b, int chunk, int head, const bf16* xl, const bf16* gl, const float* convw, const float* convb,
        const bf16* wgt  , const float* brg, const float* big, const float* lam, float* carry, bf16* y) {
    const int i32 = lane & 31, hi = lane >> 5;
    const int t0 = chunk * CHUNK; const size_t row0 = (size_t)b * SEQ + t0; const int c0 = head * 64;
    float cbrg[2], cbig[2], csp8[2], hcar[2], ptot[2];
#pragma unroll
    for (int cb = 0; cb < 2; ++cb) { const int c = c0 + 32 * cb + i32; cbrg[cb] = brg[c]; cbig[cb] = big[c];
        const float l = -lam[c]; csp8[cb] = 8.0f * (fmaxf(l, 0.f) + log1pf(expf(-fabsf(l))));
        hcar[cb] = 0.f; ptot[cb] = 1.f; }
    if (PASS == 2) {
#pragma unroll
        for (int cb = 0; cb < 2; ++cb) { const int c = c0 + 32 * cb + i32; float hh = 0.f;
            for (int j = 0; j < chunk; ++j) { const f32x2v pc = *(const GAS f32x2v*)(carry + (((size_t)b * NCHUNK + j) * LW + c) * 2); hh = pc.x * hh + pc.y; }
            hcar[cb] = hh; }
    }
    const int cc = lane & 7;
    for (int mb = 0; mb < CHUNK / 32; ++mb) {
        int zc = 0; asm volatile("" : "+v"(zc));
        const float* cwp = convw + c0 + 8 * cc + zc; const float* cbp = convb + c0 + 8 * cc + zc;
#pragma unroll
        for (int i = 0; i < 4; ++i) { const int tok = (lane >> 3) + 8 * i; const int s = t0 + 32 * mb + tok;
            float a8[8];
            { const f32x4 b0 = *(const GAS f32x4*)cbp, b1 = *(const GAS f32x4*)(cbp + 4); a8[0] = b0.x; a8[1] = b0.y; a8[2] = b0.z; a8[3] = b0.w; a8[4] = b1.x; a8[5] = b1.y; a8[6] = b1.z; a8[7] = b1.w; }
#pragma unroll
            for (int j = 0; j < 4; ++j) { const int sj = s - 3 + j;
                if (sj >= 0) { float x8[8]; unpack8(*(const GAS v4u*)(xl + ((size_t)b * SEQ + sj) * LW + c0 + 8 * cc), x8);
                    const f32x4 w0 = *(const GAS f32x4*)(cwp + j * LW), w1 = *(const GAS f32x4*)(cwp + j * LW + 4);
                    a8[0] += w0.x * x8[0]; a8[1] += w0.y * x8[1]; a8[2] += w0.z * x8[2]; a8[3] += w0.w * x8[3]; a8[4] += w1.x * x8[4]; a8[5] += w1.y * x8[5]; a8[6] += w1.z * x8[6]; a8[7] += w1.w * x8[7]; } }
            v4u o; o.x = pk2(a8[0], a8[1]); o.y = pk2(a8[2], a8[3]); o.z = pk2(a8[4], a8[5]); o.w = pk2(a8[6], a8[7]);
            *(LAS v4u*)(wl + tok * XP + cc * 16) = o; }
        LDS_WAIT(); asm volatile("" ::: "memory");
        f32x16 acc[4];
#pragma unroll
        for (int nb = 0; nb < 4; ++nb)
#pragma unroll
            for (int r = 0; r < 16; ++r) acc[nb][r] = 0.f;
        int zo = 0; asm volatile("" : "+v"(zo));
        const bf16* wrow = wgt + ((size_t)head * 128 + i32) * 64 + 8 * hi + zo;
#pragma unroll
        for (int kk = 0; kk < 4; ++kk) { const bf16x8 af = *(const LAS bf16x8*)(wl + i32 * XP + (16 * kk + 8 * hi) * 2);
#pragma unroll
            for (int nb = 0; nb < 4; ++nb) { const bf16x8 wf = *(const GAS bf16x8*)(wrow + ((nb >> 1) * 64 + (nb & 1) * 32) * 64 + 16 * kk);
                acc[nb] = __builtin_amdgcn_mfma_f32_32x32x16_bf16(af, wf, acc[nb], 0, 0, 0); } }
#pragma unroll
        for (int cb = 0; cb < 2; ++cb) {
            float av[16], bv[16];
#pragma unroll
            for (int r = 0; r < 16; ++r) { const int tok = (r & 3) + 8 * (r >> 2) + 4 * hi;
                const float rg = fsigmoid(acc[cb][r] + cbrg[cb]), ig = fsigmoid(acc[2 + cb][r] + cbig[cb]);
                const float la = -rg * csp8[cb]; const float a = __builtin_amdgcn_exp2f(1.4426950408889634f * la); const float mult = __builtin_amdgcn_sqrtf(neg_expm1(2.0f * la));
                const float xc = bf2f(*(const LAS unsigned short*)(wl + tok * XP + (32 * cb + i32) * 2));
                av[r] = a; bv[r] = mult * ig * xc; }
            float gA[4], gB[4];
#pragma unroll
            for (int g = 0; g < 4; ++g) { float P = av[4 * g], Hl = bv[4 * g];
#pragma unroll
                for (int i = 1; i < 4; ++i) { Hl = av[4 * g + i] * Hl + bv[4 * g + i]; P *= av[4 * g + i]; bv[4 * g + i] = Hl; av[4 * g + i] = P; }
                gA[g] = P; gB[g] = Hl; }
            float hin[4]; float hh = hcar[cb], pp = ptot[cb];
#pragma unroll
            for (int g = 0; g < 4; ++g) { const float oA = __shfl_xor(gA[g], 32), oB = __shfl_xor(gB[g], 32);
                const float fA = hi ? oA : gA[g], fB = hi ? oB : gB[g], sA = hi ? gA[g] : oA, sB = hi ? gB[g] : oB;
                const float h_first = hh; hh = fA * hh + fB; const float h_second = hh; hh = sA * hh + sB; pp *= fA * sA;
                hin[g] = hi ? h_second : h_first; }
            hcar[cb] = hh; ptot[cb] = pp;
            if (PASS == 2) {
                const int c = c0 + 32 * cb + i32;
#pragma unroll
                for (int r = 0; r < 16; ++r) { const int tok = (r & 3) + 8 * (r >> 2) + 4 * hi; const float hv = bv[r] + av[r] * hin[r >> 2];
                    const size_t off = (row0 + 32 * mb + tok) * LW + c;
                    const float gx = bf2f(*(const GAS unsigned short*)(gl + off));
                    const float u = 0.7978845608028654f * (gx + 0.044715f * gx * gx * gx);
                    const float ge = gx * fsigmoid(2.0f * u);
                    *(GAS unsigned short*)(y + off) = (unsigned short)f2bf(hv * ge); }
            }
        }
        LDS_WAIT(); asm volatile("" ::: "memory");
    }
    if (PASS == 1 && hi == 0) {
#pragma unroll
        for (int cb = 0; cb < 2; ++cb) { const int c = c0 + 32 * cb + i32; *(GAS f32x2v*)(carry + (((size_t)b * NCHUNK + chunk) * LW + c) * 2) = (f32x2v){ptot[cb], hcar[cb]}; }
    }
}
template <int PASS> __device__ __forceinline__ void lru_phase(const Frame& F, const bf16* xl, const bf16* gl, const float* convw, const float* convb, const bf16* wgt,
        const float* brg, const float* big, const float* lam, float* carry, bf16* y) {
    LAS unsigned char* wl = F.lds + 65536 + F.wave * WAVE_LDS;
    for (int U = F.gw; U < BATCH * NCHUNK * 8; U += F.ngw) { const int head = U & 7, chunk = (U >> 3) & (NCHUNK - 1), b = U >> 8;
        lru_unit<PASS>(wl, F.lane, b, chunk, head, xl, gl, convw, convb, wgt, brg, big, lam, carry, y); }
}
}
struct Args { const void* in[28]; float* out; unsigned char* ws; int ph_lo, ph_hi; };
constexpr int PH_PRO = 0, PH_L0 = 1, PH_PER_LAYER = 11, PH_MOE = PH_L0 + 2 * PH_PER_LAYER - 2  , N_PHASES = PH_MOE + 16;
enum { P_NORM1 = 0, P_PROJ = 1, P_PREP = 2, P_QKV = 3, P_QKPOST = 4, P_ATTN = 5, P_MERGE = 6, P_WO = 7, P_NORM2 = 8, P_FGU = 9, P_FDN = 10 };

static_assert(sizeof(Args) == 248, "Args layout: in[28] @0, out @224, ws @232, ph_lo @240, ph_hi @244");
#define KAS __attribute__((address_space(4)))
typedef KAS const unsigned char* kptr_t;
__device__ __forceinline__ kptr_t kargs_base() { kptr_t p = (kptr_t)__builtin_amdgcn_kernarg_segment_ptr(); asm volatile("" : "+s"(p)); return p; }
#define PHASE_BASES() const kptr_t ka_ = kargs_base(); unsigned char* const ws = *(unsigned char* const KAS*)(ka_ + 232)
#define KIN(k) (*(const float* const KAS*)(ka_ + 8 * (k)))
#define KOUT() (*(float* const KAS*)(ka_ + 224))
__global__ void __launch_bounds__(NWAVES * 64, 2) fwd_kernel(Args args) {
    extern __shared__ __attribute__((aligned(16))) unsigned char lds_raw[];
    LAS unsigned char* const lds0 = (LAS unsigned char*)lds_raw;
#define MAKE_FRAME() Frame F; { int t_ = threadIdx.x; asm volatile("" : "+v"(t_)); F.lds = lds0; F.tid = t_; F.lane = t_ & 63; F.wave = __builtin_amdgcn_readfirstlane(t_ >> 6); \
        F.G = gridDim.x; const int bx_ = blockIdx.x; F.vcu = (F.G % 8 == 0) ? (bx_ % 8) * (F.G / 8) + bx_ / 8 : bx_; F.gw = F.vcu * NWAVES + F.wave; F.ngw = F.G * NWAVES; }
    volatile LAS unsigned* MISC = (volatile LAS unsigned*)(lds0 + MISC_OFF);
    for (int u = threadIdx.x; u < (LDS_BYTES - RING_BYTES) / 4; u += NWAVES * 64) ((LAS unsigned*)(lds0 + RING_BYTES))[u] = 0u;
    __syncthreads();
    XcdBarrier bar; bar.bar = (unsigned*)(args.ws + WS_CTL) + CW_BAR; bar.x = 0; bar.st = nullptr;
#if !MK_PER_PHASE
    bar = xcd_barrier_post((unsigned*)(args.ws + WS_CTL) + CW_BAR, MISC + 8);
#endif
    const int lo = args.ph_lo, hi = args.ph_hi;
#ifndef PMASK
#define PMASK 0xFFFFu
#endif
#define EN(id) (((PMASK) >> (id)) & 1u)
#define IN(k) (lo <= (k) && (k) < hi)
#if MK_PER_PHASE
#define SEAM(k) do { } while (0)
#else
#define SEAM(k) do { if (IN((k) + 1)) xcd_barrier(bar); } while (0)
#endif
    LAS unsigned char* const ring = lds0;
#define WLP(L) (ws + WS_W + (size_t)(L) * WL_STRIDE)
    if (EN(0) && IN(PH_PRO)) {
        PHASE_BASES(); MAKE_FRAME();
#pragma unroll 1
        for (int L = 0; L < DEPTH; ++L) {
            unsigned char* wl = WLP(L);
            bf16* w_in_t = (bf16*)(wl + WL_IN);
            convert_matrix(F, KIN(3) + (size_t)L * DM * DIN, DIN, DM, DIN / 32, w_in_t, DM, [](int cb) { return 32 * (cb + (cb >= 13 ? 3 : 0)); });
            zero_rows(F, w_in_t, DM, 416, 96);
            bf16* w_uq_t = (bf16*)(wl + WL_UQ);
            convert_matrix(F, KIN(5) + (size_t)L * QLR * 768, 768, QLR, 24, w_uq_t, QLR, [](int cb) { return 32 * ((cb / 3) * 4 + cb % 3); });
#pragma unroll 1
            for (int h = 0; h < NH; ++h) zero_rows(F, w_uq_t, QLR, 128 * h + 96, 32);
            convert_matrix(F, KIN(7) + (size_t)L * KVLR * 1024, 1024, KVLR, 32, (bf16*)(wl + WL_UK), KVLR, [](int cb) { return (cb & 3) < 2 ? 32 * ((cb >> 2) * 2 + (cb & 3)) : -1; });
            convert_matrix(F, KIN(7) + (size_t)L * KVLR * 1024, 1024, KVLR, 32, (bf16*)(wl + WL_UV), KVLR, [](int cb) { return (cb & 3) >= 2 ? 32 * ((cb >> 2) * 2 + (cb & 3) - 2) : -1; });
            convert_matrix(F, KIN(10) + (size_t)L * 512 * DM, DM, 512, DM / 32, (bf16*)(wl + WL_UPA), 512, [](int cb) { return 32 * cb; });
            convert_matrix(F, KIN(18) + (size_t)L * 512 * DM, DM, 512, DM / 32, (bf16*)(wl + WL_UPL), 512, [](int cb) { return 32 * cb; });
            convert_matrix(F, KIN(19) + (size_t)L * DM * DM, DM, DM, DM / 32, (bf16*)(wl + WL_O), DM, [](int cb) { return 32 * cb; });
#pragma unroll 1
            for (int h = 0; h < 8; ++h) {
                convert_matrix(F, KIN(13) + ((size_t)L * 8 + h) * 4096, 64, 64, 2, (bf16*)(wl + WL_GT) + (size_t)h * 128 * 64, 64, [](int cb) { return 32 * cb; });
                convert_matrix(F, KIN(15) + ((size_t)L * 8 + h) * 4096, 64, 64, 2, (bf16*)(wl + WL_GT) + (size_t)h * 128 * 64 + 64 * 64, 64, [](int cb) { return 32 * cb; });
            }
        }
        convert_matrix(F, KIN(21), DFF, DM, DFF / 32, (bf16*)(ws + WS_FGU), DM, [](int cb) { return 32 * ((cb >> 2) * 8 + (cb & 3)); });
        convert_matrix(F, KIN(22), DFF, DM, DFF / 32, (bf16*)(ws + WS_FGU), DM, [](int cb) { return 32 * ((cb >> 2) * 8 + 4 + (cb & 3)); });
        convert_matrix(F, KIN(23), DM, DFF, DM / 32, (bf16*)(ws + WS_FD), DFF, [](int cb) { return 32 * cb; });
        { const int* pos = (const int*)KIN(1); float* rope = (float*)(ws + WS_ROPE); const int nthr = F.G * NWAVES * 64;
          for (int idx = blockIdx.x * (NWAVES * 64) + F.tid; idx < NTOK * 16; idx += nthr) { const int tok = idx >> 4, i = idx & 15;
              const double a = (double)pos[tok] * ROPE_INVF[i] * 0.15915494309189535; const double fr = a - rint(a);
              rope[(size_t)tok * 32 + i] = __builtin_amdgcn_cosf((float)fr); rope[(size_t)tok * 32 + 16 + i] = __builtin_amdgcn_sinf((float)fr); } }
        SEAM(PH_PRO);
    }

#pragma unroll 1
    for (int L = 0; L < DEPTH; ++L) {
        const int pb = PH_L0 + L * PH_PER_LAYER;

        if (EN(1) && IN(pb + P_NORM1)) { PHASE_BASES(); MAKE_FRAME();
            norm_rows<false>(F, L == 0 ? KIN(0) : (const float*)KOUT(), KIN(2) + (size_t)L * DM, (bf16*)(ws + WS_R1), nullptr, nullptr); SEAM(pb + P_NORM1); }

        if (EN(2) && IN(pb + P_PROJ)) { PHASE_BASES(); MAKE_FRAME();
            pg8::Gemm g{(const bf16*)(ws + WS_R1), (const bf16*)(WLP(L) + WL_IN), NTOK, DINP, DM, DM, DM}; pg8::StaticOrder S; S.init(NTOK, DINP, F.G, (int)blockIdx.x);
            pg8::EpiProj E{(bf16*)(ws + WS_R2)};
            pg8::gemm_phase<pg8::EpiProj, pg8::StaticOrder, true, true>(ring, g, S, E);
            SEAM(pb + P_PROJ);
        }
        if ((EN(3) || EN(14)) && IN(pb + P_PREP)) { PHASE_BASES(); MAKE_FRAME();
            if (EN(3)) qkv_prep(F, (bf16*)(ws + WS_R2 + R2_CQ), (bf16*)(ws + WS_R2 + R2_CKV), KIN(4) + (size_t)L * QLR, KIN(6) + (size_t)L * KVLR);
            if (EN(14)) lru::lru_phase<1>(F, (const bf16*)(ws + WS_R2 + R2_XL), (const bf16*)(ws + WS_R2 + R2_GL), KIN(11) + (size_t)L * 4 * LW, KIN(12) + (size_t)L * LW, (const bf16*)(WLP(L) + WL_GT),
                              KIN(14) + (size_t)L * LW, KIN(16) + (size_t)L * LW, KIN(17) + (size_t)L * LW, (float*)(ws + WS_CARRY), (bf16*)(ws + WS_R4 + R4_Y));
            SEAM(pb + P_PREP);
        }
        if (EN(4) && IN(pb + P_QKV)) { PHASE_BASES(); MAKE_FRAME();
            bf16* cq = (bf16*)(ws + WS_R2 + R2_CQ); bf16* ckv = (bf16*)(ws + WS_R2 + R2_CKV);
#pragma unroll 1
            for (int j = 0; j < 3; ++j) {
                pg8::Gemm g; pg8::EpiStore E; int M_, N_;
                if (j == 0)      { g = pg8::Gemm{cq, (const bf16*)(WLP(L) + WL_UQ), NTOK, 1024, QLR, QLR, QLR};      E = pg8::EpiStore{(bf16*)(ws + WS_R4), 1024};        M_ = NTOK; N_ = 1024; }
                else if (j == 1) { g = pg8::Gemm{ckv, (const bf16*)(WLP(L) + WL_UK), NTOK, 512, KVLR, 256, KVLR};     E = pg8::EpiStore{(bf16*)(ws + WS_R1), 512};         M_ = NTOK; N_ = 512; }
                else             { g = pg8::Gemm{(const bf16*)(WLP(L) + WL_UV), ckv, 512, NTOK, KVLR, KVLR, 256};     E = pg8::EpiStore{(bf16*)(ws + WS_R3 + R3_VT), NTOK}; M_ = 512;  N_ = NTOK; }
                pg8::StaticOrder S; S.init(M_, N_, F.G, (int)blockIdx.x);
                pg8::gemm_phase<pg8::EpiStore, pg8::StaticOrder, true, true>(ring, g, S, E);
                __syncthreads();
            }
            SEAM(pb + P_QKV);
        }
        if (EN(5) && IN(pb + P_QKPOST)) { PHASE_BASES(); MAKE_FRAME();
            qk_post(F, (const bf16*)(ws + WS_R4), (const bf16*)(ws + WS_R1), (const bf16*)(ws + WS_R2 + R2_CKV), (const float*)(ws + WS_ROPE), KIN(8) + (size_t)L * DQK, KIN(9) + (size_t)L * DQK,
                    (bf16*)(ws + WS_R3 + R3_Q), (bf16*)(ws + WS_R3 + R3_K));
            SEAM(pb + P_QKPOST);
        }
        if ((EN(6) || EN(15)) && IN(pb + P_ATTN)) { PHASE_BASES(); MAKE_FRAME();
            if (EN(6)) att::attn_phase(F, (const bf16*)(ws + WS_R3 + R3_Q), (const bf16*)(ws + WS_R3 + R3_K), (const bf16*)(ws + WS_R3 + R3_VT), (bf16*)(ws + WS_R4 + R4_O));
            if (EN(15)) lru::lru_phase<2>(F, (const bf16*)(ws + WS_R2 + R2_XL), (const bf16*)(ws + WS_R2 + R2_GL), KIN(11) + (size_t)L * 4 * LW, KIN(12) + (size_t)L * LW, (const bf16*)(WLP(L) + WL_GT),
                              KIN(14) + (size_t)L * LW, KIN(16) + (size_t)L * LW, KIN(17) + (size_t)L * LW, (float*)(ws + WS_CARRY), (bf16*)(ws + WS_R4 + R4_Y));
            SEAM(pb + P_ATTN);
        }
        if (EN(7) && IN(pb + P_MERGE)) { PHASE_BASES(); MAKE_FRAME();
#pragma unroll 1
            for (int j = 0; j < 2; ++j) {
                pg8::Gemm g{(const bf16*)(ws + WS_R4 + (j == 0 ? R4_O : R4_Y)), (const bf16*)(WLP(L) + (j == 0 ? WL_UPA : WL_UPL)), NTOK, DM, 512, 512, 512}; pg8::StaticOrder S; S.init(NTOK, DM, F.G, (int)blockIdx.x);
                pg8::EpiMerge E{(const bf16*)(ws + WS_R2 + (j == 0 ? R2_GA : R2_GB)), (bf16*)(ws + WS_R1), j};
                pg8::gemm_phase<pg8::EpiMerge, pg8::StaticOrder, true, true>(ring, g, S, E);
                __syncthreads();
            }
            SEAM(pb + P_MERGE);
        }
        if (EN(8) && IN(pb + P_WO)) { PHASE_BASES(); MAKE_FRAME();
            pg8::Gemm g{(const bf16*)(ws + WS_R1), (const bf16*)(WLP(L) + WL_O), NTOK, DM, DM, DM, DM}; pg8::StaticOrder S; S.init(NTOK, DM, F.G, (int)blockIdx.x);
            pg8::EpiResid E{L == 0 ? KIN(0) : (const float*)KOUT(), KOUT(), nullptr, 0};
            pg8::gemm_phase<pg8::EpiResid, pg8::StaticOrder, true, true>(ring, g, S, E);
            SEAM(pb + P_WO);
        }
        if (EN(9) && IN(pb + P_NORM2)) { PHASE_BASES(); MAKE_FRAME();
            if (L == 0) norm_rows<false>(F, KOUT(), KIN(20) + (size_t)L * DM, (bf16*)(ws + WS_R1), nullptr, nullptr);
            else {
                norm_rows<true>(F, KOUT(), KIN(20) + (size_t)L * DM, (bf16*)(ws + WS_R1), KIN(24), (float*)(ws + WS_WDENSE));
#pragma unroll 1
                for (int e = 0; e < NEXP; ++e) {
                    bf16* wgu = (bf16*)(ws + MOE_WGU) + (size_t)e * 2 * DFE * DM;
                    convert_matrix(F, KIN(25) + (size_t)e * DM * DFE, DFE, DM, DFE / 32, wgu, DM, [](int cb) { return 32 * ((cb >> 2) * 8 + (cb & 3)); });
                    convert_matrix(F, KIN(26) + (size_t)e * DM * DFE, DFE, DM, DFE / 32, wgu, DM, [](int cb) { return 32 * ((cb >> 2) * 8 + 4 + (cb & 3)); });
                    convert_matrix(F, KIN(27) + (size_t)e * DFE * DM, DM, DFE, DM / 32, (bf16*)(ws + MOE_WD) + (size_t)e * DM * DFE, DFE, [](int cb) { return 32 * cb; });
                }
            }
            SEAM(pb + P_NORM2);
        }
        if (L == 0) {
            if (EN(10) && IN(pb + P_FGU)) { PHASE_BASES(); MAKE_FRAME();
                pg8::Gemm g{(const bf16*)(ws + WS_R1), (const bf16*)(ws + WS_FGU), NTOK, 2 * DFF, DM, DM, DM}; pg8::StaticOrder S; S.init(NTOK, 2 * DFF, F.G, (int)blockIdx.x);
                pg8::EpiSwiglu E{(bf16*)(ws + WS_R2), DFF};
                pg8::gemm_phase<pg8::EpiSwiglu, pg8::StaticOrder, true, true>(ring, g, S, E);
                SEAM(pb + P_FGU);
            }
            if (EN(11) && IN(pb + P_FDN)) { PHASE_BASES(); MAKE_FRAME();
                pg8::Gemm g{(const bf16*)(ws + WS_R2), (const bf16*)(ws + WS_FD), NTOK, DM, DFF, DFF, DFF}; pg8::StaticOrder S; S.init(NTOK, DM, F.G, (int)blockIdx.x);
                pg8::EpiResid E{KOUT(), KOUT(), nullptr, 0};
                pg8::gemm_phase<pg8::EpiResid, pg8::StaticOrder, true, true>(ring, g, S, E);
                SEAM(pb + P_FDN);
            }
        }
    }
#pragma unroll 1
    for (int e = 0; e < NEXP; ++e) {
        if (EN(12) && IN(PH_MOE + 2 * e)) { PHASE_BASES(); MAKE_FRAME();
            pg8::Gemm g{(const bf16*)(ws + WS_R1), (const bf16*)(ws + MOE_WGU) + (size_t)e * 2 * DFE * DM, NTOK, 2 * DFE, DM, DM, DM}; pg8::StaticOrder S; S.init(NTOK, 2 * DFE, F.G, (int)blockIdx.x);
            pg8::EpiSwiglu E{(bf16*)(ws + MOE_ACT), DFE};
            pg8::gemm_phase<pg8::EpiSwiglu, pg8::StaticOrder, true, true>(ring, g, S, E);
            SEAM(PH_MOE + 2 * e);
        }
        if (EN(13) && IN(PH_MOE + 2 * e + 1)) { PHASE_BASES(); MAKE_FRAME();
            pg8::Gemm g{(const bf16*)(ws + MOE_ACT), (const bf16*)(ws + MOE_WD) + (size_t)e * DM * DFE, NTOK, DM, DFE, DFE, DFE}; pg8::StaticOrder S; S.init(NTOK, DM, F.G, (int)blockIdx.x);
            pg8::EpiResid E{KOUT(), KOUT(), (const float*)(ws + WS_WDENSE) + e, 8};
            pg8::gemm_phase<pg8::EpiResid, pg8::StaticOrder, true, true>(ring, g, S, E);
            SEAM(PH_MOE + 2 * e + 1);
        }
    }
#undef IN
#undef SEAM
}

extern "C" void kernel_launch(void* const* d_in, const int* in_sizes, int n_in, void* d_out, int out_size, void* d_ws, size_t ws_size, hipStream_t stream) {
    static int grid = 0;
    if (grid == 0) {
        if (n_in != 28 || in_sizes[0] != NTOK * DM || out_size != NTOK * DM || ws_size < WS_END) { fprintf(stderr, "kernel_launch: unexpected problem (n_in %d, ws %zu < %zu)\n", n_in, ws_size, (size_t)WS_END); grid = -1; return; }
        int dev = 0, cus = 0, per_cu = 0;
        if (hipGetDevice(&dev) != hipSuccess || hipDeviceGetAttribute(&cus, hipDeviceAttributeMultiprocessorCount, dev) != hipSuccess) { grid = -1; return; }
        if (hipFuncSetAttribute((const void*)fwd_kernel, hipFuncAttributeMaxDynamicSharedMemorySize, LDS_BYTES) != hipSuccess) { fprintf(stderr, "kernel_launch: hipFuncSetAttribute failed\n"); grid = -1; return; }
        if (hipOccupancyMaxActiveBlocksPerMultiprocessor(&per_cu, (const void*)fwd_kernel, NWAVES * 64, LDS_BYTES) != hipSuccess || per_cu < 1) fprintf(stderr, "kernel_launch: occupancy query reports %d\n", per_cu);
        (void)hipGetLastError();
        grid = cus;
    }
    if (grid < 0) return;
    if (hipMemsetAsync((char*)d_ws + WS_CTL, 0, CTL_ZERO_BYTES, stream) != hipSuccess) return;
    Args a{};
    for (int i = 0; i < 28; ++i) a.in[i] = d_in[i];
    a.out = (float*)d_out; a.ws = (unsigned char*)d_ws;
#if MK_PER_PHASE
    for (int p = 0; p < N_PHASES; ++p) { a.ph_lo = p; a.ph_hi = p + 1; hipLaunchKernelGGL(fwd_kernel, dim3(grid), dim3(NWAVES * 64), LDS_BYTES, stream, a); }
#else
    a.ph_lo = 0; a.ph_hi = N_PHASES; hipLaunchKernelGGL(fwd_kernel, dim3(grid), dim3(NWAVES * 64), LDS_BYTES, stream, a);
#endif
}
```

```cpp
#include <hip/hip_runtime.h>
#include <cstdio>
#include <cstdint>
namespace cfg {
constexpr int BATCH = 8, SEQ = 4096, NTOK = BATCH * SEQ, DM = 1024, DEPTH = 2;
constexpr int NH = 8, DQK = 96, DNOPE = 64, DROPE = 32, DVH = 64, QLR = 256, KVLR = 128;
constexpr int LW = 512, LHD = 64;
constexpr int DIN = 3488, DINP = 3584;
constexpr int DFF = 2816, NEXP = 8, DFE = 3584;
constexpr float EPS = 1e-6f;
constexpr float QSCALE = 0.14724444602590306f;
}
using namespace cfg;
constexpr int NWAVES = 8;
static_assert(true, "");
constexpr bool FFN_F8 = false;
constexpr bool FFN_DN_F8 = false;
constexpr bool PROJ_F8 = true;
constexpr bool MOE_DN_F8 = true;
constexpr bool MOE_F8 = true;
#define DUPMASK 0x0u
#ifndef MK_PER_PHASE
#define MK_PER_PHASE 0
#endif
constexpr size_t MiB = 1u << 20;
constexpr size_t WS_CTL = 0, CTL_ZERO_BYTES = 2 * MiB;
constexpr size_t WS_STAT = 64 * 1024;
static_assert(WS_STAT + 7 * (size_t)NTOK * 8 <= CTL_ZERO_BYTES, "stats inside the memset region");
constexpr size_t WS_ROPE = 2 * MiB;
constexpr size_t WS_SLOT = 6 * MiB;
constexpr size_t WS_CARRY = 7 * MiB;
constexpr size_t WS_HALO = 6 * MiB + 256 * 1024;
constexpr size_t WS_LTOK = 8 * MiB, WS_LW = 9 * MiB;
constexpr size_t WS_W = 10 * MiB;
constexpr size_t WL_STRIDE = 12 * MiB;
constexpr size_t WL_IN = 0, WL_UQ = 7 * MiB, WL_UK = WL_UQ + 512 * 1024, WL_UV = WL_UK + 128 * 1024, WL_UPA = WL_UV + 128 * 1024, WL_UPL = WL_UPA + MiB, WL_O = WL_UPL + MiB, WL_GT = WL_O + 2 * MiB;
static_assert(WL_GT + 128 * 1024 <= WL_STRIDE, "layer weights");
constexpr size_t WS_FGU = WS_W + 2 * WL_STRIDE, WS_FD = WS_FGU + 11 * MiB;
constexpr size_t WS_R1 = 52 * MiB;
constexpr size_t WS_R2 = 116 * MiB;
constexpr size_t WS_R3 = 340 * MiB;
constexpr size_t WS_R4 = 468 * MiB;
constexpr size_t WS_Y2 = 532 * MiB;
constexpr size_t WS_END = 536 * MiB;
static_assert(WS_FD + (size_t)DM * DFF * 2 <= WS_R1, "weights region");
constexpr size_t R2_CQ = 0, R2_CKV = 16 * MiB, R2_XL = 32 * MiB, R2_GL = 64 * MiB, R2_GA = 96 * MiB, R2_GB = 160 * MiB;
constexpr size_t R3_Q = 0, R3_K = 48 * MiB, R3_VT = 96 * MiB;
constexpr size_t R4_O = 0, R4_Y = 32 * MiB;
constexpr size_t MOE_X8 = 10 * MiB, MOE_WGU = 42 * MiB, MOE_WD = 98 * MiB, MOE_ACT = 126 * MiB, MOE_Y = 357 * MiB, MOE_Y2 = 489 * MiB;
static_assert(MOE_X8 + (size_t)NTOK * DM <= MOE_WGU && MOE_WGU + (size_t)NEXP * 2 * DFE * DM <= MOE_WD && MOE_WD + (size_t)NEXP * DFE * DM <= MOE_ACT && MOE_ACT + (size_t)264 * 256 * DFE <= MOE_Y && MOE_Y + (size_t)264 * 256 * DM * 2 <= MOE_Y2 && MOE_Y2 + 4 * MiB <= WS_END, "moe buffers");
constexpr int CW_CNT = 64;
constexpr int CW_BAR = 4096;
constexpr int RING_BYTES = 131072, MISC_OFF = RING_BYTES + 320, LDS_BYTES = 147456;
namespace pg8 {
#define PG8_LAS __attribute__((address_space(3)))
typedef unsigned short bf16_t;
typedef short bf16x8 __attribute__((ext_vector_type(8)));
typedef float f32x4 __attribute__((ext_vector_type(4)));
typedef unsigned u32x4 __attribute__((ext_vector_type(4)));
constexpr int BM = 256, BK = 64, HALF = 128, HTB = HALF * BK * 2  , STAGE_BYTES = 8 * HTB, NXCD = 8, WGM = 8;

__host__ __device__ __forceinline__ int lds_byte(int r, int c) { const int st = (r >> 4) * 2 + (c >> 5), rr = r & 15, cc = c & 31, ob = rr * 64 + cc * 2; return st * 1024 + (ob ^ (((ob >> 9) & 1) << 5)); }
__host__ __device__ __forceinline__ void stage_rc(int b, int& R, int& C) { const int st = b / 1024, sb = b % 1024, swz = sb ^ (((sb >> 9) & 1) << 5); R = (st >> 1) * 16 + swz / 64; C = (st & 1) * 32 + (swz % 64) / 2; }
__host__ __device__ __forceinline__ int perm32(int rho) { const int n = rho >> 4, i = rho & 15; return 8 * (i >> 2) + 4 * n + (i & 3); }

struct Unit { int pm, pn, po, lb, nvalid, stage, ntu; size_t boff, aoff; };
struct Gemm { const bf16_t* A; const bf16_t* Bt; int M, N, K, lda, ldb; int wexp = 127; };
typedef int v8i32 __attribute__((ext_vector_type(8)));
typedef int v4i32 __attribute__((ext_vector_type(4)));
__device__ __forceinline__ v8i32 cat8(const bf16x8 lo, const bf16x8 hi) { const v4i32 a = __builtin_bit_cast(v4i32, lo), b = __builtin_bit_cast(v4i32, hi); return __builtin_shufflevector(a, b, 0, 1, 2, 3, 4, 5, 6, 7); }

struct StaticOrder {
    int nM, nN, nwg, G, c;
    __host__ __device__ void init(int M, int N, int G_, int c_) { nM = M / BM; nN = N / BM; nwg = nM * nN; G = G_; c = c_; }
    __host__ __device__ bool next(int i, Unit& u) const {
        const long L = (long)i * G + c; if (L >= nwg) return false;
        int wgid = (int)L; { const int q = nwg / NXCD, r = nwg % NXCD, xcd = wgid % NXCD, off = wgid / NXCD; wgid = (xcd < r ? xcd * (q + 1) : r * (q + 1) + (xcd - r) * q) + off; }
        const int nig = WGM * nN, gid = wgid / nig, fm = gid * WGM, gsz = (nM - fm) < WGM ? (nM - fm) : WGM;
        u.pm = fm + ((wgid % nig) % gsz); u.pn = (wgid % nig) / gsz; u.po = u.pm; u.lb = 0; u.nvalid = BM; u.stage = 0; u.ntu = 0; u.boff = 0; u.aoff = 0; return true;
    }
    static constexpr bool GATHER = false;
    __device__ __forceinline__ u32x4 rows(const Unit&, int, int) const { return (u32x4){0u, 0u, 0u, 0u}; }
    __device__ __forceinline__ void a_ready(const Unit&) const {}
    __device__ __forceinline__ void done(const Unit&) const {}
};

__device__ __forceinline__ int static_unit(int i, int M, int N, int G, int c) {
    const int nM = M / BM, nN = N / BM, nwg = nM * nN; const long L = (long)i * G + c; if (L >= nwg) return -1;
    int wgid = (int)L; { const int q = nwg / NXCD, r = nwg % NXCD, xcd = wgid % NXCD, off = wgid / NXCD; wgid = (xcd < r ? xcd * (q + 1) : r * (q + 1) + (xcd - r) * q) + off; }
    const int nig = WGM * nN, gid = wgid / nig, fm = gid * WGM, gsz = (nM - fm) < WGM ? (nM - fm) : WGM;
    return ((fm + ((wgid % nig) % gsz)) << 8) | ((wgid % nig) / gsz);
}
__device__ __forceinline__ unsigned cvt_pk_bf16(float lo, float hi) { unsigned r; asm volatile("v_cvt_pk_bf16_f32 %0, %1, %2" : "=v"(r) : "v"(lo), "v"(hi)); return r; }
typedef float f32x2 __attribute__((ext_vector_type(2)));
__device__ __forceinline__ f32x2 gelu_pk(f32x2 v) {
    const f32x2 av = __builtin_elementwise_abs(v), d = av * 0.2316418882f + 1.0f;
    f32x2 t; t.x = __builtin_amdgcn_rcpf(d.x); t.y = __builtin_amdgcn_rcpf(d.y);
    f32x2 q = t * 0.5307027145f + (-0.7265760135f); q = q * t + 0.7107068705f; q = q * t + (-0.142248368f); q = q * t + 0.127414796f; q = q * t;
    const f32x2 s = (v * v) * (-0.72134752044f);
    f32x2 e; e.x = __builtin_amdgcn_exp2f(s.x); e.y = __builtin_amdgcn_exp2f(s.y);
    const f32x2 m = v * (q * e), r = v - m;
    f32x2 o; o.x = v.x < 0.f ? m.x : r.x; o.y = v.y < 0.f ? m.y : r.y; return o;
}

template <int ACT  > struct EpiBf16 {
    static constexpr bool PERM = true, AFTER_DRAIN = false; static_assert(ACT == 0 || ACT == 1, "EpiBf16: ACT is 0 (none) or 1 (gelu_pk)");
    bf16_t* O; int ldc; const float* bias; int split_cols; size_t split_stride; float scale0;
    __device__ __forceinline__ void operator()(const f32x4 (&acc)[2][2][4][2], const Unit& u, int wr, int wc, int fr, int fq) const {
        const int row0 = u.pm * BM + wr * 64 + fr; int colt = u.pn * BM; bf16_t* base = O;
        float sc = 1.f; if (split_cols) { const int t = colt / split_cols; base += (size_t)t * split_stride; colt -= t * split_cols; if (t == 0) sc = scale0; }
        const int col0 = colt + wc * 32 + 8 * fq, bcol0 = u.pn * BM + wc * 32 + 8 * fq;
        f32x4 bv[2][2];
#pragma unroll
        for (int bj = 0; bj < 2; ++bj)
#pragma unroll
            for (int n = 0; n < 2; ++n) bv[bj][n] = bias ? *(const f32x4*)(bias + bcol0 + bj * HALF + 4 * n) : (f32x4){0.f, 0.f, 0.f, 0.f};
#pragma unroll
        for (int ai = 0; ai < 2; ++ai)
#pragma unroll
            for (int m = 0; m < 4; ++m) { bf16_t* rowp = base + (size_t)(row0 + ai * HALF + m * 16) * ldc + col0;
#pragma unroll
                for (int bj = 0; bj < 2; ++bj) { f32x4 v0 = acc[ai][bj][m][0] + bv[bj][0], v1 = acc[ai][bj][m][1] + bv[bj][1];
                    if (ACT == 1) { f32x2 a = gelu_pk((f32x2){v0[0], v0[1]}), b = gelu_pk((f32x2){v0[2], v0[3]}), c = gelu_pk((f32x2){v1[0], v1[1]}), d = gelu_pk((f32x2){v1[2], v1[3]});
                        v0 = (f32x4){a.x, a.y, b.x, b.y}; v1 = (f32x4){c.x, c.y, d.x, d.y}; }
                    v0 = v0 * sc; v1 = v1 * sc; u32x4 w; w.x = cvt_pk_bf16(v0[0], v0[1]); w.y = cvt_pk_bf16(v0[2], v0[3]); w.z = cvt_pk_bf16(v1[0], v1[1]); w.w = cvt_pk_bf16(v1[2], v1[3]);
                    *(u32x4*)(rowp + bj * HALF) = w; } }
    }
};

__device__ __forceinline__ int fresh_lane_id() { int l; asm volatile("v_mbcnt_lo_u32_b32 %0, -1, 0\n\tv_mbcnt_hi_u32_b32 %0, -1, %0" : "=v"(l)); return l; }
__device__ __forceinline__ void glds16_s(const void* sbase, unsigned voff, unsigned ldsaddr) {
    unsigned keep;
    asm volatile("s_mov_b32 %0, m0\n\ts_mov_b32 m0, %3\n\ts_nop 0\n\tglobal_load_lds_dwordx4 %1, %2\n\ts_mov_b32 m0, %0"
                 : "=&s"(keep) : "v"(voff), "s"(sbase), "s"(ldsaddr) : "memory");
}
template <class E, class = void> struct epi_chain { static constexpr bool value = false; };
template <class E> struct epi_chain<E, decltype((void)E::CHAIN)> { static constexpr bool value = E::CHAIN; };
template <class Epi, class Sched, bool ALIGN_EPI = false, bool SP2 = false, int EB = 2>
__device__ __forceinline__ void gemm_phase(PG8_LAS unsigned char* lds, const Gemm g, const Sched& S, const Epi& E, const int wave_id  ) {
    int tid_ = wave_id * 64 + fresh_lane_id();
    const int tid = tid_, wid = __builtin_amdgcn_readfirstlane(tid >> 6), lane = tid & 63, wr = wid >> 2, wc = wid & 3, fr = lane & 15, fq = lane >> 4;
    const int K = g.K; int nt = K * EB / 128; asm volatile("" : "+s"(nt));
    unsigned voffA[2], voffB[2];
#pragma unroll
    for (int i = 0; i < 2; ++i) { int R, C; stage_rc(tid * 16 + i * 8192, R, C); const int Rb = Epi::PERM ? ((R & ~31) + perm32(R & 31)) : R;
        voffA[i] = (unsigned)(R * g.lda * EB + C * 2); voffB[i] = (unsigned)(Rb * g.ldb * EB + C * 2); }
    const int wsc = g.wexp * 0x01010101;
    const size_t kstep = (size_t)(BK * 2);
    constexpr bool GA = Sched::GATHER;
    const size_t hstepA = GA ? (size_t)0 : (size_t)HALF * g.lda * EB, hstepB = (size_t)HALF * g.ldb * EB;
    const size_t tstepA = 2 * hstepA, tstepB = 2 * hstepB;
    const unsigned ldsb = (unsigned)(uintptr_t)lds;
    const unsigned ldsw = (unsigned)wid * 1024u;
    const int aoff = lds_byte(wr * 64 + fr, fq * 8), boff = lds_byte(wc * 32 + fr, fq * 8);
#define PG8_SA(b, h) (((b) * 2 + (h)) * HTB)
#define PG8_SB(b, h) ((4 + (b) * 2 + (h)) * HTB)
#define PG8_STAGE(bufoff, gbase, voff) do { _Pragma("unroll") for (int _i = 0; _i < 2; ++_i) glds16_s((const char*)(gbase), (voff)[_i], ldsb + (unsigned)(bufoff) + ldsw + (unsigned)_i * 8192u); } while (0)
#define PG8_LDA(dst, b, h) do { _Pragma("unroll") for (int m = 0; m < 4; ++m) _Pragma("unroll") for (int k = 0; k < 2; ++k) dst[m][k] = *(const PG8_LAS bf16x8*)(lds + PG8_SA(b, h) + aoff + m * 2048 + k * 1024); } while (0)
#define PG8_LDB(dst, b, h) do { _Pragma("unroll") for (int n = 0; n < 2; ++n) _Pragma("unroll") for (int k = 0; k < 2; ++k) dst[n][k] = *(const PG8_LAS bf16x8*)(lds + PG8_SB(b, h) + boff + n * 2048 + k * 1024); } while (0)
#define PG8_MMA(ai, bj, At, Bt) do { __builtin_amdgcn_s_setprio(1); _Pragma("unroll") for (int m = 0; m < 4; ++m) _Pragma("unroll") for (int n = 0; n < 2; ++n) { \
        if constexpr (EB == 2) { _Pragma("unroll") for (int k = 0; k < 2; ++k) acc[ai][bj][m][n] = __builtin_amdgcn_mfma_f32_16x16x32_bf16(Bt[n][k], At[m][k], acc[ai][bj][m][n], 0, 0, 0); } \
        else { acc[ai][bj][m][n] = __builtin_amdgcn_mfma_scale_f32_16x16x128_f8f6f4(cat8(Bt[n][0], Bt[n][1]), cat8(At[m][0], At[m][1]), acc[ai][bj][m][n], 0, 0, 0, wsc, 0, wsc); } } \
        __builtin_amdgcn_s_setprio(0); } while (0)
#define PG8_WAIT_V(n) asm volatile("s_waitcnt vmcnt(" #n ")" ::: "memory")
#define PG8_WAIT_L(n) asm volatile("s_waitcnt lgkmcnt(" #n ")" ::: "memory")
#define PG8_BAR __builtin_amdgcn_s_barrier()
#define PG8_SCHED __builtin_amdgcn_sched_barrier(0)
    Unit cur, nxt; int ui = 0;
    if (!S.next(0, cur)) return;
    f32x4 acc[2][2][4][2];
#pragma unroll
    for (int a = 0; a < 2; ++a)
#pragma unroll
        for (int b = 0; b < 2; ++b)
#pragma unroll
            for (int m = 0; m < 4; ++m)
#pragma unroll
                for (int n = 0; n < 2; ++n) acc[a][b][m][n] = (f32x4){0.f, 0.f, 0.f, 0.f};
    bf16x8 At[4][2], B0[2][2], B1[2][2];
    const char* cA = (const char*)g.A + cur.aoff + (size_t)cur.pm * tstepA; const char* cB = (const char*)g.Bt + cur.boff + (size_t)cur.pn * tstepB;
    unsigned vc0[2], vc1[2];
    PG8_LAS u32x4* gslot = (PG8_LAS u32x4*)(lds + STAGE_BYTES + 1024 + tid * 16);
    if constexpr (GA) { const u32x4 o = S.rows(cur, tid, g.lda * EB); vc0[0] = o.x; vc0[1] = o.y; vc1[0] = o.z; vc1[1] = o.w; } else { vc0[0] = vc1[0] = voffA[0]; vc0[1] = vc1[1] = voffA[1]; }
    S.a_ready(cur);
    if constexpr (SP2) {
        PG8_STAGE(PG8_SB(0, 0), cB, voffB); PG8_STAGE(PG8_SB(0, 1), cB + hstepB, voffB); PG8_STAGE(PG8_SA(0, 0), cA, vc0); PG8_STAGE(PG8_SA(0, 1), cA + hstepA, vc1);
        if (wr == 1) PG8_BAR;
        PG8_WAIT_V(2); PG8_BAR;
        PG8_STAGE(PG8_SB(1, 0), cB + kstep, voffB); PG8_STAGE(PG8_SA(1, 0), cA + kstep, vc0); PG8_STAGE(PG8_SB(1, 1), cB + hstepB + kstep, voffB);
        PG8_WAIT_V(6); PG8_BAR;
    } else {
        PG8_STAGE(PG8_SB(0, 0), cB, voffB); PG8_STAGE(PG8_SA(0, 0), cA, vc0); PG8_STAGE(PG8_SB(0, 1), cB + hstepB, voffB); PG8_STAGE(PG8_SA(0, 1), cA + hstepA, vc1);
        if (wr == 1) PG8_BAR;
        PG8_WAIT_V(4); PG8_BAR;
        PG8_STAGE(PG8_SB(1, 0), cB + kstep, voffB); PG8_STAGE(PG8_SA(1, 0), cA + kstep, vc0); PG8_STAGE(PG8_SB(1, 1), cB + hstepB + kstep, voffB);
        PG8_WAIT_V(6); PG8_BAR;
    }
    for (;;) {
        const bool has_next = S.next(ui + 1, nxt);
        if constexpr (GA) { if (has_next) *gslot = S.rows(nxt, tid, g.lda * EB); }
        const char* nA = has_next ? (const char*)g.A + nxt.aoff + (size_t)nxt.pm * tstepA : cA; const char* nB = has_next ? (const char*)g.Bt + nxt.boff + (size_t)nxt.pn * tstepB : cB;
        const int ntc = cur.ntu ? cur.ntu : nt;
#pragma unroll 1
        for (int t = 0; t < ntc; t += 2) {
            const bool last = (t == ntc - 2);
            const char* a1 = cA + (size_t)(t + 1) * kstep;
            const char* a2 = last ? nA : cA + (size_t)(t + 2) * kstep; const char* b2 = last ? nB : cB + (size_t)(t + 2) * kstep;
            const char* a3 = a2 + kstep; const char* b3 = b2 + kstep;
            if (last && has_next) S.a_ready(nxt);
            if constexpr (SP2) {
            PG8_LDB(B0, 0, 0); PG8_LDB(B1, 0, 1); PG8_SCHED; PG8_LDA(At, 0, 0); PG8_STAGE(PG8_SA(1, 1), a1 + hstepA, vc1);
            if constexpr (GA) { if (last && has_next) { const u32x4 o = *gslot; vc0[0] = o.x; vc0[1] = o.y; vc1[0] = o.z; vc1[1] = o.w; } }
            PG8_WAIT_V(8); PG8_WAIT_L(0); PG8_BAR; PG8_MMA(0, 0, At, B0); PG8_MMA(0, 1, At, B1); PG8_BAR; PG8_SCHED;
            PG8_LDA(At, 0, 1); PG8_STAGE(PG8_SB(0, 0), b2, voffB); PG8_STAGE(PG8_SB(0, 1), b2 + hstepB, voffB); PG8_STAGE(PG8_SA(0, 0), a2, vc0);
            PG8_WAIT_V(8); PG8_WAIT_L(0); PG8_BAR; PG8_MMA(1, 0, At, B0); PG8_MMA(1, 1, At, B1); PG8_BAR; PG8_SCHED;
            PG8_LDB(B0, 1, 0); PG8_LDB(B1, 1, 1); PG8_SCHED; PG8_LDA(At, 1, 0); PG8_STAGE(PG8_SA(0, 1), a2 + hstepA, vc1);
            PG8_WAIT_V(8); PG8_WAIT_L(0); PG8_BAR; PG8_MMA(0, 0, At, B0); PG8_MMA(0, 1, At, B1); PG8_BAR; PG8_SCHED;
            PG8_LDA(At, 1, 1); PG8_STAGE(PG8_SB(1, 0), b3, voffB); PG8_STAGE(PG8_SB(1, 1), b3 + hstepB, voffB); PG8_STAGE(PG8_SA(1, 0), a3, vc0);
            PG8_WAIT_V(8); PG8_WAIT_L(0); PG8_BAR; PG8_MMA(1, 0, At, B0); PG8_MMA(1, 1, At, B1); PG8_BAR; PG8_SCHED;
            } else {
            PG8_LDB(B0, 0, 0); PG8_SCHED; PG8_LDA(At, 0, 0); PG8_STAGE(PG8_SA(1, 1), a1 + hstepA, vc1);
            if constexpr (GA) { if (last && has_next) { const u32x4 o = *gslot; vc0[0] = o.x; vc0[1] = o.y; vc1[0] = o.z; vc1[1] = o.w; } }
            PG8_WAIT_L(8); PG8_BAR; PG8_WAIT_L(0); PG8_MMA(0, 0, At, B0); PG8_BAR; PG8_SCHED;
            PG8_LDB(B1, 0, 1); PG8_STAGE(PG8_SB(0, 0), b2, voffB);
            PG8_BAR; PG8_WAIT_L(0); PG8_MMA(0, 1, At, B1); PG8_BAR;
            PG8_LDA(At, 0, 1); PG8_STAGE(PG8_SA(0, 0), a2, vc0);
            PG8_BAR; PG8_WAIT_L(0); PG8_MMA(1, 0, At, B0); PG8_BAR; PG8_SCHED;
            PG8_STAGE(PG8_SB(0, 1), b2 + hstepB, voffB);
            PG8_WAIT_V(6); PG8_BAR; PG8_MMA(1, 1, At, B1); PG8_BAR;
            PG8_LDB(B0, 1, 0); PG8_SCHED; PG8_LDA(At, 1, 0); PG8_STAGE(PG8_SA(0, 1), a2 + hstepA, vc1);
            PG8_WAIT_L(8); PG8_BAR; PG8_WAIT_L(0); PG8_MMA(0, 0, At, B0); PG8_BAR; PG8_SCHED;
            PG8_LDB(B1, 1, 1); PG8_STAGE(PG8_SB(1, 0), b3, voffB);
            PG8_BAR; PG8_WAIT_L(0); PG8_MMA(0, 1, At, B1); PG8_BAR;
            PG8_LDA(At, 1, 1); PG8_STAGE(PG8_SA(1, 0), a3, vc0);
            PG8_BAR; PG8_WAIT_L(0); PG8_MMA(1, 0, At, B0); PG8_BAR; PG8_SCHED;
            PG8_STAGE(PG8_SB(1, 1), b3 + hstepB, voffB);
            PG8_WAIT_V(6); PG8_BAR; PG8_MMA(1, 1, At, B1); PG8_BAR;
            }
        }
        if constexpr (ALIGN_EPI) { if (wr == 0) PG8_BAR; }
        if constexpr (!Epi::AFTER_DRAIN) { const int l2_ = fresh_lane_id();
            Unit ue_ = cur; asm volatile("" : "+s"(ue_.pm), "+s"(ue_.pn), "+s"(ue_.po), "+s"(ue_.lb), "+s"(ue_.nvalid));
            E(acc, ue_, wr, wc, l2_ & 15, l2_ >> 4); S.done(cur); }
        if (!has_next) break;
        if (!(epi_chain<Epi>::value && cur.stage == 0))
#pragma unroll
        for (int a = 0; a < 2; ++a)
#pragma unroll
            for (int b = 0; b < 2; ++b)
#pragma unroll
                for (int m = 0; m < 4; ++m)
#pragma unroll
                    for (int n = 0; n < 2; ++n) acc[a][b][m][n] = (f32x4){0.f, 0.f, 0.f, 0.f};
        cur = nxt; cA = nA; cB = nB; ++ui;

        if constexpr (ALIGN_EPI) { if (wr == 1) PG8_BAR; }
    }
    PG8_WAIT_V(0);
    if constexpr (!ALIGN_EPI) { if (wr == 0) PG8_BAR; }
    PG8_BAR;
    if constexpr (Epi::AFTER_DRAIN) { E.fused(acc, cur, wr, wc, fr, fq, lds, wid, lane); S.done(cur); }
#undef PG8_SA
#undef PG8_SB
#undef PG8_STAGE
#undef PG8_LDA
#undef PG8_LDB
#undef PG8_MMA
#undef PG8_WAIT_V
#undef PG8_WAIT_L
#undef PG8_BAR
#undef PG8_SCHED
}
}

namespace pg8 {
__device__ __forceinline__ float fsigmoid(float x) { return __builtin_amdgcn_rcpf(1.0f + __builtin_amdgcn_exp2f(-1.4426950408889634f * x)); }
__device__ __forceinline__ float bflo(unsigned w) { return __uint_as_float(w << 16); }
__device__ __forceinline__ float bfhi(unsigned w) { return __uint_as_float(w & 0xffff0000u); }
__device__ __forceinline__ u32x4 pack8(const f32x4 a, const f32x4 b) { u32x4 w; w.x = cvt_pk_bf16(a[0], a[1]); w.y = cvt_pk_bf16(a[2], a[3]); w.z = cvt_pk_bf16(b[0], b[1]); w.w = cvt_pk_bf16(b[2], b[3]); return w; }

typedef unsigned long long stat_t;
__device__ __forceinline__ float ld_stat(const stat_t* p) { return (float)(*p) * (1.0f / 16777216.0f); }
__device__ __forceinline__ float rstd_of(const stat_t* ss, int row, float inv_n) { return __builtin_amdgcn_rsqf(ld_stat(ss + row) * inv_n + 1e-6f); }
__device__ __forceinline__ float sumsq8(const f32x4 a, const f32x4 b) { return ((a[0] * a[0] + a[1] * a[1]) + (a[2] * a[2] + a[3] * a[3])) + ((b[0] * b[0] + b[1] * b[1]) + (b[2] * b[2] + b[3] * b[3])); }
__device__ __forceinline__ float xsum32(float x) { auto t = __builtin_amdgcn_permlane32_swap(__float_as_uint(x), __float_as_uint(x), false, false); return __uint_as_float(t[0]) + __uint_as_float(t[1]); }
__device__ __forceinline__ float xsum16(float x) { auto s = __builtin_amdgcn_permlane16_swap(__float_as_uint(x), __float_as_uint(x), false, false); return __uint_as_float(s[0]) + __uint_as_float(s[1]); }
__device__ __forceinline__ float xother32(float x, int hi) { auto t = __builtin_amdgcn_permlane32_swap(__float_as_uint(x), __float_as_uint(x), false, false); return __uint_as_float(hi ? t[0] : t[1]); }
template <int CTRL> __device__ __forceinline__ float dppmov(float x) { return __builtin_bit_cast(float, __builtin_amdgcn_mov_dpp(__builtin_bit_cast(int, x), CTRL, 0xf, 0xf, true)); }
__device__ __forceinline__ float wave_sum64(float v) {
    v += dppmov<0xB1>(v); v += dppmov<0x4E>(v); v += dppmov<0x141>(v); v += dppmov<0x128>(v); v = xsum16(v); return xsum32(v); }
__device__ __forceinline__ void row_atomic(stat_t* dst, float part, int fq) { part = xsum16(part); part = xsum32(part);
    if (fq == 0) __hip_atomic_fetch_add(dst, (stat_t)(part * 16777216.0f + 0.5f), __ATOMIC_RELAXED, __HIP_MEMORY_SCOPE_AGENT); }
struct EpiStore {
    static constexpr bool PERM = true, AFTER_DRAIN = false;
    bf16_t* O; int ldc; const stat_t* css; float cinv;
    __device__ __forceinline__ void operator()(const f32x4 (&acc)[2][2][4][2], const Unit& u, int wr, int wc, int fr, int fq) const {
        const int row0 = u.pm * BM + wr * 64 + fr, col0 = u.pn * BM + wc * 32 + 8 * fq;
        f32x4 cs[2][2];
#pragma unroll
        for (int bj = 0; bj < 2; ++bj)
#pragma unroll
            for (int n = 0; n < 2; ++n)
#pragma unroll
                for (int k = 0; k < 4; ++k) cs[bj][n][k] = css ? rstd_of(css, col0 + bj * HALF + 4 * n + k, cinv) : 1.0f;
#pragma unroll
        for (int ai = 0; ai < 2; ++ai)
#pragma unroll
            for (int m = 0; m < 4; ++m) { bf16_t* rowp = O + (size_t)(row0 + ai * HALF + m * 16) * ldc + col0;
#pragma unroll
                for (int bj = 0; bj < 2; ++bj) *(u32x4*)(rowp + bj * HALF) = pack8(acc[ai][bj][m][0] * cs[bj][0], acc[ai][bj][m][1] * cs[bj][1]); }
    }
};
struct EpiStoreVt {
    static constexpr bool PERM = true, AFTER_DRAIN = false;
    bf16_t* O; const stat_t* css; float cinv;
    __device__ __forceinline__ void operator()(const f32x4 (&acc)[2][2][4][2], const Unit& u, int wr, int wc, int fr, int fq) const {
        const int row0 = u.pm * BM + wr * 64 + fr, col0 = u.pn * BM + wc * 32 + 8 * fq;
        f32x4 cs[2][2];
#pragma unroll
        for (int bj = 0; bj < 2; ++bj)
#pragma unroll
            for (int n = 0; n < 2; ++n)
#pragma unroll
                for (int k = 0; k < 4; ++k) cs[bj][n][k] = rstd_of(css, col0 + bj * HALF + 4 * n + k, cinv);
#pragma unroll
        for (int ai = 0; ai < 2; ++ai)
#pragma unroll
            for (int m = 0; m < 4; ++m) { const int row = row0 + ai * HALF + m * 16;
#pragma unroll
                for (int bj = 0; bj < 2; ++bj) { const int tok = col0 + bj * HALF;
                    const size_t off = ((size_t)((tok >> 12) * 8 + (row >> 6)) * 64 + ((tok & 4095) >> 6)) * 4096 + (size_t)(row & 63) * 64 + (tok & 63);
                    *(u32x4*)(O + off) = pack8(acc[ai][bj][m][0] * cs[bj][0], acc[ai][bj][m][1] * cs[bj][1]); } }
    }
};
struct EpiProj {
    static constexpr bool PERM = true, AFTER_DRAIN = false;
    bf16_t* R2; const stat_t* ssx; stat_t* ssq; stat_t* sskv; bf16_t* halo;
    __device__ __forceinline__ void operator()(const f32x4 (&acc)[2][2][4][2], const Unit& u, int wr, int wc, int fr, int fq) const {
        const int pn = u.pn; size_t off; int ldc, ct; bool sg = false;
        if (pn == 0)      { off = 0;               ldc = 256;  ct = 0; }
        else if (pn == 1) { off = (size_t)8 << 20;  ldc = 256;  ct = 0; }
        else if (pn < 4)  { off = (size_t)16 << 20; ldc = 512;  ct = pn - 2; }
        else if (pn < 6)  { off = (size_t)32 << 20; ldc = 512;  ct = pn - 4; }
        else if (pn < 10) { off = (size_t)48 << 20; ldc = 1024; ct = pn - 6; sg = true; }
        else              { off = (size_t)80 << 20; ldc = 1024; ct = pn - 10; sg = true; }
        const int row0 = u.pm * BM + wr * 64 + fr, col0 = ct * BM + wc * 32 + 8 * fq;
        bf16_t* O = R2 + off;
        bf16_t* gp = O + ((size_t)((u.pm * 4 + ct) * 8 + wr * 4 + wc) * 1024 + fq * 16 + fr) * 8;
        float rsv[2][4];
#pragma unroll
        for (int ai = 0; ai < 2; ++ai)
#pragma unroll
            for (int m = 0; m < 4; ++m) rsv[ai][m] = rstd_of(ssx, row0 + ai * HALF + m * 16, 1.0f / 1024.0f);
        asm volatile("" : "+v"(rsv[0][0]), "+v"(rsv[0][1]), "+v"(rsv[0][2]), "+v"(rsv[0][3]), "+v"(rsv[1][0]), "+v"(rsv[1][1]), "+v"(rsv[1][2]), "+v"(rsv[1][3]));
#pragma unroll
        for (int ai = 0; ai < 2; ++ai)
#pragma unroll
            for (int m = 0; m < 4; ++m) { const int row = row0 + ai * HALF + m * 16; bf16_t* rowp = O + (size_t)row * ldc + col0;
                const float rs = rsv[ai][m];
                f32x4 v[2][2];
#pragma unroll
                for (int bj = 0; bj < 2; ++bj) { v[bj][0] = acc[ai][bj][m][0] * rs; v[bj][1] = acc[ai][bj][m][1] * rs; }
                if (pn == 0) row_atomic(ssq + row, sumsq8(v[0][0], v[0][1]) + sumsq8(v[1][0], v[1][1]), fq);
                if (pn == 1) row_atomic(sskv + row, sumsq8(v[0][0], v[0][1]), fq);
#pragma unroll
                for (int bj = 0; bj < 2; ++bj) {
                    if (sg) {
                        f32x4 t0, t1;
#pragma unroll
                        for (int k = 0; k < 4; ++k) { t0[k] = __builtin_amdgcn_exp2f(-v[bj][0][k]); t1[k] = __builtin_amdgcn_exp2f(-v[bj][1][k]); }
                        t0 = t0 + 1.0f; t1 = t1 + 1.0f;
#pragma unroll
                        for (int k = 0; k < 4; ++k) { v[bj][0][k] = __builtin_amdgcn_rcpf(t0[k]); v[bj][1][k] = __builtin_amdgcn_rcpf(t1[k]); } }
                    const u32x4 pk = pack8(v[bj][0], v[bj][1]); *(u32x4*)(sg ? gp + (ai * 8 + m * 2 + bj) * 512 : rowp + bj * HALF) = pk;
                    if ((pn == 2 || pn == 3) && (row & 127) >= 125) *(u32x4*)(halo + ((size_t)(row >> 7) * 3 + (row & 127) - 125) * 512 + col0 + bj * HALF) = pk; } }
    }
};
struct EpiMerge {
    static constexpr bool PERM = true, AFTER_DRAIN = false, CHAIN = true;
    const bf16_t* Ga; const bf16_t* Gb; bf16_t* O;
    __device__ __forceinline__ void operator()(f32x4 (&acc)[2][2][4][2], const Unit& u, int wr, int wc, int fr, int fq) const {
        const int row0 = u.pm * BM + wr * 64 + fr, col0 = u.pn * BM + wc * 32 + 8 * fq;
        const float FLOOR = 8.6736174e-19f;
        const size_t g0 = ((size_t)((u.pm * 4 + u.pn) * 8 + wr * 4 + wc) * 1024 + fq * 16 + fr) * 8;
#define PIN8(a) asm volatile("" : "+v"(a[0][0]), "+v"(a[0][1]), "+v"(a[1][0]), "+v"(a[1][1]), "+v"(a[2][0]), "+v"(a[2][1]), "+v"(a[3][0]), "+v"(a[3][1]))
#pragma unroll
        for (int ai = 0; ai < 2; ++ai) {
            u32x4 gbv[4][2], gav[4][2];
#pragma unroll
            for (int m = 0; m < 4; ++m)
#pragma unroll
                for (int bj = 0; bj < 2; ++bj) { const size_t go = g0 + (ai * 8 + m * 2 + bj) * 512; gbv[m][bj] = *(const u32x4*)(Gb + go); if (u.stage == 0) gav[m][bj] = *(const u32x4*)(Ga + go); }
            PIN8(gbv); if (u.stage == 0) PIN8(gav);
#pragma unroll
            for (int m = 0; m < 4; ++m) { const size_t ro = (size_t)(row0 + ai * HALF + m * 16) * 1024 + col0;
#pragma unroll
                for (int bj = 0; bj < 2; ++bj) { const u32x4 gb = gbv[m][bj];
                    float sb[8] = {bflo(gb.x), bfhi(gb.x), bflo(gb.y), bfhi(gb.y), bflo(gb.z), bfhi(gb.z), bflo(gb.w), bfhi(gb.w)};
#pragma unroll
                    for (int k = 0; k < 8; ++k) sb[k] = fmaxf(sb[k], FLOOR);
                    if (u.stage == 0) { const u32x4 ga = gav[m][bj];
                        const float sa[8] = {bflo(ga.x), bfhi(ga.x), bflo(ga.y), bfhi(ga.y), bflo(ga.z), bfhi(ga.z), bflo(ga.w), bfhi(ga.w)};
#pragma unroll
                        for (int k = 0; k < 4; ++k) { acc[ai][bj][m][0][k] *= sa[k] * __builtin_amdgcn_rcpf(sb[k]); acc[ai][bj][m][1][k] *= sa[4 + k] * __builtin_amdgcn_rcpf(sb[4 + k]); }
                    } else { f32x4 v0 = acc[ai][bj][m][0], v1 = acc[ai][bj][m][1];
#pragma unroll
                        for (int k = 0; k < 4; ++k) { v0[k] *= sb[k]; v1[k] *= sb[4 + k]; }
                        *(u32x4*)(O + ro + bj * HALF) = pack8(v0, v1); } } } }
    }
};
struct MergeOrder {
    static constexpr bool GATHER = false;
    StaticOrder S; size_t aoff1, boff1;
    __device__ __forceinline__ bool next(int i, Unit& u) const { if (!S.next(i >> 1, u)) return false; if (i & 1) { u.stage = 1; u.aoff = aoff1; u.boff = boff1; } return true; }
    __device__ __forceinline__ u32x4 rows(const Unit&, int, int) const { return (u32x4){0u, 0u, 0u, 0u}; }
    __device__ __forceinline__ void a_ready(const Unit&) const {}
    __device__ __forceinline__ void done(const Unit&) const {}
};
constexpr int XRP = 2048;
struct EpiResid {
    static constexpr bool PERM = true, AFTER_DRAIN = false;
    const float* base32; bf16_t* xr; unsigned char* x8; stat_t* ss;
    __device__ __forceinline__ void operator()(const f32x4 (&acc)[2][2][4][2], const Unit& u, int wr, int wc, int fr, int fq) const {
        const int row0 = u.pm * BM + wr * 64 + fr, col0 = u.pn * BM + wc * 32 + 8 * fq;
#pragma unroll
        for (int ai = 0; ai < 2; ++ai)
#pragma unroll
          for (int mh = 0; mh < 2; ++mh) {
            u32x4 wv[2][2]; f32x4 b0v[2][2], b1v[2][2];
#define PIN4(a) asm volatile("" : "+v"(a[0][0]), "+v"(a[0][1]), "+v"(a[1][0]), "+v"(a[1][1]))
            if (base32) {
#pragma unroll
                for (int mm = 0; mm < 2; ++mm)
#pragma unroll
                    for (int bj = 0; bj < 2; ++bj) { const size_t ro = (size_t)(row0 + ai * HALF + (2 * mh + mm) * 16) * 1024 + col0 + bj * HALF; b0v[mm][bj] = *(const f32x4*)(base32 + ro); b1v[mm][bj] = *(const f32x4*)(base32 + ro + 4); }
                PIN4(b0v); PIN4(b1v);
            } else {
#pragma unroll
                for (int mm = 0; mm < 2; ++mm)
#pragma unroll
                    for (int bj = 0; bj < 2; ++bj) wv[mm][bj] = *(const u32x4*)(xr + (size_t)(row0 + ai * HALF + (2 * mh + mm) * 16) * XRP + col0 + bj * HALF);
                PIN4(wv);
            }
#undef PIN4
#pragma unroll
            for (int mm = 0; mm < 2; ++mm) { const int m = 2 * mh + mm; const int row = row0 + ai * HALF + m * 16; const size_t ro = (size_t)row * 1024 + col0, rx = (size_t)row * XRP + col0; float part = 0.f;
#pragma unroll
                for (int bj = 0; bj < 2; ++bj) { f32x4 b0, b1;
                    if (base32) { b0 = b0v[mm][bj]; b1 = b1v[mm][bj]; }
                    else { const u32x4 w = wv[mm][bj]; b0 = (f32x4){bflo(w.x), bfhi(w.x), bflo(w.y), bfhi(w.y)}; b1 = (f32x4){bflo(w.z), bfhi(w.z), bflo(w.w), bfhi(w.w)}; }
                    const f32x4 o0 = b0 + acc[ai][bj][m][0], o1 = b1 + acc[ai][bj][m][1];
                    *(u32x4*)(xr + rx + bj * HALF) = pack8(o0, o1);
                    if (ss) part += sumsq8(o0, o1);
                    if (x8) { f32x2 w; int lo = __builtin_amdgcn_cvt_pk_fp8_f32(o0[0], o0[1], 0, false); lo = __builtin_amdgcn_cvt_pk_fp8_f32(o0[2], o0[3], lo, true);
                              int hi = __builtin_amdgcn_cvt_pk_fp8_f32(o1[0], o1[1], 0, false); hi = __builtin_amdgcn_cvt_pk_fp8_f32(o1[2], o1[3], hi, true);
                              w[0] = __builtin_bit_cast(float, lo); w[1] = __builtin_bit_cast(float, hi); *(f32x2*)(x8 + ro + bj * HALF) = w; } }
                if (ss) row_atomic(ss + row, part, fq); } }
    }
};
struct EpiSwiglu {
    static constexpr bool PERM = true, AFTER_DRAIN = false;
    bf16_t* O; int ldc; const stat_t* ssx; int f8;
    __device__ __forceinline__ void operator()(const f32x4 (&acc)[2][2][4][2], const Unit& u, int wr, int wc, int fr, int fq) const {
        const int row0 = u.po * BM + wr * 64 + fr, col0 = u.pn * HALF + wc * 32 + 8 * fq;
        float rsv[2][4];
        if (ssx) {
#pragma unroll
            for (int ai = 0; ai < 2; ++ai)
#pragma unroll
                for (int m = 0; m < 4; ++m) rsv[ai][m] = rstd_of(ssx, row0 + ai * HALF + m * 16, 1.0f / 1024.0f);
            asm volatile("" : "+v"(rsv[0][0]), "+v"(rsv[0][1]), "+v"(rsv[0][2]), "+v"(rsv[0][3]), "+v"(rsv[1][0]), "+v"(rsv[1][1]), "+v"(rsv[1][2]), "+v"(rsv[1][3]));
        }
#pragma unroll
        for (int ai = 0; ai < 2; ++ai)
#pragma unroll
            for (int m = 0; m < 4; ++m) { const int row = row0 + ai * HALF + m * 16;
                f32x4 g0 = acc[ai][0][m][0], g1 = acc[ai][0][m][1], p0 = acc[ai][1][m][0], p1 = acc[ai][1][m][1];
                if (ssx) { const float rs = rsv[ai][m]; g0 = g0 * rs; g1 = g1 * rs; p0 = p0 * rs; p1 = p1 * rs; }
                f32x4 t0, t1;
#pragma unroll
                for (int k = 0; k < 4; ++k) { t0[k] = __builtin_amdgcn_exp2f(-g0[k]); t1[k] = __builtin_amdgcn_exp2f(-g1[k]); }
                t0 = t0 + 1.0f; t1 = t1 + 1.0f; p0 = p0 * g0; p1 = p1 * g1;
#pragma unroll
                for (int k = 0; k < 4; ++k) { t0[k] = __builtin_amdgcn_rcpf(t0[k]); t1[k] = __builtin_amdgcn_rcpf(t1[k]); }
                const f32x4 v0 = p0 * t0, v1 = p1 * t1;
                if (f8) { int lo = __builtin_amdgcn_cvt_pk_fp8_f32(v0[0], v0[1], 0, false); lo = __builtin_amdgcn_cvt_pk_fp8_f32(v0[2], v0[3], lo, true);
                          int hi = __builtin_amdgcn_cvt_pk_fp8_f32(v1[0], v1[1], 0, false); hi = __builtin_amdgcn_cvt_pk_fp8_f32(v1[2], v1[3], hi, true);
                          f32x2 w; w[0] = __builtin_bit_cast(float, lo); w[1] = __builtin_bit_cast(float, hi); *(f32x2*)((unsigned char*)O + (size_t)row * ldc + col0) = w; }
                else *(u32x4*)(O + (size_t)row * ldc + col0) = pack8(v0, v1); }
    }
};
struct EpiMoeDown {
    static constexpr bool PERM = true, AFTER_DRAIN = false;
    bf16_t* Y; const float* list_w; bf16_t* Y2;
    __device__ __forceinline__ void operator()(const f32x4 (&acc)[2][2][4][2], const Unit& u, int wr, int wc, int fr, int fq) const {
        const int rl0 = wr * 64 + fr, col0 = u.pn * BM + wc * 32 + 8 * fq;
        bf16_t* base = u.stage ? Y2 + (size_t)(u.po - 256) * BM * 1024 : Y + (size_t)u.po * BM * 1024;
#pragma unroll
        for (int ai = 0; ai < 2; ++ai) { float wv[4];
#pragma unroll
            for (int m = 0; m < 4; ++m) { const int rl = rl0 + ai * HALF + m * 16; wv[m] = (rl < u.nvalid) ? list_w[u.lb + rl] : 0.f; }
#pragma unroll
            for (int m = 0; m < 4; ++m) { const int rl = rl0 + ai * HALF + m * 16; const float w = wv[m];
                bf16_t* rowp = base + (size_t)rl * 1024 + col0;
#pragma unroll
                for (int bj = 0; bj < 2; ++bj) *(u32x4*)(rowp + bj * HALF) = pack8(acc[ai][bj][m][0] * w, acc[ai][bj][m][1] * w); } }
    }
};
template <bool GATH> struct MoeOrder {
    static constexpr bool GATHER = GATH;
    int t0, t1, nN, G, c; int ts1, ts2, ts3, ts4, ts5, ts6, ts7; int c0, c1, c2, c3, c4, c5, c6, c7; const int* list_tok; size_t bstride; int ntok; int ksplit_tiles; size_t ksplit_bytes;
    __device__ __forceinline__ void init(const unsigned* cntp, int chunk, int nN_, int G_, int c_, const int* lt, size_t bstride_, int ntok_, int ksplit_tiles_ = 0, size_t ksplit_bytes_ = 0) {
        ksplit_tiles = ksplit_tiles_; ksplit_bytes = ksplit_bytes_;
#define MO_LD(e) __builtin_amdgcn_readfirstlane((int)__hip_atomic_load(cntp + (e), __ATOMIC_RELAXED, __HIP_MEMORY_SCOPE_AGENT))
#define MO_NT(x) (((x) + BM - 1) / BM)
        c0 = MO_LD(0); c1 = MO_LD(1); c2 = MO_LD(2); c3 = MO_LD(3); c4 = MO_LD(4); c5 = MO_LD(5); c6 = MO_LD(6); c7 = MO_LD(7);
        ts1 = MO_NT(c0); ts2 = ts1 + MO_NT(c1); ts3 = ts2 + MO_NT(c2); ts4 = ts3 + MO_NT(c3); ts5 = ts4 + MO_NT(c4); ts6 = ts5 + MO_NT(c5); ts7 = ts6 + MO_NT(c6); const int a = ts7 + MO_NT(c7);
#undef MO_LD
#undef MO_NT
        if (chunk < 0) { t0 = 0; t1 = a; }   else { t0 = chunk * 128 < a ? chunk * 128 : a; t1 = (chunk == 0) ? (128 < a ? 128 : a) : a; }          nN = nN_; G = G_; c = c_; list_tok = lt; bstride = bstride_; ntok = ntok_;
    }
    __device__ __forceinline__ bool next(int i, Unit& u) const {
        const int ntl = t1 - t0, nleft = (ksplit_tiles && t1 > 256) ? t1 - (t0 > 256 ? t0 : 256) : 0, nfull = ntl - nleft;
        const int ufull = nfull * nN, nunits = ufull + nleft * nN * 2; const int L = i * G + c; if (L >= nunits) return false;
        int tl, half = 0; bool split = false;
        if (L < ufull) { int wgid = (int)L; { const int q = ufull / NXCD, r = ufull % NXCD, xcd = wgid % NXCD, off = wgid / NXCD; wgid = (xcd < r ? xcd * (q + 1) : r * (q + 1) + (xcd - r) * q) + off; }
            tl = wgid / nN; u.pn = wgid % nN; }
        else { const int s = (int)L - ufull; tl = nfull + s / (2 * nN); u.pn = (s >> 1) % nN; half = s & 1; split = true; }
        const int t = t0 + tl;
        const int a1 = ts1, a2 = ts2, a3 = ts3, a4 = ts4, a5 = ts5, a6 = ts6, a7 = ts7, k0 = c0, k1 = c1, k2 = c2, k3 = c3, k4 = c4, k5 = c5, k6 = c6, k7 = c7;
        const int e = (t >= a1) + (t >= a2) + (t >= a3) + (t >= a4) + (t >= a5) + (t >= a6) + (t >= a7);
        const int tse = t >= a7 ? a7 : t >= a6 ? a6 : t >= a5 ? a5 : t >= a4 ? a4 : t >= a3 ? a3 : t >= a2 ? a2 : t >= a1 ? a1 : 0;
        const int ce = t >= a7 ? k7 : t >= a6 ? k6 : t >= a5 ? k5 : t >= a4 ? k4 : t >= a3 ? k3 : t >= a2 ? k2 : t >= a1 ? k1 : k0;
        const int rb = (t - tse) * BM; int nv = ce - rb; nv = nv > BM ? BM : nv;
        u.pm = tl; u.po = GATH ? tl : t; u.lb = e * ntok + rb; u.nvalid = nv; u.stage = half; u.ntu = split ? ksplit_tiles : 0; u.aoff = (size_t)half * ksplit_bytes; u.boff = (size_t)e * bstride + (size_t)half * ksplit_bytes; return true;
    }
    __device__ __forceinline__ u32x4 rows(const Unit& u, int tid, int ldab) const {
        unsigned o[4];
#pragma unroll
        for (int i = 0; i < 2; ++i) { int R, C; stage_rc(tid * 16 + i * 8192, R, C); const int r0 = R, r1 = HALF + R;
            const int k0 = (r0 < u.nvalid) ? list_tok[u.lb + r0] : 0, k1 = (r1 < u.nvalid) ? list_tok[u.lb + r1] : 0;
            o[i] = (unsigned)(k0 * ldab + C * 2); o[2 + i] = (unsigned)(k1 * ldab + C * 2); }
        return (u32x4){o[0], o[1], o[2], o[3]};
    }
    __device__ __forceinline__ void a_ready(const Unit&) const {}
    __device__ __forceinline__ void done(const Unit&) const {}
};
}
#define GAS __attribute__((address_space(1)))
#define LAS __attribute__((address_space(3)))
typedef unsigned short bf16;
typedef unsigned v4u __attribute__((ext_vector_type(4)));
typedef float f32x4 __attribute__((ext_vector_type(4)));
typedef short bf16x8 __attribute__((ext_vector_type(8)));
typedef GAS unsigned gu32;
typedef GAS unsigned long long gu64;
#define RLX_AGENT __ATOMIC_RELAXED, __HIP_MEMORY_SCOPE_AGENT
#define LDS_WAIT() asm volatile("s_waitcnt lgkmcnt(0)" ::: "memory")
#define VM_WAIT() asm volatile("s_waitcnt vmcnt(0)" ::: "memory")
__device__ __forceinline__ unsigned long long rt() { return __builtin_amdgcn_s_memrealtime(); }
__device__ __forceinline__ unsigned f2bf(float f) { unsigned u = __builtin_bit_cast(unsigned, f); return (u + 0x7fffu + ((u >> 16) & 1u)) >> 16; }
__device__ __forceinline__ unsigned pk2(float lo, float hi) { return f2bf(lo) | (f2bf(hi) << 16); }

#define XB_TMO      128
#define XB_XCNT(j)  (256  + 64 * (j))
#define XB_XSUB(j)  (1280 + 64 * (j))
#define XB_XGEN(j)  (2304 + 64 * (j))
#define XB_TOP      3328
#define XB_TOPGEN   3392
#define XCD_BAR_WORDS 3456
#define XB_SPIN_CAP (1u << 18)

__device__ __forceinline__ unsigned xb_ld(unsigned* p)              { return __hip_atomic_load(p, __ATOMIC_RELAXED, __HIP_MEMORY_SCOPE_AGENT); }
__device__ __forceinline__ unsigned xb_add(unsigned* p, unsigned v) { return __hip_atomic_fetch_add(p, v, __ATOMIC_RELAXED, __HIP_MEMORY_SCOPE_AGENT); }
__device__ __forceinline__ unsigned xb_xcc_id() { return (unsigned)__builtin_amdgcn_s_getreg((3 << 11) | 20) & 0xFu; }
#define XB_SPIN(cond, bar) do { unsigned _sp = 0; while (cond) { __builtin_amdgcn_s_sleep(1); \
    if ((++_sp & 255u) == 0u) { if (xb_ld(&(bar)[XB_TMO])) break; if (_sp > XB_SPIN_CAP) { atomicAdd(&(bar)[XB_TMO], 1u); break; } } } } while (0)

struct XcdBarrier {
    unsigned* bar; unsigned x;
    volatile LAS unsigned* st;
};

__device__ __forceinline__ XcdBarrier xcd_barrier_post(unsigned* bar, volatile LAS unsigned* st) {
    XcdBarrier b; b.bar = bar; b.x = xb_xcc_id(); b.st = st;
    if (threadIdx.x == 0) (void)xb_add(&bar[XB_XCNT(b.x)], 1u);
    return b;
}
__device__ __forceinline__ void xcd_barrier_complete(unsigned* bar, unsigned x, unsigned& nloc, unsigned& nx) {
    const unsigned G = gridDim.x * gridDim.y * gridDim.z;
    unsigned sum, cnt, sp = 0u;
    for (;;) {
        sum = 0u; cnt = 0u;
#pragma unroll
        for (unsigned j = 0; j < 16; ++j) { const unsigned c = xb_ld(&bar[XB_XCNT(j)]); sum += c; cnt += (c > 0u) ? 1u : 0u; }
        if (sum == G) break;
        __builtin_amdgcn_s_sleep(1);
        if ((++sp & 255u) == 0u) { if (xb_ld(&bar[XB_TMO])) break; if (sp > XB_SPIN_CAP) { atomicAdd(&bar[XB_TMO], 1u); break; } }
    }
    const unsigned mine = xb_ld(&bar[XB_XCNT(x)]);
    nloc = mine > 0u ? mine : 1u; nx = cnt > 0u ? cnt : 1u;
}

__device__ __forceinline__ void xcd_barrier_census(const XcdBarrier& b) { unsigned nloc, nx; xcd_barrier_complete(b.bar, b.x, nloc, nx); b.st[0] = nloc; b.st[1] = nx; }
__device__ __forceinline__ void xcd_barrier(const XcdBarrier& b, const bool is_thread0  ) {
    asm volatile("s_waitcnt vmcnt(0)" ::: "memory");
    __syncthreads();
    if (is_thread0) {
        unsigned* bar = b.bar;
        __builtin_amdgcn_s_waitcnt(0);
        unsigned nloc = b.st[0], nx = b.st[1];
        const unsigned old = xb_add(&bar[XB_XSUB(b.x)], 1u);
        const unsigned gen = old / nloc;
        if (old + 1u == (gen + 1u) * nloc) {
            __builtin_amdgcn_fence(__ATOMIC_RELEASE, "agent");
            asm volatile("s_waitcnt vmcnt(0)" ::: "memory");
            const unsigned og = xb_add(&bar[XB_TOP], 1u);
            const unsigned tg = og / nx;
            if (og + 1u == (tg + 1u) * nx) xb_add(&bar[XB_TOPGEN], 1u);
            else XB_SPIN(xb_ld(&bar[XB_TOPGEN]) == tg, bar);
            __builtin_amdgcn_fence(__ATOMIC_ACQUIRE, "agent");
            xb_add(&bar[XB_XGEN(b.x)], 1u);
            asm volatile("s_waitcnt vmcnt(0)" ::: "memory");
        } else {
            XB_SPIN(xb_ld(&bar[XB_XGEN(b.x)]) == gen, bar);
            __builtin_amdgcn_fence(__ATOMIC_ACQUIRE, "agent");
            asm volatile("s_waitcnt vmcnt(0)" ::: "memory");
        }
    }
    __syncthreads();
}

typedef unsigned v2u __attribute__((ext_vector_type(2)));
typedef float f32x2v __attribute__((ext_vector_type(2)));
struct Frame {
    LAS unsigned char* lds;
    int tid, lane, wave;
    int vcu, G;
    int gw, ngw;
};
__device__ __forceinline__ float wave_sum(float v) { return pg8::wave_sum64(v); }
__device__ __forceinline__ float bf2f(unsigned short b) { return __uint_as_float((unsigned)b << 16); }
__device__ __forceinline__ float bflo(unsigned w) { return __uint_as_float(w << 16); }
__device__ __forceinline__ float bfhi(unsigned w) { return __uint_as_float(w & 0xffff0000u); }
__device__ __forceinline__ float fsigmoid(float x) { return __builtin_amdgcn_rcpf(1.0f + __builtin_amdgcn_exp2f(-1.4426950408889634f * x)); }

__device__ __forceinline__ unsigned pk4_fp8(float a, float b, float c, float d) { int r = __builtin_amdgcn_cvt_pk_fp8_f32(a, b, 0, false); r = __builtin_amdgcn_cvt_pk_fp8_f32(c, d, r, true); return (unsigned)r; }
template <bool F8> __device__ __forceinline__ void tr_item(const float* W, int ldw, int k0, int c0, bf16* WTrow0, int ldt, LAS float* scr, int lane, const float* gk, float wmul) {
    f32x4 ld[8]; const int lr = lane >> 3, lc = (lane & 7) * 4;
#pragma unroll
    for (int i = 0; i < 8; ++i) ld[i] = *(const GAS f32x4*)(W + (size_t)(k0 + 8 * i + lr) * ldw + c0 + lc);
#pragma unroll
    for (int i = 0; i < 8; ++i) { LAS float* d = scr + (8 * i + lr) * 33 + lc; d[0] = ld[i].x; d[1] = ld[i].y; d[2] = ld[i].z; d[3] = ld[i].w; }
    LDS_WAIT(); asm volatile("" ::: "memory");
    const int c = lane & 7;
    f32x4 g0 = (f32x4){1.f, 1.f, 1.f, 1.f}, g1 = g0;
    if (gk) { g0 = *(const GAS f32x4*)(gk + k0 + 8 * c); g1 = *(const GAS f32x4*)(gk + k0 + 8 * c + 4); }
    g0 = g0 * wmul; g1 = g1 * wmul;
#pragma unroll
    for (int j = 0; j < 4; ++j) { const int n = (lane >> 3) + 8 * j; const LAS float* s = scr + (8 * c) * 33 + n;
        if constexpr (F8) {
            v2u o; o.x = pk4_fp8(s[0 * 33] * g0.x, s[1 * 33] * g0.y, s[2 * 33] * g0.z, s[3 * 33] * g0.w); o.y = pk4_fp8(s[4 * 33] * g1.x, s[5 * 33] * g1.y, s[6 * 33] * g1.z, s[7 * 33] * g1.w);
            *(GAS v2u*)((unsigned char*)WTrow0 + (size_t)n * ldt + k0 + 8 * c) = o;
        } else {
        v4u o; o.x = pk2(s[0 * 33] * g0.x, s[1 * 33] * g0.y); o.y = pk2(s[2 * 33] * g0.z, s[3 * 33] * g0.w); o.z = pk2(s[4 * 33] * g1.x, s[5 * 33] * g1.y); o.w = pk2(s[6 * 33] * g1.z, s[7 * 33] * g1.w);
        *(GAS v4u*)(WTrow0 + (size_t)n * ldt + k0 + 8 * c) = o; } }
    LDS_WAIT(); asm volatile("" ::: "memory");
}
template <bool F8 = false, class Map> __device__ __forceinline__ void convert_matrix(const Frame& F, int& rot, const float* W, int ldw, int K, int ncb, bf16* WT, int ldt, Map map, const float* gk = nullptr, float wmul = 1.0f) {
    LAS float* scr = (LAS float*)(F.lds + F.wave * 16384);
    const int nkb = K / 64, nitems = nkb * ncb;
    int first = F.gw - rot; if (first < 0) first += F.ngw;
    rot = (rot + nitems) % F.ngw;
    for (int it = first; it < nitems; it += F.ngw) { const int kb = it / ncb, cb = it % ncb; const int r0 = map(cb); if (r0 < 0) continue;
        tr_item<F8>(W, ldw, 64 * kb, 32 * cb, F8 ? (bf16*)((unsigned char*)WT + (size_t)r0 * ldt) : WT + (size_t)r0 * ldt, ldt, scr, F.lane, gk, wmul); }
}
__device__ __forceinline__ void zero_rows(const Frame& F, bf16* WT, int ldt, int r0, int nrows) {
    const int per_row = ldt / 8; const int n = nrows * per_row;
    for (int i = F.gw * 64 + F.lane; i < n; i += F.ngw * 64) { const int r = i / per_row, c = i % per_row; *(GAS v4u*)(WT + (size_t)(r0 + r) * ldt + c * 8) = (v4u){0u, 0u, 0u, 0u}; }
}
__constant__ double ROPE_INVF[16] = {1.0, 0.5623413251903491, 0.31622776601683794, 0.1778279410038923, 0.1, 0.05623413251903491, 0.03162277660168379, 0.01778279410038923,
    0.01, 0.005623413251903491, 0.0031622776601683794, 0.0017782794100389228, 0.001, 0.0005623413251903491, 0.00031622776601683794, 0.00017782794100389227};

template <bool F8> __device__ __forceinline__ void xcast_rows(const Frame& F, const float* x, bf16* xb, pg8::stat_t* ss) {
    for (int m0 = F.gw; m0 < NTOK; m0 += 4 * F.ngw) {
        f32x4 v[4][4]; int mk[4];
#pragma unroll
        for (int k = 0; k < 4; ++k) { const int m = m0 + k * F.ngw; mk[k] = m < NTOK ? m : m0; const GAS f32x4* xr = (const GAS f32x4*)(x + (size_t)mk[k] * DM) + F.lane;
#pragma unroll
            for (int j = 0; j < 4; ++j) v[k][j] = xr[64 * j]; }
#pragma unroll
        for (int k = 0; k < 4; ++k) { if (k > 0 && mk[k] == m0) continue; float s = 0.f;
            GAS unsigned long long* o8 = (GAS unsigned long long*)(xb + (size_t)mk[k] * DM) + F.lane;
#pragma unroll
            for (int j = 0; j < 4; ++j) { const f32x4 w = v[k][j]; s += (w.x * w.x + w.y * w.y) + (w.z * w.z + w.w * w.w);
                if constexpr (F8) ((GAS unsigned*)((unsigned char*)xb + (size_t)mk[k] * DM))[64 * j + F.lane] = pk4_fp8(w.x, w.y, w.z, w.w);
                else o8[64 * j] = (unsigned long long)pk2(w.x, w.y) | ((unsigned long long)pk2(w.z, w.w) << 32); }
            s = wave_sum(s); if (F.lane == 0) ss[mk[k]] = (pg8::stat_t)(s * 16777216.0f + 0.5f); }
    }
}
struct RouterOut { unsigned* cnt; int* list_tok; float* list_w; int* slot; };
__device__ __forceinline__ void router_flush(int lane, int nrows, int se0, int se1, float sw0, float sw1, int stok, const RouterOut& R) {
    const bool valid = lane < nrows; const unsigned long long lt = (1ull << lane) - 1ull;
#pragma unroll
    for (int e = 0; e < 8; ++e) {
        const bool h0 = valid && se0 == e, h1 = valid && se1 == e;
        const unsigned long long m0 = __ballot(h0), m1 = __ballot(h1);
        const int c0 = __popcll(m0), c = c0 + __popcll(m1);
        int base = 0; if (lane == 0 && c) base = (int)__hip_atomic_fetch_add(R.cnt + e, (unsigned)c, __ATOMIC_RELAXED, __HIP_MEMORY_SCOPE_AGENT);
        base = __builtin_amdgcn_readfirstlane(base);
        if (h0) { const int pos = base + __popcll(m0 & lt); R.list_tok[e * NTOK + pos] = stok; R.list_w[e * NTOK + pos] = sw0; R.slot[2 * stok] = e * NTOK + pos; }
        if (h1) { const int pos = base + c0 + __popcll(m1 & lt); R.list_tok[e * NTOK + pos] = stok; R.list_w[e * NTOK + pos] = sw1; R.slot[2 * stok + 1] = e * NTOK + pos; }
    }
}
template <bool ROUTER> __device__ __forceinline__ void norm_rows(const Frame& F, const float* x, const float* g, bf16* out, const float* router, const RouterOut R) {
    int nbuf = 0, se0 = 0, se1 = 0, stok = 0; float sw0 = 0.f, sw1 = 0.f;
    for (int m = F.gw; m < NTOK; m += F.ngw) {
        f32x4 v[4]; float s = 0.f;
        if constexpr (ROUTER) {
            const GAS v2u* xr = (const GAS v2u*)((const bf16*)x + (size_t)m * pg8::XRP) + F.lane;
#pragma unroll
            for (int j = 0; j < 4; ++j) { const v2u w = xr[64 * j]; v[j] = (f32x4){bflo(w.x), bfhi(w.x), bflo(w.y), bfhi(w.y)}; }
        } else { const GAS f32x4* xr = (const GAS f32x4*)(x + (size_t)m * DM) + F.lane;
#pragma unroll
            for (int j = 0; j < 4; ++j) v[j] = xr[64 * j]; }
#pragma unroll
        for (int j = 0; j < 4; ++j) s += (v[j].x * v[j].x + v[j].y * v[j].y) + (v[j].z * v[j].z + v[j].w * v[j].w);
        const float rstd = 1.0f / sqrtf(wave_sum(s) * (1.0f / DM) + EPS);
        GAS unsigned long long* o8 = (GAS unsigned long long*)(out + (size_t)m * DM) + F.lane;
#pragma unroll
        for (int j = 0; j < 4; ++j) { const f32x4 gg = *((const GAS f32x4*)g + 64 * j + F.lane); v[j] = v[j] * rstd * gg;
            if constexpr (ROUTER) ((GAS unsigned*)((unsigned char*)out + (size_t)m * DM))[64 * j + F.lane] = pk4_fp8(v[j].x, v[j].y, v[j].z, v[j].w);
            else o8[64 * j] = (unsigned long long)pk2(v[j].x, v[j].y) | ((unsigned long long)pk2(v[j].z, v[j].w) << 32); }
        if constexpr (ROUTER) {
            float lg[8];
#pragma unroll
            for (int e = 0; e < 8; ++e) lg[e] = 0.f;
#pragma unroll
            for (int j = 0; j < 4; ++j)
#pragma unroll
                for (int k = 0; k < 4; ++k) { const int c = 4 * F.lane + 256 * j + k; const f32x4 r0 = *(const GAS f32x4*)(router + (size_t)c * 8), r1 = *(const GAS f32x4*)(router + (size_t)c * 8 + 4);
                    const float hv = v[j][k];
                    lg[0] += hv * r0.x; lg[1] += hv * r0.y; lg[2] += hv * r0.z; lg[3] += hv * r0.w; lg[4] += hv * r1.x; lg[5] += hv * r1.y; lg[6] += hv * r1.z; lg[7] += hv * r1.w; }
#pragma unroll
            for (int e = 0; e < 8; ++e) lg[e] = wave_sum(lg[e]);
            int e0 = 0; float v0 = lg[0];
#pragma unroll
            for (int e = 1; e < 8; ++e) if (lg[e] > v0) { v0 = lg[e]; e0 = e; }
            int e1 = -1; float v1 = -INFINITY;
#pragma unroll
            for (int e = 0; e < 8; ++e) if (e != e0 && lg[e] > v1) { v1 = lg[e]; e1 = e; }
            const float w1 = 1.0f / (1.0f + expf(v0 - v1)), w0 = 1.0f - w1;
            if (F.lane == nbuf) { se0 = e0; se1 = e1; sw0 = w0; sw1 = w1; stok = m; }
            if (++nbuf == 64) { router_flush(F.lane, nbuf, se0, se1, sw0, sw1, stok, R); nbuf = 0; }
        }
    }
    if constexpr (ROUTER) { if (nbuf) router_flush(F.lane, nbuf, se0, se1, sw0, sw1, stok, R); }
}

__device__ __forceinline__ void router_rows(const Frame& F, const bf16* xr_, const float* g, unsigned char* out8, const float* router, const RouterOut R) {
    int nbuf = 0, se0 = 0, se1 = 0, stok = 0; float sw0 = 0.f, sw1 = 0.f;
    for (int m0 = F.gw; m0 < NTOK; m0 += 4 * F.ngw) {
        int mk[4]; f32x4 v[4][4]; float rs[4];
#pragma unroll
        for (int k = 0; k < 4; ++k) { const int m = m0 + k * F.ngw; mk[k] = m < NTOK ? m : m0; }
#pragma unroll
        for (int k = 0; k < 4; ++k) { const GAS v2u* xr = (const GAS v2u*)(xr_ + (size_t)mk[k] * pg8::XRP) + F.lane;
#pragma unroll
            for (int j = 0; j < 4; ++j) { const v2u w = xr[64 * j]; v[k][j] = (f32x4){bflo(w.x), bfhi(w.x), bflo(w.y), bfhi(w.y)}; } }
#pragma unroll
        for (int k = 0; k < 4; ++k) { float s = 0.f;
#pragma unroll
            for (int j = 0; j < 4; ++j) s += (v[k][j].x * v[k][j].x + v[k][j].y * v[k][j].y) + (v[k][j].z * v[k][j].z + v[k][j].w * v[k][j].w);
            rs[k] = 1.0f / sqrtf(wave_sum(s) * (1.0f / DM) + EPS); }
#pragma unroll
        for (int j = 0; j < 4; ++j) { const f32x4 gg = *((const GAS f32x4*)g + 64 * j + F.lane);
#pragma unroll
            for (int k = 0; k < 4; ++k) { v[k][j] = v[k][j] * rs[k] * gg;
                if (k == 0 || mk[k] != m0) ((GAS unsigned*)(out8 + (size_t)mk[k] * DM))[64 * j + F.lane] = pk4_fp8(v[k][j].x, v[k][j].y, v[k][j].z, v[k][j].w); } }
        float lg[4][8];
#pragma unroll
        for (int k = 0; k < 4; ++k)
#pragma unroll
            for (int e = 0; e < 8; ++e) lg[k][e] = 0.f;
#pragma unroll
        for (int j = 0; j < 4; ++j)
#pragma unroll
            for (int kk = 0; kk < 4; ++kk) { const int c = 4 * F.lane + 256 * j + kk; const f32x4 r0 = *(const GAS f32x4*)(router + (size_t)c * 8), r1 = *(const GAS f32x4*)(router + (size_t)c * 8 + 4);
#pragma unroll
                for (int k = 0; k < 4; ++k) { const float hv = v[k][j][kk];
                    lg[k][0] += hv * r0.x; lg[k][1] += hv * r0.y; lg[k][2] += hv * r0.z; lg[k][3] += hv * r0.w; lg[k][4] += hv * r1.x; lg[k][5] += hv * r1.y; lg[k][6] += hv * r1.z; lg[k][7] += hv * r1.w; } }
#pragma unroll
        for (int k = 0; k < 4; ++k) {
            if (k > 0 && mk[k] == m0) continue;
#pragma unroll
            for (int e = 0; e < 8; ++e) lg[k][e] = wave_sum(lg[k][e]);
            int e0 = 0; float v0 = lg[k][0];
#pragma unroll
            for (int e = 1; e < 8; ++e) if (lg[k][e] > v0) { v0 = lg[k][e]; e0 = e; }
            int e1 = -1; float v1 = -INFINITY;
#pragma unroll
            for (int e = 0; e < 8; ++e) if (e != e0 && lg[k][e] > v1) { v1 = lg[k][e]; e1 = e; }
            const float w1 = 1.0f / (1.0f + expf(v0 - v1)), w0 = 1.0f - w1;
            if (F.lane == nbuf) { se0 = e0; se1 = e1; sw0 = w0; sw1 = w1; stok = mk[k]; }
            if (++nbuf == 64) { router_flush(F.lane, nbuf, se0, se1, sw0, sw1, stok, R); nbuf = 0; }
        }
    }
    if (nbuf) router_flush(F.lane, nbuf, se0, se1, sw0, sw1, stok, R);
}

__device__ __forceinline__ void moe_combine(const Frame& F, float* xio, const bf16* Y, const bf16* Y2, const int* slot, const unsigned* cntp) {
    int cnt[8];
#pragma unroll
    for (int e = 0; e < 8; ++e) cnt[e] = __builtin_amdgcn_readfirstlane((int)__hip_atomic_load(cntp + e, __ATOMIC_RELAXED, __HIP_MEMORY_SCOPE_AGENT));
    for (int m0 = F.gw; m0 < NTOK; m0 += 2 * F.ngw) {
        const int m1 = (m0 + F.ngw < NTOK) ? m0 + F.ngw : m0;
        int prow[4];
#pragma unroll
        for (int k = 0; k < 4; ++k) { const int s = slot[2 * (k < 2 ? m0 : m1) + (k & 1)], e = s >> 15, pos = s & (NTOK - 1); int tsv = 0;
#pragma unroll
            for (int j = 0; j < 8; ++j) if (j < e) tsv += (cnt[j] + 255) >> 8;
            prow[k] = tsv * 256 + pos; }
        v2u xv[2][4], a[2][4], b[2][4];
#pragma unroll
        for (int r = 0; r < 2; ++r) { const GAS v2u* xr = (const GAS v2u*)((const bf16*)xio + (size_t)(r ? m1 : m0) * pg8::XRP) + F.lane;
            const GAS v2u* y0 = (const GAS v2u*)(Y + (size_t)prow[2 * r] * DM) + F.lane; const GAS v2u* y1 = (const GAS v2u*)(Y + (size_t)prow[2 * r + 1] * DM) + F.lane;
#pragma unroll
            for (int j = 0; j < 4; ++j) { xv[r][j] = xr[64 * j]; a[r][j] = y0[64 * j]; b[r][j] = y1[64 * j]; } }
#pragma unroll
        for (int k = 0; k < 4; ++k) if (prow[k] >= 65536) {
            const GAS v2u* y2 = (const GAS v2u*)(Y2 + (size_t)(prow[k] - 65536) * DM) + F.lane;
#pragma unroll
            for (int j = 0; j < 4; ++j) { const v2u w = y2[64 * j]; v2u& t = (k & 1) ? b[k >> 1][j] : a[k >> 1][j];
                t.x = pk2(bflo(t.x) + bflo(w.x), bfhi(t.x) + bfhi(w.x)); t.y = pk2(bflo(t.y) + bflo(w.y), bfhi(t.y) + bfhi(w.y)); } }
        asm volatile("s_waitcnt vmcnt(0)" ::: "memory");
#pragma unroll
        for (int r = 0; r < 2; ++r) { if (r == 1 && m1 == m0) break; GAS f32x4* orow = (GAS f32x4*)(xio + (size_t)(r ? m1 : m0) * DM) + F.lane;
#pragma unroll
            for (int j = 0; j < 4; ++j) { const v2u xx = xv[r][j], aa = a[r][j], bb = b[r][j]; f32x4 o;
                o.x = bflo(xx.x) + (bflo(aa.x) + bflo(bb.x)); o.y = bfhi(xx.x) + (bfhi(aa.x) + bfhi(bb.x)); o.z = bflo(xx.y) + (bflo(aa.y) + bflo(bb.y)); o.w = bfhi(xx.y) + (bfhi(aa.y) + bfhi(bb.y)); orow[64 * j] = o; } }
    }
}

__device__ __forceinline__ void qkv_prep(const Frame& F, bf16* cq, bf16* ckv, const float* gq, const float* gkv) {
    for (int m = F.gw; m < NTOK; m += F.ngw) {
        { GAS v2u* p = (GAS v2u*)(cq + (size_t)m * 256) + F.lane; const v2u w = *p;
          float a = bflo(w.x), b = bfhi(w.x), c = bflo(w.y), d = bfhi(w.y);
          const float rstd = 1.0f / sqrtf(wave_sum((a * a + b * b) + (c * c + d * d)) * (1.0f / 256.0f) + EPS);
          const f32x4 gg = *((const GAS f32x4*)gq + F.lane);
          v2u o; o.x = pk2(a * rstd * gg.x, b * rstd * gg.y); o.y = pk2(c * rstd * gg.z, d * rstd * gg.w); *p = o; }
        { GAS v2u* p = (GAS v2u*)(ckv + (size_t)m * 256) + (F.lane & 31); const v2u w = *p;
          float a = bflo(w.x), b = bfhi(w.x), c = bflo(w.y), d = bfhi(w.y);
          const float ss = (F.lane < 32) ? (a * a + b * b) + (c * c + d * d) : 0.f;
          const float rstd = 1.0f / sqrtf(wave_sum(ss) * (1.0f / 128.0f) + EPS);
          const f32x4 gg = *((const GAS f32x4*)gkv + (F.lane & 31));
          v2u o; o.x = pk2(a * rstd * gg.x, b * rstd * gg.y); o.y = pk2(c * rstd * gg.z, d * rstd * gg.w); if (F.lane < 32) *p = o; }
    }
}

template <class Ld> __device__ __forceinline__ void head_process(Ld ld, const float* g, const float* cs, float scale, bf16* dst) {
    float f[12][8];
#pragma unroll
    for (int c = 0; c < 12; ++c) ld(c, f[c]);
    float ss = 0.f;
#pragma unroll
    for (int c = 0; c < 12; ++c)
#pragma unroll
        for (int j = 0; j < 8; ++j) ss += f[c][j] * f[c][j];
    const float rstd = scale / sqrtf(ss * (1.0f / 96.0f) + EPS);
#pragma unroll
    for (int c = 0; c < 8; ++c) {
#pragma unroll
        for (int j = 0; j < 8; ++j) f[c][j] = f[c][j] * rstd * g[8 * c + j];
        v4u o; o.x = pk2(f[c][0], f[c][1]); o.y = pk2(f[c][2], f[c][3]); o.z = pk2(f[c][4], f[c][5]); o.w = pk2(f[c][6], f[c][7]); *(GAS v4u*)(dst + 8 * c) = o; }
#pragma unroll
    for (int c2 = 0; c2 < 2; ++c2) { float oa[8], ob[8];
#pragma unroll
        for (int j = 0; j < 8; ++j) { const float x1 = f[8 + c2][j] * rstd * g[64 + 8 * c2 + j], x2 = f[10 + c2][j] * rstd * g[80 + 8 * c2 + j], cc = cs[8 * c2 + j], sn = cs[16 + 8 * c2 + j];
            oa[j] = x1 * cc - x2 * sn; ob[j] = x2 * cc + x1 * sn; }
        v4u o; o.x = pk2(oa[0], oa[1]); o.y = pk2(oa[2], oa[3]); o.z = pk2(oa[4], oa[5]); o.w = pk2(oa[6], oa[7]); *(GAS v4u*)(dst + 64 + 8 * c2) = o;
        o.x = pk2(ob[0], ob[1]); o.y = pk2(ob[2], ob[3]); o.z = pk2(ob[4], ob[5]); o.w = pk2(ob[6], ob[7]); *(GAS v4u*)(dst + 80 + 8 * c2) = o; }
}
__device__ __forceinline__ void unpack8(const v4u w, float* f) { f[0] = bflo(w.x); f[1] = bfhi(w.x); f[2] = bflo(w.y); f[3] = bfhi(w.y); f[4] = bflo(w.z); f[5] = bfhi(w.z); f[6] = bflo(w.w); f[7] = bfhi(w.w); }
template <int WHICH> __device__ __forceinline__ void qk_post_tile3(const Frame& F, int pm, int pn, const bf16* src, const bf16* ckv, const float* rope, const float* g, bf16* dst, const pg8::stat_t* ss) {
    constexpr int NHT = WHICH == 0 ? 2 : 4, NIT = WHICH == 0 ? 128 : 256, NB = 16;
    static_assert(NIT % (NWAVES * NB) == 0, "whole trips");
    const int lane = F.lane, c = lane & 15, sub = lane >> 4;
    LAS unsigned char* scr = F.lds + F.wave * 8192 + sub * 128;
    float gv[8];
#pragma unroll
    for (int j = 0; j < 8; ++j) gv[j] = c < 12 ? g[8 * c + j] : 0.f;
    const bool ropel = (c & 12) == 8; const float sgn = (c & 2) ? 1.0f : -1.0f; const int ci = 8 * (c & 1);
    const float scale = WHICH == 0 ? QSCALE : 1.0f;
#pragma unroll 1
    for (int it0 = F.wave; it0 < NIT; it0 += NWAVES * NB) {
        v4u wv[NB], rp[NB]; float rlv[NB];
#pragma unroll
        for (int k = 0; k < NB; ++k) { const int it = it0 + k * NWAVES;
            const int trow = WHICH == 0 ? 2 * it + (sub >> 1) : it, hh = WHICH == 0 ? (sub & 1) : sub; const int tok = pm * 256 + trow;
            v4u w = (v4u){0u, 0u, 0u, 0u};
            if (WHICH == 0) w = *(const GAS v4u*)(src + (size_t)tok * 1024 + pn * 256 + hh * 128 + 8 * c);
            else { if (c < 8) w = *(const GAS v4u*)(src + (size_t)tok * 512 + pn * 256 + 64 * hh + 8 * c); else if (c < 12) w = *(const GAS v4u*)(ckv + (size_t)tok * 256 + 128 + 8 * (c - 8)); }
            wv[k] = w;
            rp[k] = *(const GAS v4u*)(rope + (size_t)tok * 32 + 4 * (c & 7));
            rlv[k] = pg8::rstd_of(ss, tok, WHICH == 0 ? 1.0f / 256.0f : 1.0f / 128.0f); }
#pragma unroll
        for (int k = 0; k < NB; ++k) if (c >= 8) *(LAS v4u*)(scr + k * 512 + (c - 8) * 16) = rp[k];
        LDS_WAIT(); asm volatile("" ::: "memory");
#pragma unroll
        for (int k = 0; k < NB; ++k) { const int it = it0 + k * NWAVES;
            const int trow = WHICH == 0 ? 2 * it + (sub >> 1) : it, hh = WHICH == 0 ? (sub & 1) : sub;
            const int tok = pm * 256 + trow, h = pn * NHT + hh, b = tok >> 12, sq_ = tok & (SEQ - 1);
            float f[8]; unpack8(wv[k], f);
            if (WHICH == 0 || c < 8) {
#pragma unroll
                for (int j = 0; j < 8; ++j) f[j] *= rlv[k]; }
            float sq = 0.f;
#pragma unroll
            for (int j = 0; j < 8; ++j) sq += f[j] * f[j];
            sq += pg8::dppmov<0xB1>(sq); sq += pg8::dppmov<0x4E>(sq); sq += pg8::dppmov<0x141>(sq); sq += pg8::dppmov<0x128>(sq);
            const float rstd = scale / sqrtf(sq * (1.0f / 96.0f) + EPS);
            float t[8], o[8];
#pragma unroll
            for (int j = 0; j < 8; ++j) t[j] = f[j] * rstd * gv[j];
            const f32x4 cc0 = *(const LAS f32x4*)(scr + k * 512 + ci * 4), cc1 = *(const LAS f32x4*)(scr + k * 512 + ci * 4 + 16), sn0 = *(const LAS f32x4*)(scr + k * 512 + 64 + ci * 4), sn1 = *(const LAS f32x4*)(scr + k * 512 + 80 + ci * 4);
            const float cs8[8] = {cc0.x, cc0.y, cc0.z, cc0.w, cc1.x, cc1.y, cc1.z, cc1.w}, sn8[8] = {sn0.x, sn0.y, sn0.z, sn0.w, sn1.x, sn1.y, sn1.z, sn1.w};
#pragma unroll
            for (int j = 0; j < 8; ++j) { const float pt = pg8::dppmov<0x4E>(t[j]);
                o[j] = ropel ? t[j] * cs8[j] + sgn * pt * sn8[j] : t[j]; }
            if (c < 12) { v4u ov; ov.x = pk2(o[0], o[1]); ov.y = pk2(o[2], o[3]); ov.z = pk2(o[4], o[5]); ov.w = pk2(o[6], o[7]);
                *(GAS v4u*)(dst + ((size_t)(b * NH + h) * SEQ + sq_) * DQK + 8 * c) = ov; } }
        LDS_WAIT(); asm volatile("" ::: "memory");
    }
}
template <int WHICH> __device__ __forceinline__ void qk_post_tile(const Frame& F, int pm, int pn, const bf16* src, const bf16* ckv, const float* rope, const float* g, bf16* dst, const pg8::stat_t* ss) {
    constexpr int NHT = WHICH == 0 ? 2 : 4;
#pragma unroll 1
    for (int item = F.tid; item < 256 * NHT; item += NWAVES * 64) {
        const int tok = pm * 256 + (item & 255), h = pn * NHT + (item >> 8), b = tok >> 12, s = tok & (SEQ - 1);
        const float* cs = rope + (size_t)tok * 32;
        bf16* d = dst + ((size_t)(b * NH + h) * SEQ + s) * DQK;
        if (WHICH == 0) { const float rq = pg8::rstd_of(ss, tok, 1.0f / 256.0f); const bf16* qp = src + (size_t)tok * 1024 + 128 * h;
            head_process([&](int c, float* f) { unpack8(*(const GAS v4u*)(qp + 8 * c), f);
#pragma unroll
                    for (int j = 0; j < 8; ++j) f[j] *= rq; }, g, cs, QSCALE, d);
        } else { const float rk = pg8::rstd_of(ss, tok, 1.0f / 128.0f); const bf16* kp = src + (size_t)tok * 512 + 64 * h; const bf16* rp = ckv + (size_t)tok * 256 + 128;
            head_process([&](int c, float* f) { if (c < 8) { unpack8(*(const GAS v4u*)(kp + 8 * c), f);
#pragma unroll
                        for (int j = 0; j < 8; ++j) f[j] *= rk; } else unpack8(*(const GAS v4u*)(rp + 8 * (c - 8)), f); }, g, cs, 1.0f, d);
        }
    }
}
namespace att {
typedef short bf16x8 __attribute__((ext_vector_type(8)));
typedef float f32x16 __attribute__((ext_vector_type(16)));
constexpr int KP = 208, VP = 144, KBUF = 64 * KP, VBUF = 64 * VP;
constexpr int OFF_K = 0, OFF_V = 2 * KBUF, OFF_L = OFF_V + 2 * VBUF, LDS_NEED = OFF_L + NWAVES * 64 * 4;
static_assert(LDS_NEED <= RING_BYTES, "attention LDS");
__device__ __forceinline__ void attn_unit(LAS unsigned char* lds, const bf16* Qh, const bf16* Kh, const bf16* Vt, bf16* O, int bh, int qb, int tid) {
    const int lane = tid & 63, wid = __builtin_amdgcn_readfirstlane(tid >> 6), i32 = lane & 31, hi = lane >> 5;
    const int b = bh >> 3, h = bh & 7, q0 = qb * 256, qw0 = q0 + wid * 32;
    bf16x8 qf[6];
    { const bf16* Qp = Qh + ((size_t)bh * SEQ + qw0 + i32) * DQK + hi * 8;
#pragma unroll
      for (int d0 = 0; d0 < 6; ++d0) qf[d0] = *(const GAS bf16x8*)(Qp + 16 * d0); }
    const unsigned char* Kb = (const unsigned char*)(Kh + (size_t)bh * SEQ * DQK);
    const bf16* Vb = Vt + (size_t)bh * 64 * 4096 + tid * 8;
    const int kl0 = (tid / 12) * KP + (tid % 12) * 16, kl1 = ((512 + tid) / 12) * KP + ((512 + tid) % 12) * 16, vl = (tid >> 3) * VP + (tid & 7) * 16;
    const int ntiles = 4 * (qb + 1);
    const int krow = (i32 & ~12) | ((i32 & 4) << 1) | ((i32 & 8) >> 1);
    const int koff = OFF_K + krow * KP + hi * 16, voff = OFF_V + i32 * VP + hi * 16;
    f32x16 o0, o1;
#pragma unroll
    for (int r = 0; r < 16; ++r) { o0[r] = 0.f; o1[r] = 0.f; }
    float lsum = 0.f;
    v4u r0, r1, rv;
    r0 = *(const GAS v4u*)(Kb + tid * 16); r1 = (tid < 256) ? *(const GAS v4u*)(Kb + (512 + tid) * 16) : (v4u){0u, 0u, 0u, 0u}; rv = *(const GAS v4u*)(Vb);
    *(LAS v4u*)(lds + OFF_K + kl0) = r0; if (tid < 256) *(LAS v4u*)(lds + OFF_K + kl1) = r1; *(LAS v4u*)(lds + OFF_V + vl) = rv;
    __syncthreads();
    for (int t = 0; t < ntiles; ++t) {
        const int cur = t & 1; const bool more = (t + 1 < ntiles);
        if (more) { const unsigned char* kt_ = Kb + (size_t)(t + 1) * (64 * DQK * 2);
            r0 = *(const GAS v4u*)(kt_ + tid * 16); if (tid < 256) r1 = *(const GAS v4u*)(kt_ + (512 + tid) * 16); rv = *(const GAS v4u*)(Vb + (t + 1) * 4096); }
        if (64 * t <= qw0 + 31) {
            const bool diag = (64 * t + 63 > qw0);
#pragma unroll
            for (int kt = 0; kt < 2; ++kt) {
                f32x16 s;
#pragma unroll
                for (int r = 0; r < 16; ++r) s[r] = 0.f;
#pragma unroll
                for (int d0 = 0; d0 < 6; ++d0) { const bf16x8 kf = *(const LAS bf16x8*)(lds + cur * KBUF + kt * 32 * KP + koff + d0 * 32);
                    s = __builtin_amdgcn_mfma_f32_32x32x16_bf16(kf, qf[d0], s, 0, 0, 0); }
                float p[16];
#pragma unroll
                for (int r = 0; r < 16; ++r) p[r] = __builtin_amdgcn_exp2f(s[r]);
                if (diag) { const int q = qw0 + i32, kb_ = 64 * t + 32 * kt + 8 * hi;
#pragma unroll
                    for (int r = 0; r < 16; ++r) { const int key = kb_ + 16 * (r >> 3) + (r & 7); if (key > q) p[r] = 0.f; } }
                float ps = 0.f;
#pragma unroll
                for (int r = 0; r < 16; ++r) ps += p[r];
                lsum += ps;
#pragma unroll
                for (int k = 0; k < 2; ++k) { v4u pw; pw.x = pg8::cvt_pk_bf16(p[8 * k], p[8 * k + 1]); pw.y = pg8::cvt_pk_bf16(p[8 * k + 2], p[8 * k + 3]); pw.z = pg8::cvt_pk_bf16(p[8 * k + 4], p[8 * k + 5]); pw.w = pg8::cvt_pk_bf16(p[8 * k + 6], p[8 * k + 7]);
                    const bf16x8 pa = __builtin_bit_cast(bf16x8, pw);
                    const bf16x8 vf0 = *(const LAS bf16x8*)(lds + cur * VBUF + voff + (kt * 32 + k * 16) * 2);
                    const bf16x8 vf1 = *(const LAS bf16x8*)(lds + cur * VBUF + voff + 32 * VP + (kt * 32 + k * 16) * 2);
                    o0 = __builtin_amdgcn_mfma_f32_32x32x16_bf16(pa, vf0, o0, 0, 0, 0); o1 = __builtin_amdgcn_mfma_f32_32x32x16_bf16(pa, vf1, o1, 0, 0, 0); }
            }
        }
        if (more) { const int nb = cur ^ 1; *(LAS v4u*)(lds + OFF_K + nb * KBUF + kl0) = r0; if (tid < 256) *(LAS v4u*)(lds + OFF_K + nb * KBUF + kl1) = r1; *(LAS v4u*)(lds + OFF_V + nb * VBUF + vl) = rv; }
        __syncthreads();
    }
    lsum = pg8::xsum32(lsum);
    LAS float* lsc = (LAS float*)(lds + OFF_L) + wid * 32;
    if (hi == 0) lsc[i32] = lsum;
    LDS_WAIT(); asm volatile("" ::: "memory");
    bf16* Op = O + ((size_t)b * SEQ + qw0) * 512 + h * 64 + i32;
#pragma unroll
    for (int r = 0; r < 16; ++r) { const int qr = (r & 3) + 8 * (r >> 2) + 4 * hi; const float inv = 1.0f / lsc[qr];
        Op[(size_t)qr * 512] = (bf16)f2bf(o0[r] * inv); Op[(size_t)qr * 512 + 32] = (bf16)f2bf(o1[r] * inv); }
    LDS_WAIT(); asm volatile("" ::: "memory");
}
#define ATT_SBAR() __builtin_amdgcn_sched_barrier(0)
__device__ __forceinline__ void attn_slice(const int j, const f32x16& c0, const f32x16& c1, v4u (&pw)[4], float& ps) {
    const int rr = (4 * j) & 15; float e[4];
#pragma unroll
    for (int k = 0; k < 4; ++k) e[k] = __builtin_amdgcn_exp2f(j < 4 ? c0[rr + k] : c1[rr + k]);
    ps += (e[0] + e[1]) + (e[2] + e[3]);
    const unsigned w0 = pg8::cvt_pk_bf16(e[0], e[1]), w1 = pg8::cvt_pk_bf16(e[2], e[3]);
    if (j & 1) { pw[j >> 1].z = w0; pw[j >> 1].w = w1; } else { pw[j >> 1].x = w0; pw[j >> 1].y = w1; }
    asm volatile("" : "+v"(pw[j >> 1]), "+v"(ps));
}
__device__ __forceinline__ void attn_qk_softmax(LAS unsigned char* lds, const int kbase  , const bf16x8 (&qf)[6],
        const f32x16& c0, const f32x16& c1, f32x16& n0, f32x16& n1, v4u (&pw)[4], float& ps) {
#pragma unroll
    for (int r = 0; r < 16; ++r) { n0[r] = 0.f; n1[r] = 0.f; }
    bf16x8 ka0 = *(const LAS bf16x8*)(lds + kbase), ka1 = *(const LAS bf16x8*)(lds + kbase + 32 * KP);
#pragma unroll
    for (int i = 0; i < 6; ++i) {
        bf16x8 kb0 = ka0, kb1 = ka1;
        if (i < 5) { kb0 = *(const LAS bf16x8*)(lds + kbase + (i + 1) * 32); kb1 = *(const LAS bf16x8*)(lds + kbase + 32 * KP + (i + 1) * 32); }
        n0 = __builtin_amdgcn_mfma_f32_32x32x16_bf16(ka0, qf[i], n0, 0, 0, 0);
        if (2 * i < 8) attn_slice(2 * i, c0, c1, pw, ps);
        ATT_SBAR();
        n1 = __builtin_amdgcn_mfma_f32_32x32x16_bf16(ka1, qf[i], n1, 0, 0, 0);
        if (2 * i + 1 < 8) attn_slice(2 * i + 1, c0, c1, pw, ps);
        ATT_SBAR();
        ka0 = kb0; ka1 = kb1;
    }
}
__device__ __forceinline__ void attn_unit2(LAS unsigned char* lds, const bf16* Qh, const bf16* Kh, const bf16* Vt, bf16* O, int bh, int qb, int tid) {
    const int lane = tid & 63, wid = __builtin_amdgcn_readfirstlane(tid >> 6), i32 = lane & 31, hi = lane >> 5;
    const int b = bh >> 3, h = bh & 7, q0 = qb * 256, qw0 = q0 + wid * 32;
    bf16x8 qf[6];
    { const bf16* Qp = Qh + ((size_t)bh * SEQ + qw0 + i32) * DQK + hi * 8;
#pragma unroll
      for (int d0 = 0; d0 < 6; ++d0) qf[d0] = *(const GAS bf16x8*)(Qp + 16 * d0); }
    const unsigned char* Kb = (const unsigned char*)(Kh + (size_t)bh * SEQ * DQK);
    const bf16* Vb = Vt + (size_t)bh * 64 * 4096 + tid * 8;
    const int kl0 = (tid / 12) * KP + (tid % 12) * 16, kl1 = ((512 + tid) / 12) * KP + ((512 + tid) % 12) * 16, vl = (tid >> 3) * VP + (tid & 7) * 16;
    const int ntiles = 4 * (qb + 1);
    const int krow = (i32 & ~12) | ((i32 & 4) << 1) | ((i32 & 8) >> 1);
    const int koff = OFF_K + krow * KP + hi * 16, voff = OFF_V + i32 * VP + hi * 16;
    const int q = qw0 + i32;
    f32x16 o0, o1;
#pragma unroll
    for (int r = 0; r < 16; ++r) { o0[r] = 0.f; o1[r] = 0.f; }
    float lsum = 0.f;
    v4u rk0, rk1 = (v4u){0u, 0u, 0u, 0u}, rvv;
#define ATT_LDK(T) do { const unsigned char* kt_ = Kb + (size_t)(T) * (64 * DQK * 2); rk0 = *(const GAS v4u*)(kt_ + tid * 16); if (tid < 256) rk1 = *(const GAS v4u*)(kt_ + (512 + tid) * 16); } while (0)
#define ATT_STK(NB) do { *(LAS v4u*)(lds + OFF_K + (NB) * KBUF + kl0) = rk0; if (tid < 256) *(LAS v4u*)(lds + OFF_K + (NB) * KBUF + kl1) = rk1; } while (0)
    ATT_LDK(0); rvv = *(const GAS v4u*)(Vb); ATT_STK(0); *(LAS v4u*)(lds + OFF_V + vl) = rvv;
    ATT_LDK(1); ATT_STK(1);
    __syncthreads();
    f32x16 sA0, sA1, sB0, sB1;
    {
#pragma unroll
        for (int r = 0; r < 16; ++r) { sA0[r] = 0.f; sA1[r] = 0.f; }
#pragma unroll
        for (int d0 = 0; d0 < 6; ++d0) { const bf16x8 kf0 = *(const LAS bf16x8*)(lds + koff + d0 * 32), kf1 = *(const LAS bf16x8*)(lds + 32 * KP + koff + d0 * 32);
            sA0 = __builtin_amdgcn_mfma_f32_32x32x16_bf16(kf0, qf[d0], sA0, 0, 0, 0); sA1 = __builtin_amdgcn_mfma_f32_32x32x16_bf16(kf1, qf[d0], sA1, 0, 0, 0); }
    }
    __syncthreads();
    auto step = [&](f32x16& c0, f32x16& c1, f32x16& n0, f32x16& n1, const int t, const int par) {
        if (t + 2 < ntiles) ATT_LDK(t + 2);
        if (t + 1 < ntiles) rvv = *(const GAS v4u*)(Vb + (t + 1) * 4096);
        v4u pw[4]; float ps = 0.f;
        const int kbase = (par ^ 1) * KBUF + koff, keyb = 64 * t + 8 * hi;
        if (t >= ntiles - 4) {
#pragma unroll
            for (int r = 0; r < 16; ++r) { const int key = keyb + 16 * (r >> 3) + (r & 7); if (key > q) c0[r] = -INFINITY; if (key + 32 > q) c1[r] = -INFINITY; } }
        attn_qk_softmax(lds, kbase, qf, c0, c1, n0, n1, pw, ps);
        lsum += ps;
#pragma unroll
        for (int f = 0; f < 4; ++f) { const bf16x8 pa = __builtin_bit_cast(bf16x8, pw[f]);
            const bf16x8 vf0 = *(const LAS bf16x8*)(lds + par * VBUF + voff + f * 32), vf1 = *(const LAS bf16x8*)(lds + par * VBUF + voff + 32 * VP + f * 32);
            o0 = __builtin_amdgcn_mfma_f32_32x32x16_bf16(pa, vf0, o0, 0, 0, 0); o1 = __builtin_amdgcn_mfma_f32_32x32x16_bf16(pa, vf1, o1, 0, 0, 0); }
        if (t + 2 < ntiles) ATT_STK(par);
        if (t + 1 < ntiles) *(LAS v4u*)(lds + OFF_V + (par ^ 1) * VBUF + vl) = rvv;
        __syncthreads();
    };
    for (int t = 0; t < ntiles; t += 2) { step(sA0, sA1, sB0, sB1, t, 0); step(sB0, sB1, sA0, sA1, t + 1, 1); }
#undef ATT_LDK
#undef ATT_STK
    lsum = pg8::xsum32(lsum);
    LAS float* lsc = (LAS float*)(lds + OFF_L) + wid * 32;
    if (hi == 0) lsc[i32] = lsum;
    LDS_WAIT(); asm volatile("" ::: "memory");
    bf16* Op = O + ((size_t)b * SEQ + qw0) * 512 + h * 64 + i32;
#pragma unroll
    for (int r = 0; r < 16; ++r) { const int qr = (r & 3) + 8 * (r >> 2) + 4 * hi; const float inv = 1.0f / lsc[qr];
        Op[(size_t)qr * 512] = (bf16)f2bf(o0[r] * inv); Op[(size_t)qr * 512 + 32] = (bf16)f2bf(o1[r] * inv); }
    LDS_WAIT(); asm volatile("" ::: "memory");
}
__device__ __forceinline__ void attn_softmax_pack(f32x16& s0, f32x16& s1, const bool diag, const int q, const int keyb, float& lsum, v4u (&pa)[4]) {
    float p0[16], p1[16];
#pragma unroll
    for (int r = 0; r < 16; ++r) { p0[r] = __builtin_amdgcn_exp2f(s0[r]); p1[r] = __builtin_amdgcn_exp2f(s1[r]); }
    if (diag) { asm volatile("" ::: "memory");
#pragma unroll
        for (int r = 0; r < 16; ++r) { const int key = keyb + 16 * (r >> 3) + (r & 7); if (key > q) p0[r] = 0.f; if (key + 32 > q) p1[r] = 0.f; } }
    float ps = 0.f;
#pragma unroll
    for (int r = 0; r < 16; ++r) ps += p0[r] + p1[r];
    lsum += ps;
#pragma unroll
    for (int k = 0; k < 2; ++k) {
        pa[k].x = pg8::cvt_pk_bf16(p0[8 * k], p0[8 * k + 1]); pa[k].y = pg8::cvt_pk_bf16(p0[8 * k + 2], p0[8 * k + 3]); pa[k].z = pg8::cvt_pk_bf16(p0[8 * k + 4], p0[8 * k + 5]); pa[k].w = pg8::cvt_pk_bf16(p0[8 * k + 6], p0[8 * k + 7]);
        pa[2 + k].x = pg8::cvt_pk_bf16(p1[8 * k], p1[8 * k + 1]); pa[2 + k].y = pg8::cvt_pk_bf16(p1[8 * k + 2], p1[8 * k + 3]); pa[2 + k].z = pg8::cvt_pk_bf16(p1[8 * k + 4], p1[8 * k + 5]); pa[2 + k].w = pg8::cvt_pk_bf16(p1[8 * k + 6], p1[8 * k + 7]); }
}
__device__ __forceinline__ void attn_unit3(LAS unsigned char* lds, const bf16* Qh, const bf16* Kh, const bf16* Vt, bf16* O, int bh, int qb, int tid_in) {
    int tid = tid_in; asm volatile("" : "+v"(tid));
    const int lane = tid & 63, wid = __builtin_amdgcn_readfirstlane(tid >> 6), i32 = lane & 31, hi = lane >> 5;
    const int b = bh >> 3, h = bh & 7, q0 = qb * 512, qA0 = q0 + wid * 32, qB0 = q0 + (15 - wid) * 32;
    bf16x8 qa[6], qb_[6];
    { const bf16* Qp = Qh + ((size_t)bh * SEQ + qA0 + i32) * DQK + hi * 8; const bf16* Qq = Qh + ((size_t)bh * SEQ + qB0 + i32) * DQK + hi * 8;
#pragma unroll
      for (int d0 = 0; d0 < 6; ++d0) { qa[d0] = *(const GAS bf16x8*)(Qp + 16 * d0); qb_[d0] = *(const GAS bf16x8*)(Qq + 16 * d0); } }
    const unsigned char* Kb = (const unsigned char*)(Kh + (size_t)bh * SEQ * DQK);
    const unsigned char* Vb = (const unsigned char*)(Vt + (size_t)bh * 64 * 4096);
    const unsigned go0 = (unsigned)tid * 16u, go1 = (unsigned)(512 + tid) * 16u;
    const int kl0 = (tid / 12) * KP + (tid % 12) * 16, kl1 = ((512 + tid) / 12) * KP + ((512 + tid) % 12) * 16, vl = (tid >> 3) * VP + (tid & 7) * 16;
    const int ntiles = 8 * (qb + 1);
    const int krow = (i32 & ~12) | ((i32 & 4) << 1) | ((i32 & 8) >> 1);
    const int koff = OFF_K + krow * KP + hi * 16, voff = OFF_V + i32 * VP + hi * 16;
    f32x16 oa0, oa1, ob0, ob1;
#pragma unroll
    for (int r = 0; r < 16; ++r) { oa0[r] = 0.f; oa1[r] = 0.f; ob0[r] = 0.f; ob1[r] = 0.f; }
    float lsa = 0.f, lsb = 0.f;
    v4u r0, r1 = (v4u){0u, 0u, 0u, 0u}, rv;
    r0 = *(const GAS v4u*)(Kb + go0); if (tid < 256) r1 = *(const GAS v4u*)(Kb + go1); rv = *(const GAS v4u*)(Vb + go0);
    *(LAS v4u*)(lds + OFF_K + kl0) = r0; if (tid < 256) *(LAS v4u*)(lds + OFF_K + kl1) = r1; *(LAS v4u*)(lds + OFF_V + vl) = rv;
    __syncthreads();
    for (int t = 0; t < ntiles; ++t) {
        const int cur = t & 1; const bool more = (t + 1 < ntiles);
        if (more) { const unsigned char* kt_ = Kb + (size_t)(t + 1) * (64 * DQK * 2);
            r0 = *(const GAS v4u*)(kt_ + go0); if (tid < 256) r1 = *(const GAS v4u*)(kt_ + go1); rv = *(const GAS v4u*)(Vb + (size_t)(t + 1) * 8192 + go0); }
#define ATT3_BLOCK(QF, O0, O1, LS, QBASE) do { if (64 * t <= (QBASE) + 31) { \
            f32x16 s0, s1; _Pragma("unroll") for (int r = 0; r < 16; ++r) { s0[r] = 0.f; s1[r] = 0.f; } \
            _Pragma("unroll") for (int d0 = 0; d0 < 6; ++d0) { const bf16x8 kf0 = *(const LAS bf16x8*)(lds + cur * KBUF + koff + d0 * 32), kf1 = *(const LAS bf16x8*)(lds + cur * KBUF + 32 * KP + koff + d0 * 32); \
                s0 = __builtin_amdgcn_mfma_f32_32x32x16_bf16(kf0, QF[d0], s0, 0, 0, 0); s1 = __builtin_amdgcn_mfma_f32_32x32x16_bf16(kf1, QF[d0], s1, 0, 0, 0); } \
            v4u pw[4]; attn_softmax_pack(s0, s1, 64 * t + 63 > (QBASE), (QBASE) + i32, 64 * t + 8 * hi, LS, pw); \
            _Pragma("unroll") for (int f = 0; f < 4; ++f) { \
                const bf16x8 vf0 = *(const LAS bf16x8*)(lds + cur * VBUF + voff + f * 32), vf1 = *(const LAS bf16x8*)(lds + cur * VBUF + voff + 32 * VP + f * 32); \
                const bf16x8 fp = __builtin_bit_cast(bf16x8, pw[f]); \
                O0 = __builtin_amdgcn_mfma_f32_32x32x16_bf16(fp, vf0, O0, 0, 0, 0); O1 = __builtin_amdgcn_mfma_f32_32x32x16_bf16(fp, vf1, O1, 0, 0, 0); } } \
            __builtin_amdgcn_sched_barrier(0); } while (0)
        ATT3_BLOCK(qa, oa0, oa1, lsa, qA0);
        ATT3_BLOCK(qb_, ob0, ob1, lsb, qB0);
#undef ATT3_BLOCK
        if (more) { const int nb = cur ^ 1; *(LAS v4u*)(lds + OFF_K + nb * KBUF + kl0) = r0; if (tid < 256) *(LAS v4u*)(lds + OFF_K + nb * KBUF + kl1) = r1; *(LAS v4u*)(lds + OFF_V + nb * VBUF + vl) = rv; }
        __syncthreads();
    }
    lsa = pg8::xsum32(lsa); lsb = pg8::xsum32(lsb);
    LAS float* lsc = (LAS float*)(lds + OFF_L) + wid * 64;
    if (hi == 0) { lsc[i32] = lsa; lsc[32 + i32] = lsb; }
    LDS_WAIT(); asm volatile("" ::: "memory");
    bf16* Op = O + ((size_t)b * SEQ + qA0) * 512 + h * 64 + i32; bf16* Oq = O + ((size_t)b * SEQ + qB0) * 512 + h * 64 + i32;
#pragma unroll
    for (int r = 0; r < 16; ++r) { const int qr = (r & 3) + 8 * (r >> 2) + 4 * hi; const float ia = 1.0f / lsc[qr], ib = 1.0f / lsc[32 + qr];
        Op[(size_t)qr * 512] = (bf16)f2bf(oa0[r] * ia); Op[(size_t)qr * 512 + 32] = (bf16)f2bf(oa1[r] * ia);
        Oq[(size_t)qr * 512] = (bf16)f2bf(ob0[r] * ib); Oq[(size_t)qr * 512 + 32] = (bf16)f2bf(ob1[r] * ib); }
    LDS_WAIT(); asm volatile("" ::: "memory");
}
constexpr int STB = 24576, STV = 16384, OFF_L4 = 3 * STB, LDS_NEED4 = OFF_L4 + NWAVES * 64 * 4;
static_assert(LDS_NEED4 <= RING_BYTES, "attention LDS (DMA ring)");
__device__ __forceinline__ void attn_unit4(LAS unsigned char* lds, const bf16* Qh, const bf16* Kh, const bf16* Vt, bf16* O, int bh, int qb, int tid_in) {
    int tid = tid_in; asm volatile("" : "+v"(tid));
    const int lane = tid & 63, wid = __builtin_amdgcn_readfirstlane(tid >> 6), i32 = lane & 31, hi = lane >> 5;
    const int b = bh >> 3, h = bh & 7, q0 = qb * 512, qA0 = q0 + wid * 32, qB0 = q0 + (15 - wid) * 32;
    bf16x8 qa[6], qb_[6];
    { const bf16* Qp = Qh + ((size_t)bh * SEQ + qA0 + i32) * DQK + hi * 8; const bf16* Qq = Qh + ((size_t)bh * SEQ + qB0 + i32) * DQK + hi * 8;
#pragma unroll
      for (int d0 = 0; d0 < 6; ++d0) { qa[d0] = *(const GAS bf16x8*)(Qp + 16 * d0); qb_[d0] = *(const GAS bf16x8*)(Qq + 16 * d0); } }
    const unsigned char* Kb = (const unsigned char*)(Kh + (size_t)bh * SEQ * DQK);
    const unsigned char* Vb = (const unsigned char*)(Vt + (size_t)bh * 64 * 4096);
    unsigned gk0, gk1, gv;
    { int s = 64 * wid + lane, row = s >> 4, c = (s & 15) ^ (row & 15); if (c >= 12) c -= 4; gk0 = (unsigned)(row * 192 + c * 16);
      s += 512; row = s >> 4; c = (s & 15) ^ (row & 15); if (c >= 12) c -= 4; gk1 = (unsigned)(row * 192 + c * 16);
      s = 64 * wid + lane; row = s >> 3; c = (s & 7) ^ ((row >> 1) & 7); gv = (unsigned)(row * 128 + c * 16); }
    const unsigned ldsb = (unsigned)(uintptr_t)lds, ldsw = (unsigned)wid * 1024u;
#define ATT4_DMA(T, ST) do { const unsigned char* kt_ = Kb + (size_t)(T) * 12288; const unsigned sb_ = ldsb + (unsigned)(ST) * STB + ldsw; \
        pg8::glds16_s(kt_, gk0, sb_); pg8::glds16_s(kt_, gk1, sb_ + 8192u); pg8::glds16_s(Vb + (size_t)(T) * 8192, gv, sb_ + STV); } while (0)
    const int ntiles = 8 * (qb + 1);
    const int krow = (i32 & ~12) | ((i32 & 4) << 1) | ((i32 & 8) >> 1);
    const int kx = krow * 256, lxk = 16 * (hi ^ (krow & 15)), vx = STV + i32 * 128, lxv = 16 * (hi ^ ((i32 >> 1) & 7));
    f32x16 oa0, oa1, ob0, ob1;
#pragma unroll
    for (int r = 0; r < 16; ++r) { oa0[r] = 0.f; oa1[r] = 0.f; ob0[r] = 0.f; ob1[r] = 0.f; }
    float lsa = 0.f, lsb = 0.f;
    __syncthreads();
    ATT4_DMA(0, 0); ATT4_DMA(1, 1);
    int st = 0;
#define ATT4_STEP_HEAD() \
        if (t + 1 < ntiles) asm volatile("s_waitcnt vmcnt(3)" ::: "memory"); else asm volatile("s_waitcnt vmcnt(0)" ::: "memory"); \
        __syncthreads();        \
        if (t + 2 < ntiles) { const int s2 = st == 0 ? 2 : st - 1; ATT4_DMA(t + 2, s2); } \
        LAS unsigned char* sp = lds + st * STB
    for (int t = 0; t < ntiles - 8; ++t) {
        ATT4_STEP_HEAD();
#define KFR(d, hh) (*(const LAS bf16x8*)(sp + kx + ((32 * (d)) ^ lxk) + (hh) * 8192))
#define VFR(f, hh) (*(const LAS bf16x8*)(sp + vx + ((32 * (f)) ^ lxv) + (hh) * 4096))
#define ATT4_BLOCK(QF, O0, O1, LS, QBASE) do { if (64 * t <= (QBASE) + 31) { \
            f32x16 s0, s1; _Pragma("unroll") for (int r = 0; r < 16; ++r) { s0[r] = 0.f; s1[r] = 0.f; } \
            _Pragma("unroll") for (int d0 = 0; d0 < 6; ++d0) { const bf16x8 kf0 = KFR(d0, 0), kf1 = KFR(d0, 1); \
                s0 = __builtin_amdgcn_mfma_f32_32x32x16_bf16(kf0, QF[d0], s0, 0, 0, 0); s1 = __builtin_amdgcn_mfma_f32_32x32x16_bf16(kf1, QF[d0], s1, 0, 0, 0); } \
            v4u pw[4]; attn_softmax_pack(s0, s1, 64 * t + 63 > (QBASE), (QBASE) + i32, 64 * t + 8 * hi, LS, pw); \
            _Pragma("unroll") for (int f = 0; f < 4; ++f) { const bf16x8 vf0 = VFR(f, 0), vf1 = VFR(f, 1); const bf16x8 fp = __builtin_bit_cast(bf16x8, pw[f]); \
                O0 = __builtin_amdgcn_mfma_f32_32x32x16_bf16(fp, vf0, O0, 0, 0, 0); O1 = __builtin_amdgcn_mfma_f32_32x32x16_bf16(fp, vf1, O1, 0, 0, 0); } } \
            __builtin_amdgcn_sched_barrier(0); } while (0)
        {
            f32x16 sA, sB; v4u pwA[4], pwB[4]; float psA = 0.f, psB = 0.f;
            bf16x8 k1[6], k2[6], k3[6], k4[6], vf[4][2], vg[4][2];
#define ATT4_Z(v) f32x16 v; _Pragma("unroll") for (int r = 0; r < 16; ++r) v[r] = 0.f
            k1[0] = KFR(0, 0);
            ATT_SBAR();
#pragma unroll
            for (int d0 = 0; d0 < 6; ++d0) {
                if (d0 + 1 < 6) k1[d0 + 1] = KFR(d0 + 1, 0); else k2[0] = KFR(0, 0);
                if (d0 == 0) { ATT4_Z(z); sA = __builtin_amdgcn_mfma_f32_32x32x16_bf16(k1[0], qa[0], z, 0, 0, 0); } else sA = __builtin_amdgcn_mfma_f32_32x32x16_bf16(k1[d0], qa[d0], sA, 0, 0, 0);
                ATT_SBAR(); }
#pragma unroll
            for (int d0 = 0; d0 < 6; ++d0) {
                if (d0 + 1 < 6) k2[d0 + 1] = KFR(d0 + 1, 0); else k3[0] = KFR(0, 1);
                if (d0 == 0) { ATT4_Z(z); sB = __builtin_amdgcn_mfma_f32_32x32x16_bf16(k2[0], qb_[0], z, 0, 0, 0); } else sB = __builtin_amdgcn_mfma_f32_32x32x16_bf16(k2[d0], qb_[d0], sB, 0, 0, 0);
                if (d0 < 4) attn_slice(d0, sA, sA, pwA, psA);
                ATT_SBAR(); }
#pragma unroll
            for (int d0 = 0; d0 < 6; ++d0) {
                if (d0 + 1 < 6) k3[d0 + 1] = KFR(d0 + 1, 1); else k4[0] = KFR(0, 1);
                if (d0 == 0) { ATT4_Z(z); sA = __builtin_amdgcn_mfma_f32_32x32x16_bf16(k3[0], qa[0], z, 0, 0, 0); } else sA = __builtin_amdgcn_mfma_f32_32x32x16_bf16(k3[d0], qa[d0], sA, 0, 0, 0);
                if (d0 < 4) attn_slice(d0, sB, sB, pwB, psB);
                ATT_SBAR(); }
#pragma unroll
            for (int d0 = 0; d0 < 6; ++d0) {
                if (d0 + 1 < 6) k4[d0 + 1] = KFR(d0 + 1, 1); else { vf[0][0] = VFR(0, 0); vf[0][1] = VFR(0, 1); }
                if (d0 == 0) { ATT4_Z(z); sB = __builtin_amdgcn_mfma_f32_32x32x16_bf16(k4[0], qb_[0], z, 0, 0, 0); } else sB = __builtin_amdgcn_mfma_f32_32x32x16_bf16(k4[d0], qb_[d0], sB, 0, 0, 0);
                if (d0 < 4) attn_slice(4 + d0, sA, sA, pwA, psA);
                ATT_SBAR(); }
#undef ATT4_Z
#pragma unroll
            for (int f = 0; f < 4; ++f) {
                if (f + 1 < 4) { vf[f + 1][0] = VFR(f + 1, 0); vf[f + 1][1] = VFR(f + 1, 1); } else { vg[0][0] = VFR(0, 0); vg[0][1] = VFR(0, 1); }
                const bf16x8 fp = __builtin_bit_cast(bf16x8, pwA[f]);
                oa0 = __builtin_amdgcn_mfma_f32_32x32x16_bf16(fp, vf[f][0], oa0, 0, 0, 0);
                attn_slice(4 + f, sB, sB, pwB, psB);
                ATT_SBAR();
                oa1 = __builtin_amdgcn_mfma_f32_32x32x16_bf16(fp, vf[f][1], oa1, 0, 0, 0);
                ATT_SBAR(); }
#pragma unroll
            for (int f = 0; f < 4; ++f) {
                if (f + 1 < 4) { vg[f + 1][0] = VFR(f + 1, 0); vg[f + 1][1] = VFR(f + 1, 1); }
                const bf16x8 fp = __builtin_bit_cast(bf16x8, pwB[f]);
                ob0 = __builtin_amdgcn_mfma_f32_32x32x16_bf16(fp, vg[f][0], ob0, 0, 0, 0); ob1 = __builtin_amdgcn_mfma_f32_32x32x16_bf16(fp, vg[f][1], ob1, 0, 0, 0);
                ATT_SBAR(); }
            lsa += psA; lsb += psB;
        }
        st = st == 2 ? 0 : st + 1;
    }
    for (int t = ntiles - 8; t < ntiles; ++t) {
        ATT4_STEP_HEAD();
        ATT4_BLOCK(qa, oa0, oa1, lsa, qA0);
        ATT4_BLOCK(qb_, ob0, ob1, lsb, qB0);
        st = st == 2 ? 0 : st + 1;
    }
#undef KFR
#undef VFR
#undef ATT4_BLOCK
#undef ATT4_STEP_HEAD
#undef ATT4_DMA
    lsa = pg8::xsum32(lsa); lsb = pg8::xsum32(lsb);
    LAS float* lsc = (LAS float*)(lds + OFF_L4) + wid * 64;
    if (hi == 0) { lsc[i32] = lsa; lsc[32 + i32] = lsb; }
    LDS_WAIT(); asm volatile("" ::: "memory");
    bf16* Op = O + ((size_t)b * SEQ + qA0) * 512 + h * 64 + i32; bf16* Oq = O + ((size_t)b * SEQ + qB0) * 512 + h * 64 + i32;
#pragma unroll
    for (int r = 0; r < 16; ++r) { const int qr = (r & 3) + 8 * (r >> 2) + 4 * hi; const float ia = 1.0f / lsc[qr], ib = 1.0f / lsc[32 + qr];
        Op[(size_t)qr * 512] = (bf16)f2bf(oa0[r] * ia); Op[(size_t)qr * 512 + 32] = (bf16)f2bf(oa1[r] * ia);
        Oq[(size_t)qr * 512] = (bf16)f2bf(ob0[r] * ib); Oq[(size_t)qr * 512 + 32] = (bf16)f2bf(ob1[r] * ib); }
    LDS_WAIT(); asm volatile("" ::: "memory");
}
__device__ __forceinline__ void attn_phase(const Frame& F, const bf16* Qh, const bf16* Kh, const bf16* Vt, bf16* O) {
    for (int P = F.vcu; P < BATCH * NH * 4; P += F.G) { const int bh = P >> 2, s = P & 3;
        attn_unit4(F.lds, Qh, Kh, Vt, O, bh, s, F.tid); attn_unit4(F.lds, Qh, Kh, Vt, O, bh, 7 - s, F.tid); }
    __syncthreads();
}
}
namespace lru {
__device__ __forceinline__ float neg_expm1(float x) {
    const float t = x * (1.0f + x * (0.5f + x * (0.16666667f + x * (0.041666668f + x * (0.0083333338f + x * 0.0013888889f)))));
    const float e = 1.0f - __builtin_amdgcn_exp2f(1.4426950408889634f * x);
    return (x > -0.25f) ? -t : e;
}
typedef short bf16x8 __attribute__((ext_vector_type(8)));
typedef float f32x16 __attribute__((ext_vector_type(16)));
constexpr int CHUNK = 128, NCHUNK = SEQ / CHUNK, XP = 144;
constexpr int WAVE_LDS = 2 * 32 * XP;
__device__ __forceinline__ void tile_store(LAS unsigned char* T, int lane, const unsigned (&pk)[2][8], bf16* dst  ) {
    const int i32 = lane & 31, hi = lane >> 5;
#pragma unroll
    for (int cb = 0; cb < 2; ++cb)
#pragma unroll
        for (int q = 0; q < 8; ++q) { const int r = 2 * q; LAS unsigned short* p = (LAS unsigned short*)(T + ((r & 3) + 8 * (r >> 2) + 4 * hi) * XP + (32 * cb + i32) * 2);
            p[0] = (unsigned short)pk[cb][q]; p[XP / 2] = (unsigned short)(pk[cb][q] >> 16); }
    LDS_WAIT(); asm volatile("" ::: "memory");
#pragma unroll
    for (int i = 0; i < 4; ++i) { const int tok = (lane >> 3) + 8 * i, cc = lane & 7; *(GAS v4u*)(dst + (size_t)tok * LW + 8 * cc) = *(const LAS v4u*)(T + tok * XP + cc * 16); }
    LDS_WAIT(); asm volatile("" ::: "memory");
}
__device__ __forceinline__ void tile_fetch(int lane, const bf16* src, v4u (&ld)[4]) {
#pragma unroll
    for (int i = 0; i < 4; ++i) { const int tok = (lane >> 3) + 8 * i, cc = lane & 7; ld[i] = *(const GAS v4u*)(src + (size_t)tok * LW + 8 * cc); }
}
__device__ __forceinline__ void tile_unpack(LAS unsigned char* T, int lane, const v4u (&ld)[4], float (&out)[2][16]) {
    const int i32 = lane & 31, hi = lane >> 5;
#pragma unroll
    for (int i = 0; i < 4; ++i) { const int tok = (lane >> 3) + 8 * i, cc = lane & 7; *(LAS v4u*)(T + tok * XP + cc * 16) = ld[i]; }
    LDS_WAIT(); asm volatile("" ::: "memory");
#pragma unroll
    for (int cb = 0; cb < 2; ++cb)
#pragma unroll
        for (int r = 0; r < 16; ++r) out[cb][r] = bf2f(*(const LAS unsigned short*)(T + ((r & 3) + 8 * (r >> 2) + 4 * hi) * XP + (32 * cb + i32) * 2));
    LDS_WAIT(); asm volatile("" ::: "memory");
}
__device__ __forceinline__ void lru_xrows(v4u (&xq)[7], const bf16* xl, const bf16* halo, int b, int chunk, int t0, int s0, int col) {
#pragma unroll
    for (int j = 0; j < 7; ++j) { const int sj = s0 - 3 + j;
        if (sj >= 0) { const bf16* src = (sj < t0) ? halo + ((size_t)((b * NCHUNK + chunk - 1) * 3 + (sj - (t0 - 3)))) * LW : xl + ((size_t)b * SEQ + sj) * LW; xq[j] = *(const GAS v4u*)(src + col); }
        else xq[j] = (v4u){0u, 0u, 0u, 0u}; }
}
template <int PASS> __device__ __forceinline__ void lru_unit(LAS unsigned char* wl, int lane, int b, int chunk, int head, const bf16* xl, const bf16* gl, const float* convw, const float* convb,
        const bf16* wgt  , const float* brg, const float* big, const float* lam, float* carry, bf16* y, bf16* apark  , bf16* xb_  , const bf16* halo  ) {
    const int i32 = lane & 31, hi = lane >> 5;
    const int t0 = chunk * CHUNK; const size_t row0 = (size_t)b * SEQ + t0; const int c0 = head * 64;
    float cbrg[2], cbig[2], csp8[2], hcar[2], ptot[2];
#pragma unroll
    for (int cb = 0; cb < 2; ++cb) { const int c = c0 + 32 * cb + i32; cbrg[cb] = -1.4426950408889634f * brg[c]; cbig[cb] = -1.4426950408889634f * big[c];
        const float l = -lam[c]; csp8[cb] = -1.4426950408889634f * 8.0f * (fmaxf(l, 0.f) + log1pf(expf(-fabsf(l))));
        hcar[cb] = 0.f; ptot[cb] = 1.f; }
    if (PASS == 2) {
#pragma unroll
        for (int cb = 0; cb < 2; ++cb) { const int c = c0 + 32 * cb + i32; float hh = 0.f;
            const float* cp = carry + ((size_t)b * NCHUNK * LW + c) * 2;
            for (int j0 = 0; j0 < chunk; j0 += 8) { f32x2v pc[8];
#pragma unroll
                for (int k = 0; k < 8; ++k) { const int j = (j0 + k < chunk) ? j0 + k : chunk - 1; pc[k] = *(const GAS f32x2v*)(cp + (size_t)j * LW * 2); }
#pragma unroll
                for (int k = 0; k < 8; ++k) if (j0 + k < chunk) hh = pc[k].x * hh + pc[k].y; }
            hcar[cb] = hh; }
    }
    const int cc = lane & 7;
    LAS unsigned char* T = wl + 32 * XP;
    v4u xq[7];
    if (PASS == 1) lru_xrows(xq, xl, halo, b, chunk, t0, t0 + 4 * (lane >> 3), c0 + 8 * (lane & 7));
    unsigned bst[2][8];
    for (int mb = 0; mb < CHUNK / 32; ++mb) {
        f32x16 acc[4]; float A_[2][16], B_[2][16], G_[2][16];
        if constexpr (PASS == 1) {
        int zc = 0; asm volatile("" : "+v"(zc));
        const float* cwp = convw + c0 + 8 * cc + zc; const float* cbp = convb + c0 + 8 * cc + zc;
        { const int tk0 = 4 * (lane >> 3);
          float xr[7][8];
#pragma unroll
          for (int j = 0; j < 7; ++j) unpack8(xq[j], xr[j]);
          if (mb + 1 < CHUNK / 32) lru_xrows(xq, xl, halo, b, chunk, t0, t0 + 32 * (mb + 1) + tk0, c0 + 8 * cc);
          float cwv[4][8], cbv[8];
          { const f32x4 b0 = *(const GAS f32x4*)cbp, b1 = *(const GAS f32x4*)(cbp + 4); cbv[0] = b0.x; cbv[1] = b0.y; cbv[2] = b0.z; cbv[3] = b0.w; cbv[4] = b1.x; cbv[5] = b1.y; cbv[6] = b1.z; cbv[7] = b1.w; }
#pragma unroll
          for (int j = 0; j < 4; ++j) { const f32x4 w0 = *(const GAS f32x4*)(cwp + j * LW), w1 = *(const GAS f32x4*)(cwp + j * LW + 4);
              cwv[j][0] = w0.x; cwv[j][1] = w0.y; cwv[j][2] = w0.z; cwv[j][3] = w0.w; cwv[j][4] = w1.x; cwv[j][5] = w1.y; cwv[j][6] = w1.z; cwv[j][7] = w1.w; }
#pragma unroll
          for (int i = 0; i < 4; ++i) { float a8[8];
#pragma unroll
              for (int e = 0; e < 8; ++e) a8[e] = cbv[e] + cwv[0][e] * xr[i][e] + cwv[1][e] * xr[i + 1][e] + cwv[2][e] * xr[i + 2][e] + cwv[3][e] * xr[i + 3][e];
              v4u o; o.x = pk2(a8[0], a8[1]); o.y = pk2(a8[2], a8[3]); o.z = pk2(a8[4], a8[5]); o.w = pk2(a8[6], a8[7]);
              *(LAS v4u*)(wl + (tk0 + i) * XP + cc * 16) = o; } }
        LDS_WAIT(); asm volatile("" ::: "memory");
        if (mb > 0) tile_store(T, lane, bst, xb_ + (row0 + 32 * (mb - 1)) * LW + c0);
#pragma unroll
        for (int nb = 0; nb < 4; ++nb)
#pragma unroll
            for (int r = 0; r < 16; ++r) acc[nb][r] = 0.f;
        int zo = 0; asm volatile("" : "+v"(zo));
        const bf16* wrow = wgt + ((size_t)head * 128 + i32) * 64 + 8 * hi + zo;
#pragma unroll
        for (int kk = 0; kk < 4; ++kk) { const bf16x8 af = *(const LAS bf16x8*)(wl + i32 * XP + (16 * kk + 8 * hi) * 2);
#pragma unroll
            for (int nb = 0; nb < 4; ++nb) { const bf16x8 wf = *(const GAS bf16x8*)(wrow + ((nb >> 1) * 64 + (nb & 1) * 32) * 64 + 16 * kk);
                acc[nb] = __builtin_amdgcn_mfma_f32_32x32x16_bf16(af, wf, acc[nb], 0, 0, 0); } }
        } else {
            v4u la[4], lb[4], lg[4];
            tile_fetch(lane, apark + (row0 + 32 * mb) * LW + c0, la); tile_fetch(lane, xb_ + (row0 + 32 * mb) * LW + c0, lb); tile_fetch(lane, gl + (row0 + 32 * mb) * LW + c0, lg);
            tile_unpack(T, lane, la, A_); tile_unpack(T, lane, lb, B_); tile_unpack(T, lane, lg, G_);
        }
        unsigned ow[2][8];
#pragma unroll
        for (int cb = 0; cb < 2; ++cb) {
            float av[16], bv[16];
            if constexpr (PASS == 1) {
#pragma unroll
            for (int r = 0; r < 16; ++r) { const int tok = (r & 3) + 8 * (r >> 2) + 4 * hi;
                const float rg = __builtin_amdgcn_rcpf(1.0f + __builtin_amdgcn_exp2f(__builtin_fmaf(acc[cb][r], -1.4426950408889634f, cbrg[cb]))), ig = __builtin_amdgcn_rcpf(1.0f + __builtin_amdgcn_exp2f(__builtin_fmaf(acc[2 + cb][r], -1.4426950408889634f, cbig[cb])));
                const float a = __builtin_amdgcn_exp2f(rg * csp8[cb]); const float mult = __builtin_amdgcn_sqrtf(__builtin_fmaf(-a, a, 1.0f));
                const float xc = bf2f(*(const LAS unsigned short*)(wl + tok * XP + (32 * cb + i32) * 2));
                av[r] = a; bv[r] = mult * ig * xc; }
#pragma unroll
            for (int q = 0; q < 8; ++q) { ow[cb][q] = pg8::cvt_pk_bf16(1.0f - av[2 * q], 1.0f - av[2 * q + 1]); bst[cb][q] = pg8::cvt_pk_bf16(bv[2 * q], bv[2 * q + 1]); }
            } else {
#pragma unroll
            for (int r = 0; r < 16; ++r) { av[r] = 1.0f - A_[cb][r]; bv[r] = B_[cb][r]; }
            }
            float gA[4], gB[4];
#pragma unroll
            for (int g = 0; g < 4; ++g) { float P = av[4 * g], Hl = bv[4 * g];
#pragma unroll
                for (int i = 1; i < 4; ++i) { Hl = av[4 * g + i] * Hl + bv[4 * g + i]; P *= av[4 * g + i]; bv[4 * g + i] = Hl; av[4 * g + i] = P; }
                gA[g] = P; gB[g] = Hl; }
            float hin[4]; float hh = hcar[cb], pp = ptot[cb];
#pragma unroll
            for (int g = 0; g < 4; ++g) { const float oA = pg8::xother32(gA[g], hi), oB = pg8::xother32(gB[g], hi);
                const float fA = hi ? oA : gA[g], fB = hi ? oB : gB[g], sA = hi ? gA[g] : oA, sB = hi ? gB[g] : oB;
                const float h_first = hh; hh = fA * hh + fB; const float h_second = hh; hh = sA * hh + sB; pp *= fA * sA;
                hin[g] = hi ? h_second : h_first; }
            hcar[cb] = hh; ptot[cb] = pp;
            if (PASS == 2) {
#pragma unroll
                for (int q = 0; q < 8; ++q) { float o2[2];
#pragma unroll
                    for (int k = 0; k < 2; ++k) { const int r = 2 * q + k; const float hv = __builtin_fmaf(av[r], hin[r >> 2], bv[r]);
                        const float gx = G_[cb][r];
                        const float t2 = gx * gx, u2 = gx * __builtin_fmaf(t2, -0.10294324f, -2.3022082f);
                        o2[k] = hv * gx * __builtin_amdgcn_rcpf(1.0f + __builtin_amdgcn_exp2f(u2)); }
                    ow[cb][q] = pg8::cvt_pk_bf16(o2[0], o2[1]); }
            }
        }
        tile_store(T, lane, ow, (PASS == 1 ? apark : y) + (row0 + 32 * mb) * LW + c0);
    }
    if (PASS == 1) tile_store(T, lane, bst, xb_ + (row0 + 32 * (CHUNK / 32 - 1)) * LW + c0);
    if (PASS == 1 && hi == 0) {
#pragma unroll
        for (int cb = 0; cb < 2; ++cb) { const int c = c0 + 32 * cb + i32; *(GAS f32x2v*)(carry + (((size_t)b * NCHUNK + chunk) * LW + c) * 2) = (f32x2v){ptot[cb], hcar[cb]}; }
    }
}
template <int PASS> __device__ __forceinline__ void lru_phase(const Frame& F, const bf16* xl, const bf16* gl, const float* convw, const float* convb, const bf16* wgt,
        const float* brg, const float* big, const float* lam, float* carry, bf16* y, bf16* apark, bf16* xb_, const bf16* halo) {
    LAS unsigned char* wl = F.lds + 49152 + F.wave * WAVE_LDS;
    static_assert(49152 + NWAVES * WAVE_LDS <= RING_BYTES, "RG-LRU LDS tiles");
    for (int U = F.gw; U < BATCH * NCHUNK * 8; U += F.ngw) { const int head = U & 7, chunk = (U >> 3) & (NCHUNK - 1), b = U >> 8;
        lru_unit<PASS>(wl, F.lane, b, chunk, head, xl, gl, convw, convb, wgt, brg, big, lam, carry, y, apark, xb_, halo); }
}
}
struct Args { const void* in[28]; float* out; unsigned char* ws; int ph_lo, ph_hi; };
constexpr int PH_PRO = 0, PH_L0 = 1, PH_PER_LAYER = 9, PH_MOE = PH_L0 + 2 * PH_PER_LAYER  , N_MOE_CHUNKS = 1, N_PHASES = PH_MOE + 2 * N_MOE_CHUNKS + 1;
enum { P_PROJ = 0, P_QKV = 1, P_QKPOST = 2, P_ATTN = 3, P_MERGE = 4, P_WO = 5, P_NORM2 = 6  , P_FGU = 7, P_FDN = 8   };

static_assert(sizeof(Args) == 248, "Args layout: in[28] @0, out @224, ws @232, ph_lo @240, ph_hi @244");
#define KAS __attribute__((address_space(4)))
typedef KAS const unsigned char* kptr_t;
__device__ __forceinline__ kptr_t kargs_base() { kptr_t p = (kptr_t)__builtin_amdgcn_kernarg_segment_ptr(); asm volatile("" : "+s"(p)); return p; }
#define PHASE_BASES() const kptr_t ka_ = kargs_base(); unsigned char* const ws = *(unsigned char* const KAS*)(ka_ + 232)
#define KIN(k) (*(const float* const KAS*)(ka_ + 8 * (k)))
#define KOUT() (*(float* const KAS*)(ka_ + 224))
__global__ void __launch_bounds__(NWAVES * 64, 2) fwd_kernel(Args args) {
    extern __shared__ __attribute__((aligned(16))) unsigned char lds_raw[];
    LAS unsigned char* const lds0 = (LAS unsigned char*)lds_raw;
    const int wave0 = __builtin_amdgcn_readfirstlane((int)threadIdx.x >> 6);
#define MAKE_FRAME() Frame F; { const int t_ = wave0 * 64 + pg8::fresh_lane_id(); F.lds = lds0; F.tid = t_; F.lane = t_ & 63; F.wave = wave0; \
        F.G = gridDim.x; const int bx_ = blockIdx.x; F.vcu = (F.G % 8 == 0) ? (bx_ % 8) * (F.G / 8) + bx_ / 8 : bx_; F.gw = F.vcu * NWAVES + F.wave; F.ngw = F.G * NWAVES; }
    volatile LAS unsigned* MISC = (volatile LAS unsigned*)(lds0 + MISC_OFF);
    for (int u = threadIdx.x; u < (LDS_BYTES - RING_BYTES) / 4; u += NWAVES * 64) ((LAS unsigned*)(lds0 + RING_BYTES))[u] = 0u;
    __syncthreads();
    XcdBarrier bar; bar.bar = (unsigned*)(args.ws + WS_CTL) + CW_BAR; bar.x = 0; bar.st = nullptr;
#if !MK_PER_PHASE
    bar = xcd_barrier_post((unsigned*)(args.ws + WS_CTL) + CW_BAR, MISC + 8);
#endif
    const int lo = args.ph_lo, hi = args.ph_hi;
#ifdef DIAG_WAIT
    unsigned wacc_ = 0u;
#endif
#ifndef PMASK
#define PMASK 0xFFFFFFFFu
#endif
#define EN(id) (((PMASK) >> (id)) & 1u)
#ifndef DUPMASK
#define DUPMASK 0u
#endif
#define NREP(id) (1 + (int)(((DUPMASK) >> (id)) & 1u))
#define IN(k) (lo <= (k) && (k) < hi)
#if MK_PER_PHASE
#define SEAM(k) do { } while (0)
#else
#ifdef DIAG_WAIT
#define SEAM(k) do { if (IN((k) + 1)) { const unsigned long long t0_ = __builtin_amdgcn_s_memrealtime(); xcd_barrier(bar, wave0 == 0 && pg8::fresh_lane_id() == 0); if (DIAG_SEL(k)) wacc_ += (unsigned)(__builtin_amdgcn_s_memrealtime() - t0_); } } while (0)
#else
#define SEAM(k) do { if (IN((k) + 1)) xcd_barrier(bar, wave0 == 0 && pg8::fresh_lane_id() == 0); } while (0)
#endif
#endif
    LAS unsigned char* const ring = lds0;
#define WLP(L) (ws + WS_W + (size_t)(L) * WL_STRIDE)
#define STAT(i) ((pg8::stat_t*)(ws + WS_STAT) + (size_t)(i) * NTOK)
    if (EN(0) && IN(PH_PRO)) {
        PHASE_BASES(); MAKE_FRAME(); int rot = 0;
        for (int rep_ = 0; rep_ < NREP(0); ++rep_) {
#pragma unroll 1
        for (int L = 0; L < DEPTH; ++L) {
            unsigned char* wl = WLP(L);
            bf16* w_in_t = (bf16*)(wl + WL_IN);
            convert_matrix<PROJ_F8>(F, rot, KIN(3) + (size_t)L * DM * DIN, DIN, DM, DIN / 32, w_in_t, DM, [](int cb) { return cb < 45 ? 32 * (cb + (cb >= 13 ? 3 : 0)) : -1; }, KIN(2) + (size_t)L * DM, PROJ_F8 ? 64.0f : 1.0f);
            convert_matrix<PROJ_F8>(F, rot, KIN(3) + (size_t)L * DM * DIN, DIN, DM, DIN / 32, w_in_t, DM, [](int cb) { return cb >= 45 ? 32 * (cb + 3) : -1; }, KIN(2) + (size_t)L * DM, (PROJ_F8 ? 64.0f : 1.0f) * 1.4426950408889634f);
            zero_rows(F, w_in_t, PROJ_F8 ? DM / 2 : DM, 416, 96);
            bf16* w_uq_t = (bf16*)(wl + WL_UQ);
            convert_matrix(F, rot, KIN(5) + (size_t)L * QLR * 768, 768, QLR, 24, w_uq_t, QLR, [](int cb) { return 32 * ((cb / 3) * 4 + cb % 3); }, KIN(4) + (size_t)L * QLR);
#pragma unroll 1
            for (int h = 0; h < NH; ++h) zero_rows(F, w_uq_t, QLR, 128 * h + 96, 32);
            convert_matrix(F, rot, KIN(7) + (size_t)L * KVLR * 1024, 1024, KVLR, 32, (bf16*)(wl + WL_UK), KVLR, [](int cb) { return (cb & 3) < 2 ? 32 * ((cb >> 2) * 2 + (cb & 3)) : -1; }, KIN(6) + (size_t)L * KVLR);
            convert_matrix(F, rot, KIN(7) + (size_t)L * KVLR * 1024, 1024, KVLR, 32, (bf16*)(wl + WL_UV), KVLR, [](int cb) { return (cb & 3) >= 2 ? 32 * ((cb >> 2) * 2 + (cb & 3) - 2) : -1; }, KIN(6) + (size_t)L * KVLR);
            convert_matrix(F, rot, KIN(10) + (size_t)L * 512 * DM, DM, 512, DM / 32, (bf16*)(wl + WL_UPA), 512, [](int cb) { return 32 * cb; });
            convert_matrix(F, rot, KIN(18) + (size_t)L * 512 * DM, DM, 512, DM / 32, (bf16*)(wl + WL_UPL), 512, [](int cb) { return 32 * cb; });
            convert_matrix(F, rot, KIN(19) + (size_t)L * DM * DM, DM, DM, DM / 32, (bf16*)(wl + WL_O), DM, [](int cb) { return 32 * cb; });
#pragma unroll 1
            for (int h = 0; h < 8; ++h) {
                convert_matrix(F, rot, KIN(13) + ((size_t)L * 8 + h) * 4096, 64, 64, 2, (bf16*)(wl + WL_GT) + (size_t)h * 128 * 64, 64, [](int cb) { return 32 * cb; });
                convert_matrix(F, rot, KIN(15) + ((size_t)L * 8 + h) * 4096, 64, 64, 2, (bf16*)(wl + WL_GT) + (size_t)h * 128 * 64 + 64 * 64, 64, [](int cb) { return 32 * cb; });
            }
        }
        convert_matrix<FFN_F8>(F, rot, KIN(21), DFF, DM, DFF / 32, (bf16*)(ws + WS_FGU), DM, [](int cb) { return 32 * ((cb >> 2) * 8 + (cb & 3)); }, KIN(20), (FFN_F8 ? 64.0f : 1.0f) * 1.4426950408889634f);
        convert_matrix<FFN_F8>(F, rot, KIN(22), DFF, DM, DFF / 32, (bf16*)(ws + WS_FGU), DM, [](int cb) { return 32 * ((cb >> 2) * 8 + 4 + (cb & 3)); }, KIN(20), (FFN_F8 ? 64.0f : 1.0f) * 0.6931471805599453f);
        convert_matrix<FFN_DN_F8>(F, rot, KIN(23), DM, DFF, DM / 32, (bf16*)(ws + WS_FD), DFF, [](int cb) { return 32 * cb; }, nullptr, FFN_DN_F8 ? 256.0f : 1.0f);
        xcast_rows<PROJ_F8>(F, KIN(0), (bf16*)(ws + WS_R1), STAT(0));
        { const int* pos = (const int*)KIN(1); float* rope = (float*)(ws + WS_ROPE); const int nthr = F.G * NWAVES * 64;
          for (int idx = blockIdx.x * (NWAVES * 64) + F.tid; idx < NTOK * 16; idx += nthr) { const int tok = idx >> 4, i = idx & 15;
              const double a = (double)pos[tok] * ROPE_INVF[i] * 0.15915494309189535; const double fr = a - rint(a);
              rope[(size_t)tok * 32 + i] = __builtin_amdgcn_cosf((float)fr); rope[(size_t)tok * 32 + 16 + i] = __builtin_amdgcn_sinf((float)fr); } }
        }
    }
#if !MK_PER_PHASE
    {
      if (wave0 == 0 && pg8::fresh_lane_id() == 0) xcd_barrier_census(bar);
      if (IN(PH_PRO)) SEAM(PH_PRO); }
#endif

#pragma unroll 1
    for (int L = 0; L < DEPTH; ++L) {
        const int pb = PH_L0 + L * PH_PER_LAYER;

        if (EN(2) && IN(pb + P_PROJ)) { PHASE_BASES(); MAKE_FRAME();
            for (int rep_ = 0; rep_ < NREP(2); ++rep_) { if (rep_) __syncthreads();
            pg8::Gemm g{(L == 1 && !PROJ_F8) ? (const bf16*)KOUT() : (const bf16*)(ws + (L == 0 ? WS_R1 : WS_R3 + 64 * MiB)), (const bf16*)(WLP(L) + WL_IN), NTOK, DINP, DM, (L == 1 && !PROJ_F8) ? pg8::XRP : DM, DM, 127 - 3}; pg8::StaticOrder S; S.init(NTOK, DINP, F.G, (int)blockIdx.x);
            pg8::EpiProj E{(bf16*)(ws + WS_R2), STAT(L == 0 ? 0 : 2), STAT(3 + L), STAT(5 + L), (bf16*)(ws + WS_HALO)};
            pg8::gemm_phase<pg8::EpiProj, pg8::StaticOrder, true, false, PROJ_F8 ? 1 : 2>(ring, g, S, E, F.wave);
            }
            SEAM(pb + P_PROJ);
        }
        if ((EN(4) || EN(14)) && IN(pb + P_QKV)) { PHASE_BASES(); MAKE_FRAME();
            for (int rep_ = 0; rep_ < NREP(4); ++rep_) { if (rep_) __syncthreads();
            bf16* cq = (bf16*)(ws + WS_R2 + R2_CQ); bf16* ckv = (bf16*)(ws + WS_R2 + R2_CKV);
            {
                pg8::Gemm g{cq, (const bf16*)(WLP(L) + WL_UQ), NTOK, 1024, QLR, QLR, QLR}; pg8::EpiStore E{(bf16*)(ws + WS_R4), 1024, nullptr, 0.f};
                pg8::StaticOrder S; S.init(NTOK, 1024, F.G, (int)blockIdx.x);
                pg8::gemm_phase<pg8::EpiStore, pg8::StaticOrder, true, false>(ring, g, S, E, F.wave);
                __syncthreads();
#pragma unroll 1
                for (int i = 0, pu; (pu = pg8::static_unit(i, NTOK, 1024, F.G, (int)blockIdx.x)) >= 0; ++i) qk_post_tile3<0>(F, pu >> 8, pu & 255, (const bf16*)(ws + WS_R4), nullptr, (const float*)(ws + WS_ROPE), KIN(8) + (size_t)L * DQK, (bf16*)(ws + WS_R3 + R3_Q), STAT(3 + L));
                __syncthreads();
            }
            {
                pg8::Gemm g{ckv, (const bf16*)(WLP(L) + WL_UK), NTOK, 512, KVLR, 256, KVLR}; pg8::EpiStore E{(bf16*)(ws + WS_R1), 512, nullptr, 0.f};
                pg8::StaticOrder S; S.init(NTOK, 512, F.G, (int)blockIdx.x);
                pg8::gemm_phase<pg8::EpiStore, pg8::StaticOrder, true, false>(ring, g, S, E, F.wave);
                __syncthreads();
#pragma unroll 1
                for (int i = 0, pu; (pu = pg8::static_unit(i, NTOK, 512, F.G, (int)blockIdx.x)) >= 0; ++i) qk_post_tile3<1>(F, pu >> 8, pu & 255, (const bf16*)(ws + WS_R1), ckv, (const float*)(ws + WS_ROPE), KIN(9) + (size_t)L * DQK, (bf16*)(ws + WS_R3 + R3_K), STAT(5 + L));
                __syncthreads();
            }
            {
                pg8::Gemm g{(const bf16*)(WLP(L) + WL_UV), ckv, 512, NTOK, KVLR, KVLR, 256}; pg8::StaticOrder S; S.init(512, NTOK, F.G, (int)blockIdx.x);
                pg8::EpiStoreVt E{(bf16*)(ws + WS_R3 + R3_VT), STAT(5 + L), 1.0f / 128.0f};
                pg8::gemm_phase<pg8::EpiStoreVt, pg8::StaticOrder, true, false>(ring, g, S, E, F.wave);
                __syncthreads();
            }
            }
            for (int rep_ = 0; rep_ < NREP(14); ++rep_)
            if (EN(14)) lru::lru_phase<1>(F, (const bf16*)(ws + WS_R2 + R2_XL), (const bf16*)(ws + WS_R2 + R2_GL), KIN(11) + (size_t)L * 4 * LW, KIN(12) + (size_t)L * LW, (const bf16*)(WLP(L) + WL_GT),
                              KIN(14) + (size_t)L * LW, KIN(16) + (size_t)L * LW, KIN(17) + (size_t)L * LW, (float*)(ws + WS_CARRY), (bf16*)(ws + WS_R4 + R4_Y), (bf16*)(ws + WS_R1 + 32 * MiB), (bf16*)(ws + WS_R2 + R2_XL), (const bf16*)(ws + WS_HALO));
            SEAM(pb + P_QKV);
        }
        if ((EN(6) || EN(15)) && IN(pb + P_ATTN)) { PHASE_BASES(); MAKE_FRAME();
            for (int rep_ = 0; rep_ < NREP(6); ++rep_) { if (rep_) __syncthreads();
            if (EN(6)) att::attn_phase(F, (const bf16*)(ws + WS_R3 + R3_Q), (const bf16*)(ws + WS_R3 + R3_K), (const bf16*)(ws + WS_R3 + R3_VT), (bf16*)(ws + WS_R4 + R4_O)); }
            for (int rep_ = 0; rep_ < NREP(15); ++rep_)
            if (EN(15)) lru::lru_phase<2>(F, (const bf16*)(ws + WS_R2 + R2_XL), (const bf16*)(ws + WS_R2 + R2_GL), KIN(11) + (size_t)L * 4 * LW, KIN(12) + (size_t)L * LW, (const bf16*)(WLP(L) + WL_GT),
                              KIN(14) + (size_t)L * LW, KIN(16) + (size_t)L * LW, KIN(17) + (size_t)L * LW, (float*)(ws + WS_CARRY), (bf16*)(ws + WS_R4 + R4_Y), (bf16*)(ws + WS_R1 + 32 * MiB), (bf16*)(ws + WS_R2 + R2_XL), (const bf16*)(ws + WS_HALO));
            SEAM(pb + P_ATTN);
        }
        if (EN(7) && IN(pb + P_MERGE)) { PHASE_BASES(); MAKE_FRAME();
            for (int rep_ = 0; rep_ < NREP(7); ++rep_) { if (rep_) __syncthreads();
            {
                pg8::Gemm g{(const bf16*)(ws + WS_R4 + R4_O), (const bf16*)(WLP(L) + WL_UPA), NTOK, DM, 512, 512, 512};
                pg8::MergeOrder S; S.S.init(NTOK, DM, F.G, (int)blockIdx.x); S.aoff1 = R4_Y - R4_O; S.boff1 = WL_UPL - WL_UPA;
                pg8::EpiMerge E{(const bf16*)(ws + WS_R2 + R2_GA), (const bf16*)(ws + WS_R2 + R2_GB), (bf16*)(ws + WS_R1)};
                pg8::gemm_phase<pg8::EpiMerge, pg8::MergeOrder, true, false>(ring, g, S, E, F.wave);
                __syncthreads();
            }
            }
            SEAM(pb + P_MERGE);
        }
        if (EN(8) && IN(pb + P_WO)) { PHASE_BASES(); MAKE_FRAME();
            pg8::Gemm g{(const bf16*)(ws + WS_R1), (const bf16*)(WLP(L) + WL_O), NTOK, DM, DM, DM, DM}; pg8::StaticOrder S; S.init(NTOK, DM, F.G, (int)blockIdx.x);
            pg8::EpiResid E{L == 0 ? KIN(0) : nullptr, (bf16*)KOUT(), nullptr, L == 0 ? STAT(1) : nullptr};
            pg8::gemm_phase<pg8::EpiResid, pg8::StaticOrder, true, false>(ring, g, S, E, F.wave);
            SEAM(pb + P_WO);
        }
        if (EN(9) && L == 1 && IN(pb + P_NORM2)) { PHASE_BASES(); MAKE_FRAME();
            {
                router_rows(F, (const bf16*)KOUT(), KIN(20) + (size_t)L * DM, (unsigned char*)(ws + MOE_X8), KIN(24), RouterOut{(unsigned*)(ws + WS_CTL) + CW_CNT, (int*)(ws + WS_LTOK), (float*)(ws + WS_LW), (int*)(ws + WS_SLOT)});
                int rot = 0;
                for (int rep_ = 0; rep_ < NREP(16); ++rep_)
#pragma unroll 1
                for (int e = 0; e < NEXP; ++e) {
                    bf16* wgu = (bf16*)(ws + MOE_WGU + (size_t)e * 2 * DFE * DM);
                    convert_matrix<true>(F, rot, KIN(25) + (size_t)e * DM * DFE, DFE, DM, DFE / 32, wgu, DM, [](int cb) { return 32 * ((cb >> 2) * 8 + (cb & 3)); }, nullptr, 64.0f * 1.4426950408889634f);
                    convert_matrix<true>(F, rot, KIN(26) + (size_t)e * DM * DFE, DFE, DM, DFE / 32, wgu, DM, [](int cb) { return 32 * ((cb >> 2) * 8 + 4 + (cb & 3)); }, nullptr, 64.0f * 0.6931471805599453f);
                    convert_matrix<MOE_DN_F8>(F, rot, KIN(27) + (size_t)e * DFE * DM, DM, DFE, DM / 32, (bf16*)(ws + MOE_WD + (size_t)e * DM * DFE * (MOE_DN_F8 ? 1 : 2)), DFE, [](int cb) { return 32 * cb; }, nullptr, MOE_DN_F8 ? 256.0f : 1.0f);
                }
            }
            SEAM(pb + P_NORM2);
        }
        if (L == 0) {
            if (EN(10) && IN(pb + P_FGU)) { PHASE_BASES(); MAKE_FRAME();
            for (int rep_ = 0; rep_ < NREP(10); ++rep_) { if (rep_) __syncthreads();
                pg8::Gemm g{(const bf16*)KOUT(), (const bf16*)(ws + WS_FGU), NTOK, 2 * DFF, DM, pg8::XRP, DM, 127 - 3};   pg8::StaticOrder S; S.init(NTOK, 2 * DFF, F.G, (int)blockIdx.x);
                pg8::EpiSwiglu E{(bf16*)(ws + WS_R2), DFF, STAT(1), FFN_DN_F8 ? 1 : 0};
                pg8::gemm_phase<pg8::EpiSwiglu, pg8::StaticOrder, true, false, FFN_F8 ? 1 : 2>(ring, g, S, E, F.wave);
                }
            SEAM(pb + P_FGU);
            }
            if (EN(11) && IN(pb + P_FDN)) { PHASE_BASES(); MAKE_FRAME();
                pg8::Gemm g{(const bf16*)(ws + WS_R2), (const bf16*)(ws + WS_FD), NTOK, DM, DFF, DFF, DFF, 127 - 4}; pg8::StaticOrder S; S.init(NTOK, DM, F.G, (int)blockIdx.x);
                pg8::EpiResid E{nullptr, (bf16*)KOUT(), PROJ_F8 ? (unsigned char*)(ws + WS_R3 + 64 * MiB) : nullptr, STAT(2)};
                pg8::gemm_phase<pg8::EpiResid, pg8::StaticOrder, true, false, FFN_DN_F8 ? 1 : 2>(ring, g, S, E, F.wave);
                SEAM(pb + P_FDN);
            }
        }
    }
#pragma unroll 1
    for (int ch = 0; ch < N_MOE_CHUNKS; ++ch) {
        if (EN(12) && IN(PH_MOE + 2 * ch)) { PHASE_BASES(); MAKE_FRAME();
            for (int rep_ = 0; rep_ < NREP(12); ++rep_) { if (rep_) __syncthreads();
            pg8::Gemm g{(const bf16*)(ws + MOE_X8), (const bf16*)(ws + MOE_WGU), NTOK, 2 * DFE, DM, DM, DM, 127 - 3};
            pg8::MoeOrder<true> S; S.init((const unsigned*)(ws + WS_CTL) + CW_CNT, N_MOE_CHUNKS == 1 ? -1 : ch, 2 * DFE / 256, F.G, (int)blockIdx.x, (const int*)(ws + WS_LTOK), (size_t)2 * DFE * DM, NTOK);
            pg8::EpiSwiglu E{(bf16*)(ws + MOE_ACT), DFE, nullptr, MOE_DN_F8 ? 1 : 0};
            pg8::gemm_phase<pg8::EpiSwiglu, pg8::MoeOrder<true>, true, false, 1>(ring, g, S, E, F.wave);
            }
            SEAM(PH_MOE + 2 * ch);
        }
        if (EN(13) && IN(PH_MOE + 2 * ch + 1)) { PHASE_BASES(); MAKE_FRAME();
            for (int rep_ = 0; rep_ < NREP(13); ++rep_) { if (rep_) __syncthreads();
            pg8::Gemm g{(const bf16*)(ws + MOE_ACT), (const bf16*)(ws + MOE_WD), 264 * 256, DM, DFE, DFE, DFE, 127 - 4};
            pg8::MoeOrder<false> S; S.init((const unsigned*)(ws + WS_CTL) + CW_CNT, N_MOE_CHUNKS == 1 ? -1 : ch, DM / 256, F.G, (int)blockIdx.x, (const int*)(ws + WS_LTOK), (size_t)DM * DFE * (MOE_DN_F8 ? 1 : 2), NTOK, DFE * (MOE_DN_F8 ? 1 : 2) / 256, (size_t)DFE * (MOE_DN_F8 ? 1 : 2) / 2);
            pg8::EpiMoeDown E{(bf16*)(ws + MOE_Y), (const float*)(ws + WS_LW), (bf16*)(ws + MOE_Y2)};
            pg8::gemm_phase<pg8::EpiMoeDown, pg8::MoeOrder<false>, true, false, MOE_DN_F8 ? 1 : 2>(ring, g, S, E, F.wave);
            }
            SEAM(PH_MOE + 2 * ch + 1);
        }
    }
    if (EN(12) && IN(PH_MOE + 2 * N_MOE_CHUNKS)) { PHASE_BASES(); MAKE_FRAME();
        moe_combine(F, KOUT(), (const bf16*)(ws + MOE_Y), (const bf16*)(ws + MOE_Y2), (const int*)(ws + WS_SLOT), (const unsigned*)(ws + WS_CTL) + CW_CNT);
    }
#if defined(DIAG_WAIT) && !MK_PER_PHASE
    {
        unsigned* dg = (unsigned*)(args.ws + WS_CTL) + 128;
        if (wave0 == 0 && pg8::fresh_lane_id() == 0) atomicAdd(dg, wacc_ / 16u);
        xcd_barrier(bar, wave0 == 0 && pg8::fresh_lane_id() == 0);
        if (blockIdx.x == 0 && wave0 == 0 && pg8::fresh_lane_id() == 0) { const unsigned s = __hip_atomic_load(dg, __ATOMIC_RELAXED, __HIP_MEMORY_SCOPE_AGENT); args.out[0] += (float)(s / gridDim.x) * 16.0f * (1.0f / 1000.0f); }
    }
#endif
#if defined(EXTRA_BARRIERS) && !MK_PER_PHASE
    for (int xb_ = 0; xb_ < EXTRA_BARRIERS; ++xb_) xcd_barrier(bar, threadIdx.x == 0);
#endif
#undef IN
#undef SEAM
}

extern "C" void kernel_launch(void* const* d_in, const int* in_sizes, int n_in, void* d_out, int out_size, void* d_ws, size_t ws_size, hipStream_t stream) {
    static int grid = 0;
    if (grid == 0) {
        if (n_in != 28 || in_sizes[0] != NTOK * DM || out_size != NTOK * DM || ws_size < WS_END) { fprintf(stderr, "kernel_launch: unexpected problem (n_in %d, ws %zu < %zu)\n", n_in, ws_size, (size_t)WS_END); grid = -1; return; }
        int dev = 0, cus = 0, per_cu = 0;
        if (hipGetDevice(&dev) != hipSuccess || hipDeviceGetAttribute(&cus, hipDeviceAttributeMultiprocessorCount, dev) != hipSuccess) { grid = -1; return; }
        if (hipFuncSetAttribute((const void*)fwd_kernel, hipFuncAttributeMaxDynamicSharedMemorySize, LDS_BYTES) != hipSuccess) { fprintf(stderr, "kernel_launch: hipFuncSetAttribute failed\n"); grid = -1; return; }
        if (hipOccupancyMaxActiveBlocksPerMultiprocessor(&per_cu, (const void*)fwd_kernel, NWAVES * 64, LDS_BYTES) != hipSuccess || per_cu < 1) fprintf(stderr, "kernel_launch: occupancy query reports %d\n", per_cu);
        (void)hipGetLastError();
        grid = cus;
    }
    if (grid < 0) return;
    if (hipMemsetAsync((char*)d_ws + WS_CTL, 0, CTL_ZERO_BYTES, stream) != hipSuccess) return;
    Args a{};
    for (int i = 0; i < 28; ++i) a.in[i] = d_in[i];
    a.out = (float*)d_out; a.ws = (unsigned char*)d_ws;
#if MK_PER_PHASE
    for (int p = 0; p < N_PHASES; ++p) { a.ph_lo = p; a.ph_hi = p + 1; hipLaunchKernelGGL(fwd_kernel, dim3(grid), dim3(NWAVES * 64), LDS_BYTES, stream, a); }
#else
    a.ph_lo = 0; a.ph_hi = N_PHASES; hipLaunchKernelGGL(fwd_kernel, dim3(grid), dim3(NWAVES * 64), LDS_BYTES, stream, a);
#endif
}
```

```cpp
#include <hip/hip_runtime.h>
#include <cstdio>
#include <cstdint>
namespace cfg {
constexpr int BATCH = 8, SEQ = 4096, NTOK = BATCH * SEQ, DM = 1024, DEPTH = 2;
constexpr int NH = 8, DQK = 96, DNOPE = 64, DROPE = 32, DVH = 64, QLR = 256, KVLR = 128;
constexpr int LW = 512, LHD = 64;
constexpr int DIN = 3488, DINP = 3584;
constexpr int DFF = 2816, NEXP = 8, DFE = 3584;
constexpr float EPS = 1e-6f;
constexpr float QSCALE = 0.14724444602590306f;
}
using namespace cfg;
constexpr int NWAVES = 8;
static_assert(true, "");
constexpr bool FFN_F8 = false;
constexpr bool FFN_DN_F8 = true;
constexpr bool PROJ_F8 = true;
constexpr bool MOE_DN_F8 = true;
constexpr bool MOE_F8 = true;
#define DUPMASK 0x0u
#ifndef MK_PER_PHASE
#define MK_PER_PHASE 0
#endif
constexpr size_t MiB = 1u << 20;
constexpr size_t WS_CTL = 0, CTL_ZERO_BYTES = 2 * MiB;
constexpr size_t WS_STAT = 64 * 1024;
static_assert(WS_STAT + 7 * (size_t)NTOK * 8 <= CTL_ZERO_BYTES, "stats inside the memset region");
constexpr size_t WS_ROPE = 2 * MiB;
constexpr size_t WS_SLOT = 6 * MiB;
constexpr size_t WS_CARRY = 7 * MiB;
constexpr size_t WS_HALO = 6 * MiB + 256 * 1024;
constexpr size_t WS_LTOK = 8 * MiB, WS_LW = 9 * MiB;
constexpr size_t WS_W = 10 * MiB;
constexpr size_t WL_STRIDE = 12 * MiB;
constexpr size_t WL_IN = 0, WL_UQ = 7 * MiB, WL_UK = WL_UQ + 512 * 1024, WL_UV = WL_UK + 128 * 1024, WL_UPA = WL_UV + 128 * 1024, WL_UPL = WL_UPA + MiB, WL_O = WL_UPL + MiB, WL_GT = WL_O + 2 * MiB;
static_assert(WL_GT + 128 * 1024 <= WL_STRIDE, "layer weights");
constexpr size_t WS_FGU = WS_W + 2 * WL_STRIDE, WS_FD = WS_FGU + 11 * MiB;
constexpr size_t WS_R1 = 52 * MiB;
constexpr size_t WS_R2 = 116 * MiB;
constexpr size_t WS_R3 = 340 * MiB;
constexpr size_t WS_R4 = 468 * MiB;
constexpr size_t WS_Y2 = 532 * MiB;
constexpr size_t WS_END = 536 * MiB;
static_assert(WS_FD + (size_t)DM * DFF * 2 <= WS_R1, "weights region");
constexpr size_t R2_CQ = 0, R2_CKV = 16 * MiB, R2_XL = 32 * MiB, R2_GL = 64 * MiB, R2_GA = 96 * MiB, R2_GB = 160 * MiB;
constexpr size_t R3_Q = 0, R3_K = 48 * MiB, R3_VT = 96 * MiB;
constexpr size_t R4_O = 0, R4_Y = 32 * MiB;
constexpr size_t MOE_X8 = 10 * MiB, MOE_WGU = 42 * MiB, MOE_WD = 98 * MiB, MOE_ACT = 126 * MiB, MOE_Y = 357 * MiB, MOE_Y2 = 489 * MiB;
static_assert(MOE_X8 + (size_t)NTOK * DM <= MOE_WGU && MOE_WGU + (size_t)NEXP * 2 * DFE * DM <= MOE_WD && MOE_WD + (size_t)NEXP * DFE * DM <= MOE_ACT && MOE_ACT + (size_t)264 * 256 * DFE <= MOE_Y && MOE_Y + (size_t)264 * 256 * DM * 2 <= MOE_Y2 && MOE_Y2 + 4 * MiB <= WS_END, "moe buffers");
constexpr int CW_CNT = 64;
constexpr int CW_BAR = 4096;
constexpr int RING_BYTES = 131072, MISC_OFF = RING_BYTES + 320, LDS_BYTES = 147456;
namespace pg8 {
#define PG8_LAS __attribute__((address_space(3)))
typedef unsigned short bf16_t;
typedef short bf16x8 __attribute__((ext_vector_type(8)));
typedef float f32x4 __attribute__((ext_vector_type(4)));
typedef unsigned u32x4 __attribute__((ext_vector_type(4)));
constexpr int BM = 256, BK = 64, HALF = 128, HTB = HALF * BK * 2  , STAGE_BYTES = 8 * HTB, NXCD = 8, WGM = 8;

__host__ __device__ __forceinline__ int lds_byte(int r, int c) { const int st = (r >> 4) * 2 + (c >> 5), rr = r & 15, cc = c & 31, ob = rr * 64 + cc * 2; return st * 1024 + (ob ^ (((ob >> 9) & 1) << 5)); }
__host__ __device__ __forceinline__ void stage_rc(int b, int& R, int& C) { const int st = b / 1024, sb = b % 1024, swz = sb ^ (((sb >> 9) & 1) << 5); R = (st >> 1) * 16 + swz / 64; C = (st & 1) * 32 + (swz % 64) / 2; }
__host__ __device__ __forceinline__ int perm32(int rho) { const int n = rho >> 4, i = rho & 15; return 8 * (i >> 2) + 4 * n + (i & 3); }

struct Unit { int pm, pn, po, lb, nvalid, stage, ntu; size_t boff, aoff; int pf; };
struct Gemm { const bf16_t* A; const bf16_t* Bt; int M, N, K, lda, ldb; int wexp = 127; };
typedef int v8i32 __attribute__((ext_vector_type(8)));
typedef int v4i32 __attribute__((ext_vector_type(4)));
__device__ __forceinline__ v8i32 cat8(const bf16x8 lo, const bf16x8 hi) { const v4i32 a = __builtin_bit_cast(v4i32, lo), b = __builtin_bit_cast(v4i32, hi); return __builtin_shufflevector(a, b, 0, 1, 2, 3, 4, 5, 6, 7); }

struct StaticOrder {
    int nM, nN, nwg, G, c;
    __host__ __device__ void init(int M, int N, int G_, int c_) { nM = M / BM; nN = N / BM; nwg = nM * nN; G = G_; c = c_; }
    __host__ __device__ bool next(int i, Unit& u) const {
        const int L = i * G + c; if (L >= nwg) return false;
        int wgid = (int)L; { const int q = nwg / NXCD, r = nwg % NXCD, xcd = wgid % NXCD, off = wgid / NXCD; wgid = (xcd < r ? xcd * (q + 1) : r * (q + 1) + (xcd - r) * q) + off; }
        const int nig = WGM * nN, gid = wgid / nig, fm = gid * WGM, gsz = (nM - fm) < WGM ? (nM - fm) : WGM;
        u.pm = fm + ((wgid % nig) % gsz); u.pn = (wgid % nig) / gsz; u.po = u.pm; u.lb = 0; u.nvalid = BM; u.stage = 0; u.ntu = 0; u.boff = 0; u.aoff = 0; return true;
    }
    static constexpr bool GATHER = false;
    __device__ __forceinline__ u32x4 rows(const Unit&, int, int) const { return (u32x4){0u, 0u, 0u, 0u}; }
    __device__ __forceinline__ void a_ready(const Unit&) const {}
    __device__ __forceinline__ void done(const Unit&) const {}
};

__device__ __forceinline__ int static_unit(int i, int M, int N, int G, int c) {
    const int nM = M / BM, nN = N / BM, nwg = nM * nN; const int L = i * G + c; if (L >= nwg) return -1;
    int wgid = (int)L; { const int q = nwg / NXCD, r = nwg % NXCD, xcd = wgid % NXCD, off = wgid / NXCD; wgid = (xcd < r ? xcd * (q + 1) : r * (q + 1) + (xcd - r) * q) + off; }
    const int nig = WGM * nN, gid = wgid / nig, fm = gid * WGM, gsz = (nM - fm) < WGM ? (nM - fm) : WGM;
    return ((fm + ((wgid % nig) % gsz)) << 8) | ((wgid % nig) / gsz);
}
__device__ __forceinline__ unsigned cvt_pk_bf16(float lo, float hi) { unsigned r; asm volatile("v_cvt_pk_bf16_f32 %0, %1, %2" : "=v"(r) : "v"(lo), "v"(hi)); return r; }
typedef float f32x2 __attribute__((ext_vector_type(2)));
__device__ __forceinline__ f32x2 gelu_pk(f32x2 v) {
    const f32x2 av = __builtin_elementwise_abs(v), d = av * 0.2316418882f + 1.0f;
    f32x2 t; t.x = __builtin_amdgcn_rcpf(d.x); t.y = __builtin_amdgcn_rcpf(d.y);
    f32x2 q = t * 0.5307027145f + (-0.7265760135f); q = q * t + 0.7107068705f; q = q * t + (-0.142248368f); q = q * t + 0.127414796f; q = q * t;
    const f32x2 s = (v * v) * (-0.72134752044f);
    f32x2 e; e.x = __builtin_amdgcn_exp2f(s.x); e.y = __builtin_amdgcn_exp2f(s.y);
    const f32x2 m = v * (q * e), r = v - m;
    f32x2 o; o.x = v.x < 0.f ? m.x : r.x; o.y = v.y < 0.f ? m.y : r.y; return o;
}

template <int ACT  > struct EpiBf16 {
    static constexpr bool PERM = true, AFTER_DRAIN = false; static_assert(ACT == 0 || ACT == 1, "EpiBf16: ACT is 0 (none) or 1 (gelu_pk)");
    bf16_t* O; int ldc; const float* bias; int split_cols; size_t split_stride; float scale0;
    __device__ __forceinline__ void operator()(const f32x4 (&acc)[2][2][4][2], const Unit& u, int wr, int wc, int fr, int fq) const {
        const int row0 = u.pm * BM + wr * 64 + fr; int colt = u.pn * BM; bf16_t* base = O;
        float sc = 1.f; if (split_cols) { const int t = colt / split_cols; base += (size_t)t * split_stride; colt -= t * split_cols; if (t == 0) sc = scale0; }
        const int col0 = colt + wc * 32 + 8 * fq, bcol0 = u.pn * BM + wc * 32 + 8 * fq;
        f32x4 bv[2][2];
#pragma unroll
        for (int bj = 0; bj < 2; ++bj)
#pragma unroll
            for (int n = 0; n < 2; ++n) bv[bj][n] = bias ? *(const f32x4*)(bias + bcol0 + bj * HALF + 4 * n) : (f32x4){0.f, 0.f, 0.f, 0.f};
#pragma unroll
        for (int ai = 0; ai < 2; ++ai)
#pragma unroll
            for (int m = 0; m < 4; ++m) { bf16_t* rowp = base + (size_t)(row0 + ai * HALF + m * 16) * ldc + col0;
#pragma unroll
                for (int bj = 0; bj < 2; ++bj) { f32x4 v0 = acc[ai][bj][m][0] + bv[bj][0], v1 = acc[ai][bj][m][1] + bv[bj][1];
                    if (ACT == 1) { f32x2 a = gelu_pk((f32x2){v0[0], v0[1]}), b = gelu_pk((f32x2){v0[2], v0[3]}), c = gelu_pk((f32x2){v1[0], v1[1]}), d = gelu_pk((f32x2){v1[2], v1[3]});
                        v0 = (f32x4){a.x, a.y, b.x, b.y}; v1 = (f32x4){c.x, c.y, d.x, d.y}; }
                    v0 = v0 * sc; v1 = v1 * sc; u32x4 w; w.x = cvt_pk_bf16(v0[0], v0[1]); w.y = cvt_pk_bf16(v0[2], v0[3]); w.z = cvt_pk_bf16(v1[0], v1[1]); w.w = cvt_pk_bf16(v1[2], v1[3]);
                    *(u32x4*)(rowp + bj * HALF) = w; } }
    }
};

__device__ __forceinline__ int fresh_lane_id() { int l; asm volatile("v_mbcnt_lo_u32_b32 %0, -1, 0\n\tv_mbcnt_hi_u32_b32 %0, -1, %0" : "=v"(l)); return l; }
__device__ __forceinline__ void glds16_s(const void* sbase, unsigned voff, unsigned ldsaddr) {
    unsigned keep;
    asm volatile("s_mov_b32 %0, m0\n\ts_mov_b32 m0, %3\n\ts_nop 0\n\tglobal_load_lds_dwordx4 %1, %2\n\ts_mov_b32 m0, %0"
                 : "=&s"(keep) : "v"(voff), "s"(sbase), "s"(ldsaddr) : "memory");
}
template <class E, class = void> struct epi_pf { static constexpr bool value = false; };
template <class E> struct epi_pf<E, decltype((void)E::PREFETCH)> { static constexpr bool value = E::PREFETCH; };
template <class E, class = void> struct epi_chain { static constexpr bool value = false; };
template <class E> struct epi_chain<E, decltype((void)E::CHAIN)> { static constexpr bool value = E::CHAIN; };
template <class Epi, class Sched, bool ALIGN_EPI = false, bool SP2 = false, int EB = 2>
__device__ __forceinline__ void gemm_phase(PG8_LAS unsigned char* lds, const Gemm g, const Sched& S, const Epi& E, const int wave_id  ) {
    int tid_ = wave_id * 64 + fresh_lane_id();
    const int tid = tid_, wid = __builtin_amdgcn_readfirstlane(tid >> 6), lane = tid & 63, wr = wid >> 2, wc = wid & 3, fr = lane & 15, fq = lane >> 4;
    const int K = g.K; int nt = K * EB / 128; asm volatile("" : "+s"(nt));
    unsigned voffA[2], voffB[2];
#pragma unroll
    for (int i = 0; i < 2; ++i) { int R, C; stage_rc(tid * 16 + i * 8192, R, C); const int Rb = Epi::PERM ? ((R & ~31) + perm32(R & 31)) : R;
        voffA[i] = (unsigned)(R * g.lda * EB + C * 2); voffB[i] = (unsigned)(Rb * g.ldb * EB + C * 2); }
    const int wsc = g.wexp * 0x01010101;
    const size_t kstep = (size_t)(BK * 2);
    constexpr bool GA = Sched::GATHER;
    const size_t hstepA = GA ? (size_t)0 : (size_t)HALF * g.lda * EB, hstepB = (size_t)HALF * g.ldb * EB;
    const size_t tstepA = 2 * hstepA, tstepB = 2 * hstepB;
    const unsigned ldsb = (unsigned)(uintptr_t)lds;
    const unsigned ldsw = (unsigned)wid * 1024u;
    const int aoff = lds_byte(wr * 64 + fr, fq * 8), boff = lds_byte(wc * 32 + fr, fq * 8);
#define PG8_SA(b, h) (((b) * 2 + (h)) * HTB)
#define PG8_SB(b, h) ((4 + (b) * 2 + (h)) * HTB)
#define PG8_STAGE(bufoff, gbase, voff) do { _Pragma("unroll") for (int _i = 0; _i < 2; ++_i) glds16_s((const char*)(gbase), (voff)[_i], ldsb + (unsigned)(bufoff) + ldsw + (unsigned)_i * 8192u); } while (0)
#define PG8_LDA(dst, b, h) do { _Pragma("unroll") for (int m = 0; m < 4; ++m) _Pragma("unroll") for (int k = 0; k < 2; ++k) dst[m][k] = *(const PG8_LAS bf16x8*)(lds + PG8_SA(b, h) + aoff + m * 2048 + k * 1024); } while (0)
#define PG8_LDB(dst, b, h) do { _Pragma("unroll") for (int n = 0; n < 2; ++n) _Pragma("unroll") for (int k = 0; k < 2; ++k) dst[n][k] = *(const PG8_LAS bf16x8*)(lds + PG8_SB(b, h) + boff + n * 2048 + k * 1024); } while (0)
#define PG8_MMA(ai, bj, At, Bt) do { __builtin_amdgcn_s_setprio(1); _Pragma("unroll") for (int m = 0; m < 4; ++m) _Pragma("unroll") for (int n = 0; n < 2; ++n) { \
        if constexpr (EB == 2) { _Pragma("unroll") for (int k = 0; k < 2; ++k) acc[ai][bj][m][n] = __builtin_amdgcn_mfma_f32_16x16x32_bf16(Bt[n][k], At[m][k], acc[ai][bj][m][n], 0, 0, 0); } \
        else { acc[ai][bj][m][n] = __builtin_amdgcn_mfma_scale_f32_16x16x128_f8f6f4(cat8(Bt[n][0], Bt[n][1]), cat8(At[m][0], At[m][1]), acc[ai][bj][m][n], 0, 0, 0, wsc, 0, wsc); } } \
        __builtin_amdgcn_s_setprio(0); } while (0)
#define PG8_WAIT_V(n) asm volatile("s_waitcnt vmcnt(" #n ")" ::: "memory")
#define PG8_WAIT_L(n) asm volatile("s_waitcnt lgkmcnt(" #n ")" ::: "memory")
#define PG8_BAR __builtin_amdgcn_s_barrier()
#define PG8_SCHED __builtin_amdgcn_sched_barrier(0)
    Unit cur, nxt; int ui = 0;
    if (!S.next(0, cur)) return;
    f32x4 acc[2][2][4][2];
#pragma unroll
    for (int a = 0; a < 2; ++a)
#pragma unroll
        for (int b = 0; b < 2; ++b)
#pragma unroll
            for (int m = 0; m < 4; ++m)
#pragma unroll
                for (int n = 0; n < 2; ++n) acc[a][b][m][n] = (f32x4){0.f, 0.f, 0.f, 0.f};
    bf16x8 At[4][2], B0[2][2], B1[2][2];
    const char* cA = (const char*)g.A + cur.aoff + (size_t)cur.pm * tstepA; const char* cB = (const char*)g.Bt + cur.boff + (size_t)cur.pn * tstepB;
    unsigned vc0[2], vc1[2];
    PG8_LAS u32x4* gslot = (PG8_LAS u32x4*)(lds + STAGE_BYTES + 1024 + tid * 16);
    if constexpr (GA) { const u32x4 o = S.rows(cur, tid, g.lda * EB); vc0[0] = o.x; vc0[1] = o.y; vc1[0] = o.z; vc1[1] = o.w; } else { vc0[0] = vc1[0] = voffA[0]; vc0[1] = vc1[1] = voffA[1]; }
    S.a_ready(cur);
    if constexpr (SP2) {
        PG8_STAGE(PG8_SB(0, 0), cB, voffB); PG8_STAGE(PG8_SB(0, 1), cB + hstepB, voffB); PG8_STAGE(PG8_SA(0, 0), cA, vc0); PG8_STAGE(PG8_SA(0, 1), cA + hstepA, vc1);
        if (wr == 1) PG8_BAR;
        PG8_WAIT_V(2); PG8_BAR;
        PG8_STAGE(PG8_SB(1, 0), cB + kstep, voffB); PG8_STAGE(PG8_SA(1, 0), cA + kstep, vc0); PG8_STAGE(PG8_SB(1, 1), cB + hstepB + kstep, voffB);
        PG8_WAIT_V(6); PG8_BAR;
    } else {
        PG8_STAGE(PG8_SB(0, 0), cB, voffB); PG8_STAGE(PG8_SA(0, 0), cA, vc0); PG8_STAGE(PG8_SB(0, 1), cB + hstepB, voffB); PG8_STAGE(PG8_SA(0, 1), cA + hstepA, vc1);
        if (wr == 1) PG8_BAR;
        PG8_WAIT_V(4); PG8_BAR;
        PG8_STAGE(PG8_SB(1, 0), cB + kstep, voffB); PG8_STAGE(PG8_SA(1, 0), cA + kstep, vc0); PG8_STAGE(PG8_SB(1, 1), cB + hstepB + kstep, voffB);
        PG8_WAIT_V(6); PG8_BAR;
    }
    for (;;) {
        const bool has_next = S.next(ui + 1, nxt);
        if constexpr (epi_pf<Epi>::value) { cur.pf = ui & 1; E.prefetch(cur, ldsb + (unsigned)STAGE_BYTES + 9216u + (unsigned)(ui & 1) * 2048u, wid, fresh_lane_id() & 63); }
        if constexpr (GA) { if (has_next) S.rows_dma(nxt, tid, ldsb + (unsigned)STAGE_BYTES + 1024u + (unsigned)wid * 256u); }
        const char* nA = has_next ? (const char*)g.A + nxt.aoff + (size_t)nxt.pm * tstepA : cA; const char* nB = has_next ? (const char*)g.Bt + nxt.boff + (size_t)nxt.pn * tstepB : cB;
        const int ntc = cur.ntu ? cur.ntu : nt;
#pragma unroll 1
        for (int t = 0; t < ntc; t += 2) {
            const bool last = (t == ntc - 2);
            const char* a1 = cA + (size_t)(t + 1) * kstep;
            const char* a2 = last ? nA : cA + (size_t)(t + 2) * kstep; const char* b2 = last ? nB : cB + (size_t)(t + 2) * kstep;
            const char* a3 = a2 + kstep; const char* b3 = b2 + kstep;
            if (last && has_next) S.a_ready(nxt);
            if constexpr (SP2) {
            PG8_LDB(B0, 0, 0); PG8_LDB(B1, 0, 1); PG8_SCHED; PG8_LDA(At, 0, 0); PG8_STAGE(PG8_SA(1, 1), a1 + hstepA, vc1);
            if constexpr (GA) { if (last && has_next) { const u32x4 o = *gslot; vc0[0] = o.x; vc0[1] = o.y; vc1[0] = o.z; vc1[1] = o.w; } }
            PG8_WAIT_V(8); PG8_WAIT_L(0); PG8_BAR; PG8_MMA(0, 0, At, B0); PG8_MMA(0, 1, At, B1); PG8_BAR; PG8_SCHED;
            PG8_LDA(At, 0, 1); PG8_STAGE(PG8_SB(0, 0), b2, voffB); PG8_STAGE(PG8_SB(0, 1), b2 + hstepB, voffB); PG8_STAGE(PG8_SA(0, 0), a2, vc0);
            PG8_WAIT_V(8); PG8_WAIT_L(0); PG8_BAR; PG8_MMA(1, 0, At, B0); PG8_MMA(1, 1, At, B1); PG8_BAR; PG8_SCHED;
            PG8_LDB(B0, 1, 0); PG8_LDB(B1, 1, 1); PG8_SCHED; PG8_LDA(At, 1, 0); PG8_STAGE(PG8_SA(0, 1), a2 + hstepA, vc1);
            PG8_WAIT_V(8); PG8_WAIT_L(0); PG8_BAR; PG8_MMA(0, 0, At, B0); PG8_MMA(0, 1, At, B1); PG8_BAR; PG8_SCHED;
            PG8_LDA(At, 1, 1); PG8_STAGE(PG8_SB(1, 0), b3, voffB); PG8_STAGE(PG8_SB(1, 1), b3 + hstepB, voffB); PG8_STAGE(PG8_SA(1, 0), a3, vc0);
            PG8_WAIT_V(8); PG8_WAIT_L(0); PG8_BAR; PG8_MMA(1, 0, At, B0); PG8_MMA(1, 1, At, B1); PG8_BAR; PG8_SCHED;
            } else {
            PG8_LDB(B0, 0, 0); PG8_SCHED; PG8_LDA(At, 0, 0); PG8_STAGE(PG8_SA(1, 1), a1 + hstepA, vc1);
            if constexpr (GA) { if (last && has_next) { if (ntc <= 2) PG8_WAIT_V(0);
                const u32x4 o = S.rows_lds(nxt, tid, g.lda * EB, lds + STAGE_BYTES + 1024 + wid * 256 + lane * 4); vc0[0] = o.x; vc0[1] = o.y; vc1[0] = o.z; vc1[1] = o.w; } }
            PG8_WAIT_L(8); PG8_BAR; PG8_WAIT_L(0); PG8_MMA(0, 0, At, B0); PG8_BAR; PG8_SCHED;
            PG8_LDB(B1, 0, 1); PG8_STAGE(PG8_SB(0, 0), b2, voffB);
            PG8_BAR; PG8_WAIT_L(0); PG8_MMA(0, 1, At, B1); PG8_BAR;
            PG8_LDA(At, 0, 1); PG8_STAGE(PG8_SA(0, 0), a2, vc0);
            PG8_BAR; PG8_WAIT_L(0); PG8_MMA(1, 0, At, B0); PG8_BAR; PG8_SCHED;
            PG8_STAGE(PG8_SB(0, 1), b2 + hstepB, voffB);
            PG8_WAIT_V(6); PG8_BAR; PG8_MMA(1, 1, At, B1); PG8_BAR;
            PG8_LDB(B0, 1, 0); PG8_SCHED; PG8_LDA(At, 1, 0); PG8_STAGE(PG8_SA(0, 1), a2 + hstepA, vc1);
            PG8_WAIT_L(8); PG8_BAR; PG8_WAIT_L(0); PG8_MMA(0, 0, At, B0); PG8_BAR; PG8_SCHED;
            PG8_LDB(B1, 1, 1); PG8_STAGE(PG8_SB(1, 0), b3, voffB);
            PG8_BAR; PG8_WAIT_L(0); PG8_MMA(0, 1, At, B1); PG8_BAR;
            PG8_LDA(At, 1, 1); PG8_STAGE(PG8_SA(1, 0), a3, vc0);
            PG8_BAR; PG8_WAIT_L(0); PG8_MMA(1, 0, At, B0); PG8_BAR; PG8_SCHED;
            PG8_STAGE(PG8_SB(1, 1), b3 + hstepB, voffB);
            PG8_WAIT_V(6); PG8_BAR; PG8_MMA(1, 1, At, B1); PG8_BAR;
            }
        }
        if constexpr (ALIGN_EPI) { if (wr == 0) PG8_BAR; }
        if constexpr (!Epi::AFTER_DRAIN) { const int l2_ = fresh_lane_id();
            Unit ue_ = cur; asm volatile("" : "+s"(ue_.pm), "+s"(ue_.pn), "+s"(ue_.po), "+s"(ue_.lb), "+s"(ue_.nvalid));
            E(acc, ue_, wr, wc, l2_ & 15, l2_ >> 4); S.done(cur); }
        if (!has_next) break;
        if (!(epi_chain<Epi>::value && cur.stage == 0))
#pragma unroll
        for (int a = 0; a < 2; ++a)
#pragma unroll
            for (int b = 0; b < 2; ++b)
#pragma unroll
                for (int m = 0; m < 4; ++m)
#pragma unroll
                    for (int n = 0; n < 2; ++n) acc[a][b][m][n] = (f32x4){0.f, 0.f, 0.f, 0.f};
        cur = nxt; cA = nA; cB = nB; ++ui;

        if constexpr (ALIGN_EPI) { if (wr == 1) PG8_BAR; }
    }
    PG8_WAIT_V(0);
    if constexpr (!ALIGN_EPI) { if (wr == 0) PG8_BAR; }
    PG8_BAR;
    if constexpr (Epi::AFTER_DRAIN) { E.fused(acc, cur, wr, wc, fr, fq, lds, wid, lane); S.done(cur); }
#undef PG8_SA
#undef PG8_SB
#undef PG8_STAGE
#undef PG8_LDA
#undef PG8_LDB
#undef PG8_MMA
#undef PG8_WAIT_V
#undef PG8_WAIT_L
#undef PG8_BAR
#undef PG8_SCHED
}
}

namespace pg8 {
__device__ __forceinline__ float fsigmoid(float x) { return __builtin_amdgcn_rcpf(1.0f + __builtin_amdgcn_exp2f(-1.4426950408889634f * x)); }
__device__ __forceinline__ float bflo(unsigned w) { return __uint_as_float(w << 16); }
__device__ __forceinline__ float bfhi(unsigned w) { return __uint_as_float(w & 0xffff0000u); }
__device__ __forceinline__ u32x4 pack8(const f32x4 a, const f32x4 b) { u32x4 w; w.x = cvt_pk_bf16(a[0], a[1]); w.y = cvt_pk_bf16(a[2], a[3]); w.z = cvt_pk_bf16(b[0], b[1]); w.w = cvt_pk_bf16(b[2], b[3]); return w; }

typedef unsigned long long stat_t;
__device__ __forceinline__ float ld_stat(const stat_t* p) { return (float)(*p) * (1.0f / 16777216.0f); }
__device__ __forceinline__ float rstd_of(const stat_t* ss, int row, float inv_n) { return __builtin_amdgcn_rsqf(ld_stat(ss + row) * inv_n + 1e-6f); }
__device__ __forceinline__ void stat_dma(const stat_t* ss, int rowbase, unsigned ldsaddr, int wid, int lane) { unsigned keep; const unsigned voff = (unsigned)(rowbase + 32 * wid) * 8u + 4u * (unsigned)lane;
    asm volatile("s_mov_b32 %0, m0\n\ts_mov_b32 m0, %3\n\ts_nop 0\n\tglobal_load_lds_dword %1, %2\n\ts_mov_b32 m0, %0" : "=&s"(keep) : "v"(voff), "s"(ss), "s"(ldsaddr + (unsigned)wid * 256u) : "memory"); }
__device__ __forceinline__ float rstd_lds(const PG8_LAS unsigned char* tab, int rl, float inv_n) { return __builtin_amdgcn_rsqf((float)(*(const PG8_LAS stat_t*)(tab + rl * 8)) * (1.0f / 16777216.0f) * inv_n + 1e-6f); }
#define STAT_TAB(u_) (lds + STAGE_BYTES + 9216 + (u_).pf * 2048)
__device__ __forceinline__ float sumsq8(const f32x4 a, const f32x4 b) { return ((a[0] * a[0] + a[1] * a[1]) + (a[2] * a[2] + a[3] * a[3])) + ((b[0] * b[0] + b[1] * b[1]) + (b[2] * b[2] + b[3] * b[3])); }
__device__ __forceinline__ float xsum32(float x) { auto t = __builtin_amdgcn_permlane32_swap(__float_as_uint(x), __float_as_uint(x), false, false); return __uint_as_float(t[0]) + __uint_as_float(t[1]); }
__device__ __forceinline__ float xsum16(float x) { auto s = __builtin_amdgcn_permlane16_swap(__float_as_uint(x), __float_as_uint(x), false, false); return __uint_as_float(s[0]) + __uint_as_float(s[1]); }
__device__ __forceinline__ float xother32(float x, int hi) { auto t = __builtin_amdgcn_permlane32_swap(__float_as_uint(x), __float_as_uint(x), false, false); return __uint_as_float(hi ? t[0] : t[1]); }
template <int CTRL> __device__ __forceinline__ float dppmov(float x) { return __builtin_bit_cast(float, __builtin_amdgcn_mov_dpp(__builtin_bit_cast(int, x), CTRL, 0xf, 0xf, true)); }
__device__ __forceinline__ float wave_sum64(float v) {
    v += dppmov<0xB1>(v); v += dppmov<0x4E>(v); v += dppmov<0x141>(v); v += dppmov<0x128>(v); v = xsum16(v); return xsum32(v); }
__device__ __forceinline__ void row_atomic(stat_t* dst, float part, int fq) { part = xsum16(part); part = xsum32(part);
    if (fq == 0) __hip_atomic_fetch_add(dst, (stat_t)(part * 16777216.0f + 0.5f), __ATOMIC_RELAXED, __HIP_MEMORY_SCOPE_AGENT); }
struct EpiQ {
    static constexpr bool PERM = true, AFTER_DRAIN = false;
    const stat_t* ssq; const float* rope; const float* g; bf16_t* Qh; PG8_LAS unsigned char* lds;
    static constexpr bool PREFETCH = true;
    __device__ __forceinline__ void prefetch(const Unit& u, unsigned tab, int wid, int lane) const { stat_dma(ssq, u.pm * BM, tab, wid, lane); }
    __device__ __forceinline__ void operator()(f32x4 (&acc)[2][2][4][2], const Unit& u, int wr, int wc, int fr, int fq) const {
        const int rl0 = wr * 64 + fr, row0 = u.pm * BM + rl0;
        PG8_LAS float* part = (PG8_LAS float*)(lds + STAGE_BYTES + 1024);
        float rsv[2][4];
#pragma unroll
        for (int ai = 0; ai < 2; ++ai)
#pragma unroll
            for (int m = 0; m < 4; ++m) rsv[ai][m] = rstd_lds(STAT_TAB(u), rl0 + ai * HALF + m * 16, 1.0f / 256.0f);
#pragma unroll
        for (int ai = 0; ai < 2; ++ai)
#pragma unroll
            for (int m = 0; m < 4; ++m) { const float rs = rsv[ai][m];
#pragma unroll
                for (int bj = 0; bj < 2; ++bj) { acc[ai][bj][m][0] = acc[ai][bj][m][0] * rs; acc[ai][bj][m][1] = acc[ai][bj][m][1] * rs;
                    float p = sumsq8(acc[ai][bj][m][0], acc[ai][bj][m][1]); p = xsum16(p); p = xsum32(p);
                    if (fq == 0) part[((rl0 + ai * HALF + m * 16) * 2 + bj) * 4 + wc] = p; } }
        asm volatile("s_waitcnt lgkmcnt(0)" ::: "memory");
        __builtin_amdgcn_s_barrier();
        float gv[8];
#pragma unroll
        for (int j = 0; j < 8; ++j) gv[j] = wc < 3 ? g[wc * 32 + 8 * fq + j] : 0.f;
        const int hi = fq >> 1; const float sgn = hi ? 1.0f : -1.0f;
#pragma unroll
        for (int ai = 0; ai < 2; ++ai) {
            f32x4 c0v[4], c1v[4], s0v[4], s1v[4];
#pragma unroll
            for (int m = 0; m < 4; ++m) { c0v[m] = (f32x4){0.f, 0.f, 0.f, 0.f}; c1v[m] = c0v[m]; s0v[m] = c0v[m]; s1v[m] = c0v[m]; }
            if (wc == 2) {
#pragma unroll
                for (int m = 0; m < 4; ++m) { const float* cs = rope + (unsigned)((row0 + ai * HALF + m * 16) * 32 + 8 * (fq & 1)); c0v[m] = *(const f32x4*)cs; c1v[m] = *(const f32x4*)(cs + 4); s0v[m] = *(const f32x4*)(cs + 16); s1v[m] = *(const f32x4*)(cs + 20); }
                asm volatile("" : "+v"(c0v[0]), "+v"(c0v[1]), "+v"(c0v[2]), "+v"(c0v[3]), "+v"(c1v[0]), "+v"(c1v[1]), "+v"(c1v[2]), "+v"(c1v[3]), "+v"(s0v[0]), "+v"(s0v[1]), "+v"(s0v[2]), "+v"(s0v[3]), "+v"(s1v[0]), "+v"(s1v[1]), "+v"(s1v[2]), "+v"(s1v[3])); }
#pragma unroll
            for (int m = 0; m < 4; ++m) { const int rl = rl0 + ai * HALF + m * 16, tok = u.pm * BM + rl, b = tok >> 12, sq_ = tok & (SEQ - 1);
                const f32x4 cc0 = c0v[m], cc1 = c1v[m], sn0 = s0v[m], sn1 = s1v[m];
#pragma unroll
                for (int bj = 0; bj < 2; ++bj) { const int h = u.pn * 2 + bj;
                    const f32x4 pp = *(const PG8_LAS f32x4*)(part + (rl * 2 + bj) * 4);
                    const float rstd = QSCALE * __builtin_amdgcn_rsqf(((pp[0] + pp[1]) + (pp[2] + pp[3])) * (1.0f / 96.0f) + EPS);
                    f32x4 t0 = acc[ai][bj][m][0] * rstd, t1 = acc[ai][bj][m][1] * rstd;
#pragma unroll
                    for (int k = 0; k < 4; ++k) { t0[k] *= gv[k]; t1[k] *= gv[4 + k]; }
                    if (wc == 2) {
#pragma unroll
                        for (int k = 0; k < 4; ++k) { const float p0 = xother32(t0[k], hi), p1 = xother32(t1[k], hi);
                            t0[k] = t0[k] * cc0[k] + sgn * p0 * sn0[k]; t1[k] = t1[k] * cc1[k] + sgn * p1 * sn1[k]; } }
                    if (wc < 3) *(u32x4*)(Qh + (unsigned)(((b * NH + h) * SEQ + sq_) * DQK + wc * 32 + 8 * fq)) = pack8(t0, t1); } } }
    }
};
struct EpiK {
    static constexpr bool PERM = true, AFTER_DRAIN = false;
    const stat_t* sskv; const bf16_t* ckv; const float* rope; const float* g; bf16_t* Kh; PG8_LAS unsigned char* lds;
    static constexpr bool PREFETCH = true;
    __device__ __forceinline__ void prefetch(const Unit& u, unsigned tab, int wid, int lane) const { stat_dma(sskv, u.pm * BM, tab, wid, lane); }
    __device__ __forceinline__ void operator()(f32x4 (&acc)[2][2][4][2], const Unit& u, int wr, int wc, int fr, int fq) const {
        const int rl0 = wr * 64 + fr, row0 = u.pm * BM + rl0;
        PG8_LAS float* part = (PG8_LAS float*)(lds + STAGE_BYTES + 1024);
        float rsv[2][4];
#pragma unroll
        for (int ai = 0; ai < 2; ++ai)
#pragma unroll
            for (int m = 0; m < 4; ++m) rsv[ai][m] = rstd_lds(STAT_TAB(u), rl0 + ai * HALF + m * 16, 1.0f / 128.0f);
        u32x4 pk[2][2][4];
#pragma unroll
        for (int ai = 0; ai < 2; ++ai)
#pragma unroll
            for (int m = 0; m < 4; ++m) { const float rs = rsv[ai][m];
#pragma unroll
                for (int bj = 0; bj < 2; ++bj) { const f32x4 v0 = acc[ai][bj][m][0] * rs, v1 = acc[ai][bj][m][1] * rs;
                    float p = sumsq8(v0, v1); p = xsum16(p); p = xsum32(p);
                    if (fq == 0) part[((rl0 + ai * HALF + m * 16) * 4 + 2 * bj + (wc >> 1)) * 2 + (wc & 1)] = p;
                    pk[ai][bj][m] = pack8(v0, v1); } }
        asm volatile("s_waitcnt lgkmcnt(0)" ::: "memory");
        __builtin_amdgcn_s_barrier();
        float gn[8], gr[8];
#pragma unroll
        for (int j = 0; j < 8; ++j) { gn[j] = g[(wc & 1) * 32 + 8 * fq + j]; gr[j] = g[64 + 8 * fq + j]; }
        const int hi = fq >> 1; const float sgn = hi ? 1.0f : -1.0f;
#pragma unroll
        for (int ai = 0; ai < 2; ++ai) {
            u32x4 krv[4]; f32x4 cc0[4], cc1[4], sn0[4], sn1[4];
#pragma unroll
            for (int m = 0; m < 4; ++m) { const int tok = row0 + ai * HALF + m * 16; krv[m] = *(const u32x4*)(ckv + (unsigned)(tok * 256 + 128 + 8 * fq));
                const float* cs = rope + (unsigned)(tok * 32 + 8 * (fq & 1)); cc0[m] = *(const f32x4*)cs; cc1[m] = *(const f32x4*)(cs + 4); sn0[m] = *(const f32x4*)(cs + 16); sn1[m] = *(const f32x4*)(cs + 20); }
            asm volatile("" : "+v"(krv[0]), "+v"(krv[1]), "+v"(krv[2]), "+v"(krv[3]), "+v"(cc0[0]), "+v"(cc0[1]), "+v"(cc0[2]), "+v"(cc0[3]), "+v"(cc1[0]), "+v"(cc1[1]), "+v"(cc1[2]), "+v"(cc1[3]));
            asm volatile("" : "+v"(sn0[0]), "+v"(sn0[1]), "+v"(sn0[2]), "+v"(sn0[3]), "+v"(sn1[0]), "+v"(sn1[1]), "+v"(sn1[2]), "+v"(sn1[3]));
#pragma unroll
            for (int m = 0; m < 4; ++m) { const int rl = rl0 + ai * HALF + m * 16, tok = u.pm * BM + rl, b = tok >> 12, sq_ = tok & (SEQ - 1);
                const u32x4 kw = krv[m];
                const f32x4 r0 = (f32x4){bflo(kw.x), bfhi(kw.x), bflo(kw.y), bfhi(kw.y)}, r1 = (f32x4){bflo(kw.z), bfhi(kw.z), bflo(kw.w), bfhi(kw.w)};
                float rss = sumsq8(r0, r1); rss = xsum16(rss); rss = xsum32(rss);
                const f32x4 pa = *(const PG8_LAS f32x4*)(part + rl * 8), pb = *(const PG8_LAS f32x4*)(part + rl * 8 + 4);
                const float hs[4] = {pa[0] + pa[1], pa[2] + pa[3], pb[0] + pb[1], pb[2] + pb[3]};
                { const float tot = (wc == 0 ? hs[0] : wc == 1 ? hs[1] : wc == 2 ? hs[2] : hs[3]) + rss; const float rstd = __builtin_amdgcn_rsqf(tot * (1.0f / 96.0f) + EPS);
                  f32x4 t0 = r0 * rstd, t1 = r1 * rstd;
#pragma unroll
                  for (int k = 0; k < 4; ++k) { t0[k] *= gr[k]; t1[k] *= gr[4 + k]; }
#pragma unroll
                  for (int k = 0; k < 4; ++k) { const float p0 = xother32(t0[k], hi), p1 = xother32(t1[k], hi);
                      t0[k] = t0[k] * cc0[m][k] + sgn * p0 * sn0[m][k]; t1[k] = t1[k] * cc1[m][k] + sgn * p1 * sn1[m][k]; }
                  *(u32x4*)(Kh + (unsigned)(((b * NH + u.pn * 4 + wc) * SEQ + sq_) * DQK + 64 + 8 * fq)) = pack8(t0, t1); }
#pragma unroll
                for (int bj = 0; bj < 2; ++bj) { const int hl = 2 * bj + (wc >> 1);
                    const float tot = (bj == 0 ? ((wc >> 1) ? hs[1] : hs[0]) : ((wc >> 1) ? hs[3] : hs[2])) + rss; const float rstd = __builtin_amdgcn_rsqf(tot * (1.0f / 96.0f) + EPS);
                    const u32x4 w = pk[ai][bj][m];
                    f32x4 t0 = (f32x4){bflo(w.x), bfhi(w.x), bflo(w.y), bfhi(w.y)} * rstd, t1 = (f32x4){bflo(w.z), bfhi(w.z), bflo(w.w), bfhi(w.w)} * rstd;
#pragma unroll
                    for (int k = 0; k < 4; ++k) { t0[k] *= gn[k]; t1[k] *= gn[4 + k]; }
                    *(u32x4*)(Kh + (unsigned)(((b * NH + u.pn * 4 + hl) * SEQ + sq_) * DQK + (wc & 1) * 32 + 8 * fq)) = pack8(t0, t1); } } }
    }
};
struct EpiStore {
    static constexpr bool PERM = true, AFTER_DRAIN = false;
    bf16_t* O; int ldc; const stat_t* css; float cinv;
    __device__ __forceinline__ void operator()(const f32x4 (&acc)[2][2][4][2], const Unit& u, int wr, int wc, int fr, int fq) const {
        const int row0 = u.pm * BM + wr * 64 + fr, col0 = u.pn * BM + wc * 32 + 8 * fq;
        f32x4 cs[2][2];
#pragma unroll
        for (int bj = 0; bj < 2; ++bj)
#pragma unroll
            for (int n = 0; n < 2; ++n)
#pragma unroll
                for (int k = 0; k < 4; ++k) cs[bj][n][k] = css ? rstd_of(css, col0 + bj * HALF + 4 * n + k, cinv) : 1.0f;
#pragma unroll
        for (int ai = 0; ai < 2; ++ai)
#pragma unroll
            for (int m = 0; m < 4; ++m) { bf16_t* rowp = O + (size_t)(row0 + ai * HALF + m * 16) * ldc + col0;
#pragma unroll
                for (int bj = 0; bj < 2; ++bj) *(u32x4*)(rowp + bj * HALF) = pack8(acc[ai][bj][m][0] * cs[bj][0], acc[ai][bj][m][1] * cs[bj][1]); }
    }
};
struct EpiStoreVt {
    static constexpr bool PERM = true, AFTER_DRAIN = false;
    bf16_t* O; const stat_t* css; float cinv;
    __device__ __forceinline__ void operator()(const f32x4 (&acc)[2][2][4][2], const Unit& u, int wr, int wc, int fr, int fq) const {
        const int row0 = u.pm * BM + wr * 64 + fr, col0 = u.pn * BM + wc * 32 + 8 * fq;
        f32x4 cs[2][2];
#pragma unroll
        for (int bj = 0; bj < 2; ++bj)
#pragma unroll
            for (int n = 0; n < 2; ++n)
#pragma unroll
                for (int k = 0; k < 4; ++k) cs[bj][n][k] = rstd_of(css, col0 + bj * HALF + 4 * n + k, cinv);
#pragma unroll
        for (int ai = 0; ai < 2; ++ai)
#pragma unroll
            for (int m = 0; m < 4; ++m) { const int row = row0 + ai * HALF + m * 16;
#pragma unroll
                for (int bj = 0; bj < 2; ++bj) { const int tok = col0 + bj * HALF;
                    const size_t off = ((size_t)((tok >> 12) * 8 + (row >> 6)) * 64 + ((tok & 4095) >> 6)) * 4096 + (size_t)(row & 63) * 64 + (tok & 63);
                    *(u32x4*)(O + off) = pack8(acc[ai][bj][m][0] * cs[bj][0], acc[ai][bj][m][1] * cs[bj][1]); } }
    }
};
struct EpiProj {
    static constexpr bool PERM = true, AFTER_DRAIN = false;
    bf16_t* R2; const stat_t* ssx; stat_t* ssq; stat_t* sskv; bf16_t* halo; PG8_LAS unsigned char* lds;
    static constexpr bool PREFETCH = true;
    __device__ __forceinline__ void prefetch(const Unit& u, unsigned tab, int wid, int lane) const { stat_dma(ssx, u.pm * BM, tab, wid, lane); }
    __device__ __forceinline__ void operator()(const f32x4 (&acc)[2][2][4][2], const Unit& u, int wr, int wc, int fr, int fq) const {
        const int pn = u.pn; size_t off; int ldc, ct; bool sg = false;
        if (pn == 0)      { off = 0;               ldc = 256;  ct = 0; }
        else if (pn == 1) { off = (size_t)8 << 20;  ldc = 256;  ct = 0; }
        else if (pn < 4)  { off = (size_t)16 << 20; ldc = 512;  ct = pn - 2; }
        else if (pn < 6)  { off = (size_t)32 << 20; ldc = 512;  ct = pn - 4; }
        else if (pn < 10) { off = (size_t)48 << 20; ldc = 1024; ct = pn - 6; sg = true; }
        else              { off = (size_t)80 << 20; ldc = 1024; ct = pn - 10; sg = true; }
        const int row0 = u.pm * BM + wr * 64 + fr, col0 = ct * BM + wc * 32 + 8 * fq;
        bf16_t* O = R2 + off;
        bf16_t* gp = O + ((size_t)((u.pm * 4 + ct) * 8 + wr * 4 + wc) * 1024 + fq * 16 + fr) * 8;
        const PG8_LAS unsigned char* stab = STAT_TAB(u) + (wr * 64 + fr) * 8;
#pragma unroll
        for (int ai = 0; ai < 2; ++ai)
#pragma unroll
            for (int m = 0; m < 4; ++m) { const int row = row0 + ai * HALF + m * 16; bf16_t* rowp = O + (size_t)row * ldc + col0;
                const float rs = rstd_lds(stab, ai * HALF + m * 16, 1.0f / 1024.0f);
                f32x4 v[2][2];
#pragma unroll
                for (int bj = 0; bj < 2; ++bj) { v[bj][0] = acc[ai][bj][m][0] * rs; v[bj][1] = acc[ai][bj][m][1] * rs; }
                if (pn == 0) row_atomic(ssq + row, sumsq8(v[0][0], v[0][1]) + sumsq8(v[1][0], v[1][1]), fq);
                if (pn == 1) row_atomic(sskv + row, sumsq8(v[0][0], v[0][1]), fq);
#pragma unroll
                for (int bj = 0; bj < 2; ++bj) {
                    if (sg) {
                        f32x4 t0, t1;
#pragma unroll
                        for (int k = 0; k < 4; ++k) { t0[k] = __builtin_amdgcn_exp2f(-v[bj][0][k]); t1[k] = __builtin_amdgcn_exp2f(-v[bj][1][k]); }
                        t0 = t0 + 1.0f; t1 = t1 + 1.0f;
#pragma unroll
                        for (int k = 0; k < 4; ++k) { v[bj][0][k] = __builtin_amdgcn_rcpf(t0[k]); v[bj][1][k] = __builtin_amdgcn_rcpf(t1[k]); } }
                    const u32x4 pk = pack8(v[bj][0], v[bj][1]); *(u32x4*)(sg ? gp + (ai * 8 + m * 2 + bj) * 512 : rowp + bj * HALF) = pk;
                    if ((pn == 2 || pn == 3) && (row & 127) >= 125) *(u32x4*)(halo + ((size_t)(row >> 7) * 3 + (row & 127) - 125) * 512 + col0 + bj * HALF) = pk; } }
    }
};
struct EpiMerge {
    static constexpr bool PERM = true, AFTER_DRAIN = false, CHAIN = true;
    const bf16_t* Ga; const bf16_t* Gb; bf16_t* O;
    __device__ __forceinline__ void operator()(f32x4 (&acc)[2][2][4][2], const Unit& u, int wr, int wc, int fr, int fq) const {
        const int row0 = u.pm * BM + wr * 64 + fr, col0 = u.pn * BM + wc * 32 + 8 * fq;
        const float FLOOR = 8.6736174e-19f;
        const size_t g0 = ((size_t)((u.pm * 4 + u.pn) * 8 + wr * 4 + wc) * 1024 + fq * 16 + fr) * 8;
#define PIN8(a) asm volatile("" : "+v"(a[0][0]), "+v"(a[0][1]), "+v"(a[1][0]), "+v"(a[1][1]), "+v"(a[2][0]), "+v"(a[2][1]), "+v"(a[3][0]), "+v"(a[3][1]))
#pragma unroll
        for (int ai = 0; ai < 2; ++ai) {
            u32x4 gbv[4][2], gav[4][2];
#pragma unroll
            for (int m = 0; m < 4; ++m)
#pragma unroll
                for (int bj = 0; bj < 2; ++bj) { const size_t go = g0 + (ai * 8 + m * 2 + bj) * 512; gbv[m][bj] = *(const u32x4*)(Gb + go); if (u.stage == 0) gav[m][bj] = __builtin_nontemporal_load((const u32x4*)(Ga + go)); }
            PIN8(gbv); if (u.stage == 0) PIN8(gav);
#pragma unroll
            for (int m = 0; m < 4; ++m) { const size_t ro = (size_t)(row0 + ai * HALF + m * 16) * 1024 + col0;
#pragma unroll
                for (int bj = 0; bj < 2; ++bj) { const u32x4 gb = gbv[m][bj];
                    float sb[8] = {bflo(gb.x), bfhi(gb.x), bflo(gb.y), bfhi(gb.y), bflo(gb.z), bfhi(gb.z), bflo(gb.w), bfhi(gb.w)};
#pragma unroll
                    for (int k = 0; k < 8; ++k) sb[k] = fmaxf(sb[k], FLOOR);
                    if (u.stage == 0) { const u32x4 ga = gav[m][bj];
                        const float sa[8] = {bflo(ga.x), bfhi(ga.x), bflo(ga.y), bfhi(ga.y), bflo(ga.z), bfhi(ga.z), bflo(ga.w), bfhi(ga.w)};
#pragma unroll
                        for (int k = 0; k < 4; ++k) { acc[ai][bj][m][0][k] *= sa[k] * __builtin_amdgcn_rcpf(sb[k]); acc[ai][bj][m][1][k] *= sa[4 + k] * __builtin_amdgcn_rcpf(sb[4 + k]); }
                    } else { f32x4 v0 = acc[ai][bj][m][0], v1 = acc[ai][bj][m][1];
#pragma unroll
                        for (int k = 0; k < 4; ++k) { v0[k] *= sb[k]; v1[k] *= sb[4 + k]; }
                        *(u32x4*)(O + ro + bj * HALF) = pack8(v0, v1); } } } }
    }
};
struct MergeOrder {
    static constexpr bool GATHER = false;
    StaticOrder S; size_t aoff1, boff1;
    __device__ __forceinline__ bool next(int i, Unit& u) const { if (!S.next(i >> 1, u)) return false; if (i & 1) { u.stage = 1; u.aoff = aoff1; u.boff = boff1; } return true; }
    __device__ __forceinline__ u32x4 rows(const Unit&, int, int) const { return (u32x4){0u, 0u, 0u, 0u}; }
    __device__ __forceinline__ void a_ready(const Unit&) const {}
    __device__ __forceinline__ void done(const Unit&) const {}
};
constexpr int XRP = 2048;
struct EpiResid {
    static constexpr bool PERM = true, AFTER_DRAIN = false;
    const float* base32; bf16_t* xr; unsigned char* x8; stat_t* ss;
    __device__ __forceinline__ void operator()(const f32x4 (&acc)[2][2][4][2], const Unit& u, int wr, int wc, int fr, int fq) const {
        const int row0 = u.pm * BM + wr * 64 + fr, col0 = u.pn * BM + wc * 32 + 8 * fq;
        u32x4 wv[2][2][2]; f32x4 b0v[1][2][2], b1v[1][2][2];
#define PIN4(a) asm volatile("" : "+v"(a[0][0]), "+v"(a[0][1]), "+v"(a[1][0]), "+v"(a[1][1]))
#define RESID_LOAD(B_, AI_, MH_) do { \
            if (base32) { _Pragma("unroll") for (int mm = 0; mm < 2; ++mm) _Pragma("unroll") for (int bj = 0; bj < 2; ++bj) { const size_t ro_ = (size_t)(row0 + (AI_) * HALF + (2 * (MH_) + mm) * 16) * 1024 + col0 + bj * HALF; \
                    b0v[B_][mm][bj] = __builtin_nontemporal_load((const f32x4*)(base32 + ro_)); b1v[B_][mm][bj] = __builtin_nontemporal_load((const f32x4*)(base32 + ro_ + 4)); } } \
            else { _Pragma("unroll") for (int mm = 0; mm < 2; ++mm) _Pragma("unroll") for (int bj = 0; bj < 2; ++bj) wv[B_][mm][bj] = *(const u32x4*)(xr + (size_t)(row0 + (AI_) * HALF + (2 * (MH_) + mm) * 16) * XRP + col0 + bj * HALF); } } while (0)
        if (!base32) RESID_LOAD(0, 0, 0);
#pragma unroll
        for (int bt = 0; bt < 4; ++bt) { const int ai = bt >> 1, mh = bt & 1, cb_ = bt & 1;
            if (base32) { RESID_LOAD(0, ai, mh); PIN4(b0v[0]); PIN4(b1v[0]); }
            else { PIN4(wv[cb_]); if (bt + 1 < 4) RESID_LOAD(cb_ ^ 1, (bt + 1) >> 1, (bt + 1) & 1); }
#pragma unroll
            for (int mm = 0; mm < 2; ++mm) { const int m = 2 * mh + mm; const int row = row0 + ai * HALF + m * 16; const size_t ro = (size_t)row * 1024 + col0, rx = (size_t)row * XRP + col0; float part = 0.f;
#pragma unroll
                for (int bj = 0; bj < 2; ++bj) { f32x4 b0, b1;
                    if (base32) { b0 = b0v[0][mm][bj]; b1 = b1v[0][mm][bj]; }
                    else { const u32x4 w = wv[cb_][mm][bj]; b0 = (f32x4){bflo(w.x), bfhi(w.x), bflo(w.y), bfhi(w.y)}; b1 = (f32x4){bflo(w.z), bfhi(w.z), bflo(w.w), bfhi(w.w)}; }
                    const f32x4 o0 = b0 + acc[ai][bj][m][0], o1 = b1 + acc[ai][bj][m][1];
                    *(u32x4*)(xr + rx + bj * HALF) = pack8(o0, o1);
                    if (ss) part += sumsq8(o0, o1);
                    if (x8) { f32x2 w; int lo = __builtin_amdgcn_cvt_pk_fp8_f32(o0[0], o0[1], 0, false); lo = __builtin_amdgcn_cvt_pk_fp8_f32(o0[2], o0[3], lo, true);
                              int hi = __builtin_amdgcn_cvt_pk_fp8_f32(o1[0], o1[1], 0, false); hi = __builtin_amdgcn_cvt_pk_fp8_f32(o1[2], o1[3], hi, true);
                              w[0] = __builtin_bit_cast(float, lo); w[1] = __builtin_bit_cast(float, hi); *(f32x2*)(x8 + ro + bj * HALF) = w; } }
                if (ss) row_atomic(ss + row, part, fq); } }
#undef RESID_LOAD
#undef PIN4
    }
};
struct EpiSwiglu {
    static constexpr bool PERM = true, AFTER_DRAIN = false;
    bf16_t* O; int ldc; const stat_t* ssx; int f8; PG8_LAS unsigned char* lds;
    static constexpr bool PREFETCH = true;
    __device__ __forceinline__ void prefetch(const Unit& u, unsigned tab, int wid, int lane) const { if (ssx) stat_dma(ssx, u.po * BM, tab, wid, lane); }
    __device__ __forceinline__ void operator()(const f32x4 (&acc)[2][2][4][2], const Unit& u, int wr, int wc, int fr, int fq) const {
        const int row0 = u.po * BM + wr * 64 + fr, col0 = u.pn * HALF + wc * 32 + 8 * fq;
        float rsv[2][4];
        if (ssx) {
#pragma unroll
            for (int ai = 0; ai < 2; ++ai)
#pragma unroll
                for (int m = 0; m < 4; ++m) rsv[ai][m] = rstd_lds(STAT_TAB(u), wr * 64 + fr + ai * HALF + m * 16, 1.0f / 1024.0f);
        }
#pragma unroll
        for (int ai = 0; ai < 2; ++ai)
#pragma unroll
            for (int m = 0; m < 4; ++m) { const int row = row0 + ai * HALF + m * 16;
                f32x4 g0 = acc[ai][0][m][0], g1 = acc[ai][0][m][1], p0 = acc[ai][1][m][0], p1 = acc[ai][1][m][1];
                if (ssx) { const float rs = rsv[ai][m]; g0 = g0 * rs; g1 = g1 * rs; p0 = p0 * rs; p1 = p1 * rs; }
                f32x4 t0, t1;
#pragma unroll
                for (int k = 0; k < 4; ++k) { t0[k] = __builtin_amdgcn_exp2f(-g0[k]); t1[k] = __builtin_amdgcn_exp2f(-g1[k]); }
                t0 = t0 + 1.0f; t1 = t1 + 1.0f; p0 = p0 * g0; p1 = p1 * g1;
#pragma unroll
                for (int k = 0; k < 4; ++k) { t0[k] = __builtin_amdgcn_rcpf(t0[k]); t1[k] = __builtin_amdgcn_rcpf(t1[k]); }
                const f32x4 v0 = p0 * t0, v1 = p1 * t1;
                if (f8) { int lo = __builtin_amdgcn_cvt_pk_fp8_f32(v0[0], v0[1], 0, false); lo = __builtin_amdgcn_cvt_pk_fp8_f32(v0[2], v0[3], lo, true);
                          int hi = __builtin_amdgcn_cvt_pk_fp8_f32(v1[0], v1[1], 0, false); hi = __builtin_amdgcn_cvt_pk_fp8_f32(v1[2], v1[3], hi, true);
                          f32x2 w; w[0] = __builtin_bit_cast(float, lo); w[1] = __builtin_bit_cast(float, hi); *(f32x2*)((unsigned char*)O + (size_t)row * ldc + col0) = w; }
                else *(u32x4*)(O + (size_t)row * ldc + col0) = pack8(v0, v1); }
    }
};
struct EpiMoeDown {
    static constexpr bool PERM = true, AFTER_DRAIN = false;
    bf16_t* Y; const float* list_w; bf16_t* Y2; PG8_LAS unsigned char* lds;
    static constexpr bool PREFETCH = true;
    __device__ __forceinline__ void prefetch(const Unit& u, unsigned tab, int wid, int lane) const { if (wid < 4) { unsigned keep; const unsigned voff = (unsigned)(u.lb + 64 * wid + lane) * 4u;
        asm volatile("s_mov_b32 %0, m0\n\ts_mov_b32 m0, %3\n\ts_nop 0\n\tglobal_load_lds_dword %1, %2\n\ts_mov_b32 m0, %0" : "=&s"(keep) : "v"(voff), "s"(list_w), "s"(tab + (unsigned)wid * 256u) : "memory"); } }
    __device__ __forceinline__ void operator()(const f32x4 (&acc)[2][2][4][2], const Unit& u, int wr, int wc, int fr, int fq) const {
        const int rl0 = wr * 64 + fr, col0 = u.pn * BM + wc * 32 + 8 * fq;
        bf16_t* base = u.stage ? Y2 + (size_t)(u.po - 256) * BM * 1024 : Y + (size_t)u.po * BM * 1024;
#pragma unroll
        for (int ai = 0; ai < 2; ++ai) { float wv[4];
#pragma unroll
            for (int m = 0; m < 4; ++m) { const int rl = rl0 + ai * HALF + m * 16; wv[m] = (rl < u.nvalid) ? *(const PG8_LAS float*)(STAT_TAB(u) + rl * 4) : 0.f; }
#pragma unroll
            for (int m = 0; m < 4; ++m) { const int rl = rl0 + ai * HALF + m * 16; const float w = wv[m];
                bf16_t* rowp = base + (size_t)rl * 1024 + col0;
#pragma unroll
                for (int bj = 0; bj < 2; ++bj) *(u32x4*)(rowp + bj * HALF) = pack8(acc[ai][bj][m][0] * w, acc[ai][bj][m][1] * w); } }
    }
};
template <bool GATH> struct MoeOrder {
    static constexpr bool GATHER = GATH;
    static constexpr int NNC = GATH ? 2 * DFE / 256 : DM / 256;
    int t0, t1, nN, G, c; int ts1, ts2, ts3, ts4, ts5, ts6, ts7; int c0, c1, c2, c3, c4, c5, c6, c7; const int* list_tok; size_t bstride; int ntok; int ksplit_tiles; size_t ksplit_bytes;
    __device__ __forceinline__ void init(const unsigned* cntp, int chunk, int nN_, int G_, int c_, const int* lt, size_t bstride_, int ntok_, int ksplit_tiles_ = 0, size_t ksplit_bytes_ = 0) {
        ksplit_tiles = ksplit_tiles_; ksplit_bytes = ksplit_bytes_;
#define MO_LD(e) __builtin_amdgcn_readfirstlane((int)__hip_atomic_load(cntp + (e), __ATOMIC_RELAXED, __HIP_MEMORY_SCOPE_AGENT))
#define MO_NT(x) (((x) + BM - 1) / BM)
        c0 = MO_LD(0); c1 = MO_LD(1); c2 = MO_LD(2); c3 = MO_LD(3); c4 = MO_LD(4); c5 = MO_LD(5); c6 = MO_LD(6); c7 = MO_LD(7);
        ts1 = MO_NT(c0); ts2 = ts1 + MO_NT(c1); ts3 = ts2 + MO_NT(c2); ts4 = ts3 + MO_NT(c3); ts5 = ts4 + MO_NT(c4); ts6 = ts5 + MO_NT(c5); ts7 = ts6 + MO_NT(c6); const int a = ts7 + MO_NT(c7);
#undef MO_LD
#undef MO_NT
        if (chunk < 0) { t0 = 0; t1 = a; }   else { t0 = chunk * 128 < a ? chunk * 128 : a; t1 = (chunk == 0) ? (128 < a ? 128 : a) : a; }          nN = nN_; G = G_; c = c_; list_tok = lt; bstride = bstride_; ntok = ntok_;
    }
    __device__ __forceinline__ bool next(int i, Unit& u) const {
        const int ntl = t1 - t0, nleft = (ksplit_tiles && t1 > 256) ? t1 - (t0 > 256 ? t0 : 256) : 0, nfull = ntl - nleft;
        constexpr int nN = NNC;
        const int ufull = nfull * nN, nunits = ufull + nleft * nN * 2; const int L = i * G + c; if (L >= nunits) return false;
        int tl, half = 0; bool split = false;
        if (L < ufull) { int wgid = (int)L; { const int q = ufull / NXCD, r = ufull % NXCD, xcd = wgid % NXCD, off = wgid / NXCD; wgid = (xcd < r ? xcd * (q + 1) : r * (q + 1) + (xcd - r) * q) + off; }
            tl = wgid / nN; u.pn = wgid % nN; }
        else { const int s = (int)L - ufull; tl = nfull + s / (2 * nN); u.pn = (s >> 1) % nN; half = s & 1; split = true; }
        const int t = t0 + tl;
        const int a1 = ts1, a2 = ts2, a3 = ts3, a4 = ts4, a5 = ts5, a6 = ts6, a7 = ts7, k0 = c0, k1 = c1, k2 = c2, k3 = c3, k4 = c4, k5 = c5, k6 = c6, k7 = c7;
        const int e = (t >= a1) + (t >= a2) + (t >= a3) + (t >= a4) + (t >= a5) + (t >= a6) + (t >= a7);
        const int tse = t >= a7 ? a7 : t >= a6 ? a6 : t >= a5 ? a5 : t >= a4 ? a4 : t >= a3 ? a3 : t >= a2 ? a2 : t >= a1 ? a1 : 0;
        const int ce = t >= a7 ? k7 : t >= a6 ? k6 : t >= a5 ? k5 : t >= a4 ? k4 : t >= a3 ? k3 : t >= a2 ? k2 : t >= a1 ? k1 : k0;
        const int rb = (t - tse) * BM; int nv = ce - rb; nv = nv > BM ? BM : nv;
        u.pm = tl; u.po = GATH ? tl : t; u.lb = e * ntok + rb; u.nvalid = nv; u.stage = half; u.ntu = split ? ksplit_tiles : 0; u.aoff = (size_t)half * ksplit_bytes; u.boff = (size_t)e * bstride + (size_t)half * ksplit_bytes; return true;
    }
    __device__ __forceinline__ u32x4 rows(const Unit& u, int tid, int ldab) const {
        unsigned o[4];
#pragma unroll
        for (int i = 0; i < 2; ++i) { int R, C; stage_rc(tid * 16 + i * 8192, R, C); const int r0 = R, r1 = HALF + R;
            const int k0 = (r0 < u.nvalid) ? list_tok[u.lb + r0] : 0, k1 = (r1 < u.nvalid) ? list_tok[u.lb + r1] : 0;
            o[i] = (unsigned)(k0 * ldab + C * 2); o[2 + i] = (unsigned)(k1 * ldab + C * 2); }
        return (u32x4){o[0], o[1], o[2], o[3]};
    }
    __device__ __forceinline__ void rows_dma(const Unit& u, int tid, unsigned ldsaddr  ) const {
#pragma unroll
        for (int i = 0; i < 2; ++i) { int R, C; stage_rc(tid * 16 + i * 8192, R, C); const int r0 = R, r1 = HALF + R;
            const unsigned o0 = (unsigned)(u.lb + (r0 < u.nvalid ? r0 : 0)) * 4u, o1 = (unsigned)(u.lb + (r1 < u.nvalid ? r1 : 0)) * 4u; unsigned keep;
            asm volatile("s_mov_b32 %0, m0\n\ts_mov_b32 m0, %3\n\ts_nop 0\n\tglobal_load_lds_dword %1, %2\n\ts_mov_b32 m0, %0" : "=&s"(keep) : "v"(o0), "s"(list_tok), "s"(ldsaddr + (unsigned)i * 2048u) : "memory");
            asm volatile("s_mov_b32 %0, m0\n\ts_mov_b32 m0, %3\n\ts_nop 0\n\tglobal_load_lds_dword %1, %2\n\ts_mov_b32 m0, %0" : "=&s"(keep) : "v"(o1), "s"(list_tok), "s"(ldsaddr + (unsigned)(2 + i) * 2048u) : "memory"); }
    }
    __device__ __forceinline__ u32x4 rows_lds(const Unit& u, int tid, int ldab, const PG8_LAS unsigned char* tab  ) const {
        unsigned o[4];
#pragma unroll
        for (int i = 0; i < 2; ++i) { int R, C; stage_rc(tid * 16 + i * 8192, R, C); const int r0 = R, r1 = HALF + R;
            const int k0 = (r0 < u.nvalid) ? *(const PG8_LAS int*)(tab + i * 2048) : 0, k1 = (r1 < u.nvalid) ? *(const PG8_LAS int*)(tab + (2 + i) * 2048) : 0;
            o[i] = (unsigned)(k0 * ldab + C * 2); o[2 + i] = (unsigned)(k1 * ldab + C * 2); }
        return (u32x4){o[0], o[1], o[2], o[3]};
    }
    __device__ __forceinline__ void a_ready(const Unit&) const {}
    __device__ __forceinline__ void done(const Unit&) const {}
};
}
#define GAS __attribute__((address_space(1)))
#define LAS __attribute__((address_space(3)))
typedef unsigned short bf16;
typedef unsigned v4u __attribute__((ext_vector_type(4)));
typedef float f32x4 __attribute__((ext_vector_type(4)));
typedef short bf16x8 __attribute__((ext_vector_type(8)));
typedef GAS unsigned gu32;
typedef GAS unsigned long long gu64;
#define RLX_AGENT __ATOMIC_RELAXED, __HIP_MEMORY_SCOPE_AGENT
#define LDS_WAIT() asm volatile("s_waitcnt lgkmcnt(0)" ::: "memory")
#define VM_WAIT() asm volatile("s_waitcnt vmcnt(0)" ::: "memory")
__device__ __forceinline__ unsigned long long rt() { return __builtin_amdgcn_s_memrealtime(); }
__device__ __forceinline__ unsigned f2bf(float f) { unsigned u = __builtin_bit_cast(unsigned, f); return (u + 0x7fffu + ((u >> 16) & 1u)) >> 16; }
__device__ __forceinline__ unsigned pk2(float lo, float hi) { return f2bf(lo) | (f2bf(hi) << 16); }

#define XB_TMO      128
#define XB_XCNT(j)  (256  + 64 * (j))
#define XB_XSUB(j)  (1280 + 64 * (j))
#define XB_XGEN(j)  (2304 + 64 * (j))
#define XB_TOP      3328
#define XB_TOPGEN   3392
#define XCD_BAR_WORDS 3456
#define XB_SPIN_CAP (1u << 18)

__device__ __forceinline__ unsigned xb_ld(unsigned* p)              { return __hip_atomic_load(p, __ATOMIC_RELAXED, __HIP_MEMORY_SCOPE_AGENT); }
__device__ __forceinline__ unsigned xb_add(unsigned* p, unsigned v) { return __hip_atomic_fetch_add(p, v, __ATOMIC_RELAXED, __HIP_MEMORY_SCOPE_AGENT); }
__device__ __forceinline__ unsigned xb_xcc_id() { return (unsigned)__builtin_amdgcn_s_getreg((3 << 11) | 20) & 0xFu; }
#define XB_SPIN(cond, bar) do { unsigned _sp = 0; while (cond) { __builtin_amdgcn_s_sleep(1); \
    if ((++_sp & 255u) == 0u) { if (xb_ld(&(bar)[XB_TMO])) break; if (_sp > XB_SPIN_CAP) { atomicAdd(&(bar)[XB_TMO], 1u); break; } } } } while (0)

struct XcdBarrier {
    unsigned* bar; unsigned x;
    volatile LAS unsigned* st;
};

__device__ __forceinline__ XcdBarrier xcd_barrier_post(unsigned* bar, volatile LAS unsigned* st) {
    XcdBarrier b; b.bar = bar; b.x = xb_xcc_id(); b.st = st;
    if (threadIdx.x == 0) (void)xb_add(&bar[XB_XCNT(b.x)], 1u);
    return b;
}
__device__ __forceinline__ void xcd_barrier_complete(unsigned* bar, unsigned x, unsigned& nloc, unsigned& nx) {
    const unsigned G = gridDim.x * gridDim.y * gridDim.z;
    unsigned sum, cnt, sp = 0u;
    for (;;) {
        sum = 0u; cnt = 0u;
#pragma unroll
        for (unsigned j = 0; j < 16; ++j) { const unsigned c = xb_ld(&bar[XB_XCNT(j)]); sum += c; cnt += (c > 0u) ? 1u : 0u; }
        if (sum == G) break;
        __builtin_amdgcn_s_sleep(1);
        if ((++sp & 255u) == 0u) { if (xb_ld(&bar[XB_TMO])) break; if (sp > XB_SPIN_CAP) { atomicAdd(&bar[XB_TMO], 1u); break; } }
    }
    const unsigned mine = xb_ld(&bar[XB_XCNT(x)]);
    nloc = mine > 0u ? mine : 1u; nx = cnt > 0u ? cnt : 1u;
}

__device__ __forceinline__ void xcd_barrier_census(const XcdBarrier& b) { unsigned nloc, nx; xcd_barrier_complete(b.bar, b.x, nloc, nx); b.st[0] = nloc; b.st[1] = nx; }
__device__ __forceinline__ void xcd_barrier(const XcdBarrier& b, const bool is_thread0  ) {
    asm volatile("s_waitcnt vmcnt(0)" ::: "memory");
    __syncthreads();
    if (is_thread0) {
        unsigned* bar = b.bar;
        __builtin_amdgcn_s_waitcnt(0);
        unsigned nloc = b.st[0], nx = b.st[1];
        const unsigned old = xb_add(&bar[XB_XSUB(b.x)], 1u);
        const unsigned gen = old / nloc;
        if (old + 1u == (gen + 1u) * nloc) {
            __builtin_amdgcn_fence(__ATOMIC_RELEASE, "agent");
            asm volatile("s_waitcnt vmcnt(0)" ::: "memory");
            const unsigned og = xb_add(&bar[XB_TOP], 1u);
            const unsigned tg = og / nx;
            if (og + 1u == (tg + 1u) * nx) xb_add(&bar[XB_TOPGEN], 1u);
            else XB_SPIN(xb_ld(&bar[XB_TOPGEN]) == tg, bar);
            __builtin_amdgcn_fence(__ATOMIC_ACQUIRE, "agent");
            xb_add(&bar[XB_XGEN(b.x)], 1u);
            asm volatile("s_waitcnt vmcnt(0)" ::: "memory");
        } else {
            XB_SPIN(xb_ld(&bar[XB_XGEN(b.x)]) == gen, bar);
            __builtin_amdgcn_fence(__ATOMIC_ACQUIRE, "agent");
            asm volatile("s_waitcnt vmcnt(0)" ::: "memory");
        }
    }
    __syncthreads();
}

typedef unsigned v2u __attribute__((ext_vector_type(2)));
typedef float f32x2v __attribute__((ext_vector_type(2)));
struct Frame {
    LAS unsigned char* lds;
    int tid, lane, wave;
    int vcu, G;
    int gw, ngw;
};
__device__ __forceinline__ float wave_sum(float v) { return pg8::wave_sum64(v); }
__device__ __forceinline__ float bf2f(unsigned short b) { return __uint_as_float((unsigned)b << 16); }
__device__ __forceinline__ float bflo(unsigned w) { return __uint_as_float(w << 16); }
__device__ __forceinline__ float bfhi(unsigned w) { return __uint_as_float(w & 0xffff0000u); }
__device__ __forceinline__ float fsigmoid(float x) { return __builtin_amdgcn_rcpf(1.0f + __builtin_amdgcn_exp2f(-1.4426950408889634f * x)); }

__device__ __forceinline__ unsigned pk4_fp8(float a, float b, float c, float d) { int r = __builtin_amdgcn_cvt_pk_fp8_f32(a, b, 0, false); r = __builtin_amdgcn_cvt_pk_fp8_f32(c, d, r, true); return (unsigned)r; }
template <bool F8> __device__ __forceinline__ void tr_item(const float* W, int ldw, int k0, int c0, bf16* WTrow0, int ldt, LAS float* scr, int lane, const float* gk, float wmul) {
    f32x4 ld[8]; const int lr = lane >> 3, lc = (lane & 7) * 4;
#pragma unroll
    for (int i = 0; i < 8; ++i) ld[i] = __builtin_nontemporal_load((const GAS f32x4*)(W + (size_t)(k0 + 8 * i + lr) * ldw + c0 + lc));
#pragma unroll
    for (int i = 0; i < 8; ++i) { LAS float* d = scr + (8 * i + lr) * 33 + lc; d[0] = ld[i].x; d[1] = ld[i].y; d[2] = ld[i].z; d[3] = ld[i].w; }
    LDS_WAIT(); asm volatile("" ::: "memory");
    const int c = lane & 7;
    f32x4 g0 = (f32x4){1.f, 1.f, 1.f, 1.f}, g1 = g0;
    if (gk) { g0 = *(const GAS f32x4*)(gk + k0 + 8 * c); g1 = *(const GAS f32x4*)(gk + k0 + 8 * c + 4); }
    g0 = g0 * wmul; g1 = g1 * wmul;
#pragma unroll
    for (int j = 0; j < 4; ++j) { const int n = (lane >> 3) + 8 * j; const LAS float* s = scr + (8 * c) * 33 + n;
        if constexpr (F8) {
            v2u o; o.x = pk4_fp8(s[0 * 33] * g0.x, s[1 * 33] * g0.y, s[2 * 33] * g0.z, s[3 * 33] * g0.w); o.y = pk4_fp8(s[4 * 33] * g1.x, s[5 * 33] * g1.y, s[6 * 33] * g1.z, s[7 * 33] * g1.w);
            *(GAS v2u*)((unsigned char*)WTrow0 + (size_t)n * ldt + k0 + 8 * c) = o;
        } else {
        v4u o; o.x = pk2(s[0 * 33] * g0.x, s[1 * 33] * g0.y); o.y = pk2(s[2 * 33] * g0.z, s[3 * 33] * g0.w); o.z = pk2(s[4 * 33] * g1.x, s[5 * 33] * g1.y); o.w = pk2(s[6 * 33] * g1.z, s[7 * 33] * g1.w);
        *(GAS v4u*)(WTrow0 + (size_t)n * ldt + k0 + 8 * c) = o; } }
    LDS_WAIT(); asm volatile("" ::: "memory");
}
template <bool F8 = false, class Map> __device__ __forceinline__ void convert_matrix(const Frame& F, int& rot, const float* W, int ldw, int K, int ncb, bf16* WT, int ldt, Map map, const float* gk = nullptr, float wmul = 1.0f) {
    LAS float* scr = (LAS float*)(F.lds + F.wave * 16384);
    const int nkb = K / 64, nitems = nkb * ncb;
    int first = F.gw - rot; if (first < 0) first += F.ngw;
    rot = (rot + nitems) % F.ngw;
    for (int it = first; it < nitems; it += F.ngw) { const int kb = it / ncb, cb = it % ncb; const int r0 = map(cb); if (r0 < 0) continue;
        tr_item<F8>(W, ldw, 64 * kb, 32 * cb, F8 ? (bf16*)((unsigned char*)WT + (size_t)r0 * ldt) : WT + (size_t)r0 * ldt, ldt, scr, F.lane, gk, wmul); }
}
__device__ __forceinline__ void zero_rows(const Frame& F, bf16* WT, int ldt, int r0, int nrows) {
    const int per_row = ldt / 8; const int n = nrows * per_row;
    for (int i = F.gw * 64 + F.lane; i < n; i += F.ngw * 64) { const int r = i / per_row, c = i % per_row; *(GAS v4u*)(WT + (size_t)(r0 + r) * ldt + c * 8) = (v4u){0u, 0u, 0u, 0u}; }
}
__constant__ double ROPE_INVF[16] = {1.0, 0.5623413251903491, 0.31622776601683794, 0.1778279410038923, 0.1, 0.05623413251903491, 0.03162277660168379, 0.01778279410038923,
    0.01, 0.005623413251903491, 0.0031622776601683794, 0.0017782794100389228, 0.001, 0.0005623413251903491, 0.00031622776601683794, 0.00017782794100389227};

template <bool F8> __device__ __forceinline__ void xcast_rows(const Frame& F, const float* x, bf16* xb, pg8::stat_t* ss) {
    for (int m0 = F.gw; m0 < NTOK; m0 += 4 * F.ngw) {
        f32x4 v[4][4]; int mk[4];
#pragma unroll
        for (int k = 0; k < 4; ++k) { const int m = m0 + k * F.ngw; mk[k] = m < NTOK ? m : m0; const GAS f32x4* xr = (const GAS f32x4*)(x + (size_t)mk[k] * DM) + F.lane;
#pragma unroll
            for (int j = 0; j < 4; ++j) v[k][j] = __builtin_nontemporal_load(xr + 64 * j); }
#pragma unroll
        for (int k = 0; k < 4; ++k) { if (k > 0 && mk[k] == m0) continue; float s = 0.f;
            GAS unsigned long long* o8 = (GAS unsigned long long*)(xb + (size_t)mk[k] * DM) + F.lane;
#pragma unroll
            for (int j = 0; j < 4; ++j) { const f32x4 w = v[k][j]; s += (w.x * w.x + w.y * w.y) + (w.z * w.z + w.w * w.w);
                if constexpr (F8) ((GAS unsigned*)((unsigned char*)xb + (size_t)mk[k] * DM))[64 * j + F.lane] = pk4_fp8(w.x, w.y, w.z, w.w);
                else o8[64 * j] = (unsigned long long)pk2(w.x, w.y) | ((unsigned long long)pk2(w.z, w.w) << 32); }
            s = wave_sum(s); if (F.lane == 0) ss[mk[k]] = (pg8::stat_t)(s * 16777216.0f + 0.5f); }
    }
}
struct RouterOut { unsigned* cnt; int* list_tok; float* list_w; int* slot; };
__device__ __forceinline__ void router_flush(int lane, int nrows, int se0, int se1, float sw0, float sw1, int stok, const RouterOut& R) {
    const bool valid = lane < nrows; const unsigned long long lt = (1ull << lane) - 1ull;
#pragma unroll
    for (int e = 0; e < 8; ++e) {
        const bool h0 = valid && se0 == e, h1 = valid && se1 == e;
        const unsigned long long m0 = __ballot(h0), m1 = __ballot(h1);
        const int c0 = __popcll(m0), c = c0 + __popcll(m1);
        int base = 0; if (lane == 0 && c) base = (int)__hip_atomic_fetch_add(R.cnt + e, (unsigned)c, __ATOMIC_RELAXED, __HIP_MEMORY_SCOPE_AGENT);
        base = __builtin_amdgcn_readfirstlane(base);
        if (h0) { const int pos = base + __popcll(m0 & lt); R.list_tok[e * NTOK + pos] = stok; R.list_w[e * NTOK + pos] = sw0; R.slot[2 * stok] = e * NTOK + pos; }
        if (h1) { const int pos = base + c0 + __popcll(m1 & lt); R.list_tok[e * NTOK + pos] = stok; R.list_w[e * NTOK + pos] = sw1; R.slot[2 * stok + 1] = e * NTOK + pos; }
    }
}
template <bool ROUTER> __device__ __forceinline__ void norm_rows(const Frame& F, const float* x, const float* g, bf16* out, const float* router, const RouterOut R) {
    int nbuf = 0, se0 = 0, se1 = 0, stok = 0; float sw0 = 0.f, sw1 = 0.f;
    for (int m = F.gw; m < NTOK; m += F.ngw) {
        f32x4 v[4]; float s = 0.f;
        if constexpr (ROUTER) {
            const GAS v2u* xr = (const GAS v2u*)((const bf16*)x + (size_t)m * pg8::XRP) + F.lane;
#pragma unroll
            for (int j = 0; j < 4; ++j) { const v2u w = xr[64 * j]; v[j] = (f32x4){bflo(w.x), bfhi(w.x), bflo(w.y), bfhi(w.y)}; }
        } else { const GAS f32x4* xr = (const GAS f32x4*)(x + (size_t)m * DM) + F.lane;
#pragma unroll
            for (int j = 0; j < 4; ++j) v[j] = xr[64 * j]; }
#pragma unroll
        for (int j = 0; j < 4; ++j) s += (v[j].x * v[j].x + v[j].y * v[j].y) + (v[j].z * v[j].z + v[j].w * v[j].w);
        const float rstd = 1.0f / sqrtf(wave_sum(s) * (1.0f / DM) + EPS);
        GAS unsigned long long* o8 = (GAS unsigned long long*)(out + (size_t)m * DM) + F.lane;
#pragma unroll
        for (int j = 0; j < 4; ++j) { const f32x4 gg = *((const GAS f32x4*)g + 64 * j + F.lane); v[j] = v[j] * rstd * gg;
            if constexpr (ROUTER) ((GAS unsigned*)((unsigned char*)out + (size_t)m * DM))[64 * j + F.lane] = pk4_fp8(v[j].x, v[j].y, v[j].z, v[j].w);
            else o8[64 * j] = (unsigned long long)pk2(v[j].x, v[j].y) | ((unsigned long long)pk2(v[j].z, v[j].w) << 32); }
        if constexpr (ROUTER) {
            float lg[8];
#pragma unroll
            for (int e = 0; e < 8; ++e) lg[e] = 0.f;
#pragma unroll
            for (int j = 0; j < 4; ++j)
#pragma unroll
                for (int k = 0; k < 4; ++k) { const int c = 4 * F.lane + 256 * j + k; const f32x4 r0 = *(const GAS f32x4*)(router + (size_t)c * 8), r1 = *(const GAS f32x4*)(router + (size_t)c * 8 + 4);
                    const float hv = v[j][k];
                    lg[0] += hv * r0.x; lg[1] += hv * r0.y; lg[2] += hv * r0.z; lg[3] += hv * r0.w; lg[4] += hv * r1.x; lg[5] += hv * r1.y; lg[6] += hv * r1.z; lg[7] += hv * r1.w; }
#pragma unroll
            for (int e = 0; e < 8; ++e) lg[e] = wave_sum(lg[e]);
            int e0 = 0; float v0 = lg[0];
#pragma unroll
            for (int e = 1; e < 8; ++e) if (lg[e] > v0) { v0 = lg[e]; e0 = e; }
            int e1 = -1; float v1 = -INFINITY;
#pragma unroll
            for (int e = 0; e < 8; ++e) if (e != e0 && lg[e] > v1) { v1 = lg[e]; e1 = e; }
            const float w1 = 1.0f / (1.0f + expf(v0 - v1)), w0 = 1.0f - w1;
            if (F.lane == nbuf) { se0 = e0; se1 = e1; sw0 = w0; sw1 = w1; stok = m; }
            if (++nbuf == 64) { router_flush(F.lane, nbuf, se0, se1, sw0, sw1, stok, R); nbuf = 0; }
        }
    }
    if constexpr (ROUTER) { if (nbuf) router_flush(F.lane, nbuf, se0, se1, sw0, sw1, stok, R); }
}

__device__ __forceinline__ void router_rows(const Frame& F, const bf16* xr_, const float* g, unsigned char* out8, const float* router, const RouterOut R) {
    int nbuf = 0, se0 = 0, se1 = 0, stok = 0; float sw0 = 0.f, sw1 = 0.f;
    for (int m0 = F.gw; m0 < NTOK; m0 += 4 * F.ngw) {
        int mk[4]; f32x4 v[4][4]; float rs[4];
#pragma unroll
        for (int k = 0; k < 4; ++k) { const int m = m0 + k * F.ngw; mk[k] = m < NTOK ? m : m0; }
#pragma unroll
        for (int k = 0; k < 4; ++k) { const GAS v2u* xr = (const GAS v2u*)(xr_ + (size_t)mk[k] * pg8::XRP) + F.lane;
#pragma unroll
            for (int j = 0; j < 4; ++j) { const v2u w = xr[64 * j]; v[k][j] = (f32x4){bflo(w.x), bfhi(w.x), bflo(w.y), bfhi(w.y)}; } }
#pragma unroll
        for (int k = 0; k < 4; ++k) { float s = 0.f;
#pragma unroll
            for (int j = 0; j < 4; ++j) s += (v[k][j].x * v[k][j].x + v[k][j].y * v[k][j].y) + (v[k][j].z * v[k][j].z + v[k][j].w * v[k][j].w);
            rs[k] = 1.0f / sqrtf(wave_sum(s) * (1.0f / DM) + EPS); }
#pragma unroll
        for (int j = 0; j < 4; ++j) { const f32x4 gg = *((const GAS f32x4*)g + 64 * j + F.lane);
#pragma unroll
            for (int k = 0; k < 4; ++k) { v[k][j] = v[k][j] * rs[k] * gg;
                if (k == 0 || mk[k] != m0) ((GAS unsigned*)(out8 + (size_t)mk[k] * DM))[64 * j + F.lane] = pk4_fp8(v[k][j].x, v[k][j].y, v[k][j].z, v[k][j].w); } }
        float lg[4][8];
#pragma unroll
        for (int k = 0; k < 4; ++k)
#pragma unroll
            for (int e = 0; e < 8; ++e) lg[k][e] = 0.f;
#pragma unroll
        for (int j = 0; j < 4; ++j)
#pragma unroll
            for (int kk = 0; kk < 4; ++kk) { const int c = 4 * F.lane + 256 * j + kk; const f32x4 r0 = *(const GAS f32x4*)(router + (size_t)c * 8), r1 = *(const GAS f32x4*)(router + (size_t)c * 8 + 4);
#pragma unroll
                for (int k = 0; k < 4; ++k) { const float hv = v[k][j][kk];
                    lg[k][0] += hv * r0.x; lg[k][1] += hv * r0.y; lg[k][2] += hv * r0.z; lg[k][3] += hv * r0.w; lg[k][4] += hv * r1.x; lg[k][5] += hv * r1.y; lg[k][6] += hv * r1.z; lg[k][7] += hv * r1.w; } }
#pragma unroll
        for (int k = 0; k < 4; ++k) {
            if (k > 0 && mk[k] == m0) continue;
#pragma unroll
            for (int e = 0; e < 8; ++e) lg[k][e] = wave_sum(lg[k][e]);
            int e0 = 0; float v0 = lg[k][0];
#pragma unroll
            for (int e = 1; e < 8; ++e) if (lg[k][e] > v0) { v0 = lg[k][e]; e0 = e; }
            int e1 = -1; float v1 = -INFINITY;
#pragma unroll
            for (int e = 0; e < 8; ++e) if (e != e0 && lg[k][e] > v1) { v1 = lg[k][e]; e1 = e; }
            const float w1 = 1.0f / (1.0f + expf(v0 - v1)), w0 = 1.0f - w1;
            if (F.lane == nbuf) { se0 = e0; se1 = e1; sw0 = w0; sw1 = w1; stok = mk[k]; }
            if (++nbuf == 64) { router_flush(F.lane, nbuf, se0, se1, sw0, sw1, stok, R); nbuf = 0; }
        }
    }
    {
        LAS int* cntw = (LAS int*)F.lds; LAS int* offw = cntw + 64;
        const int lane = F.lane; const bool valid = lane < nbuf; const unsigned long long lt = (1ull << lane) - 1ull;
        int mine = 0;
#pragma unroll 1
        for (int e = 0; e < 8; ++e) { const int c = __popcll(__ballot(valid && se0 == e)) + __popcll(__ballot(valid && se1 == e)); if (lane == e) mine = c; }
        if (lane < 8) cntw[F.wave * 8 + lane] = mine;
        __syncthreads();
        if (F.wave == 0 && lane < 8) { int tot = 0;
#pragma unroll
            for (int w = 0; w < NWAVES; ++w) tot += cntw[w * 8 + lane];
            int run = tot ? (int)__hip_atomic_fetch_add(R.cnt + lane, (unsigned)tot, __ATOMIC_RELAXED, __HIP_MEMORY_SCOPE_AGENT) : 0;
#pragma unroll
            for (int w = 0; w < NWAVES; ++w) { offw[w * 8 + lane] = run; run += cntw[w * 8 + lane]; } }
        __syncthreads();
#pragma unroll 1
        for (int e = 0; e < 8; ++e) {
            const bool h0 = valid && se0 == e, h1 = valid && se1 == e;
            const unsigned long long m0 = __ballot(h0), m1 = __ballot(h1); const int c0 = __popcll(m0);
            const int base = __builtin_amdgcn_readfirstlane(offw[F.wave * 8 + e]);
            if (h0) { const int pos = base + __popcll(m0 & lt); R.list_tok[e * NTOK + pos] = stok; R.list_w[e * NTOK + pos] = sw0; R.slot[2 * stok] = e * NTOK + pos; }
            if (h1) { const int pos = base + c0 + __popcll(m1 & lt); R.list_tok[e * NTOK + pos] = stok; R.list_w[e * NTOK + pos] = sw1; R.slot[2 * stok + 1] = e * NTOK + pos; }
        }
        __syncthreads();
    }
}

__device__ __forceinline__ void moe_combine(const Frame& F, float* xio, const bf16* Y, const bf16* Y2, const int* slot, const unsigned* cntp) {
    int cnt[8];
#pragma unroll
    for (int e = 0; e < 8; ++e) cnt[e] = __builtin_amdgcn_readfirstlane((int)__hip_atomic_load(cntp + e, __ATOMIC_RELAXED, __HIP_MEMORY_SCOPE_AGENT));
    for (int m0 = F.gw; m0 < NTOK; m0 += 2 * F.ngw) {
        const int m1 = (m0 + F.ngw < NTOK) ? m0 + F.ngw : m0;
        int prow[4];
#pragma unroll
        for (int k = 0; k < 4; ++k) { const int s = slot[2 * (k < 2 ? m0 : m1) + (k & 1)], e = s >> 15, pos = s & (NTOK - 1); int tsv = 0;
#pragma unroll
            for (int j = 0; j < 8; ++j) if (j < e) tsv += (cnt[j] + 255) >> 8;
            prow[k] = tsv * 256 + pos; }
        v2u xv[2][4], a[2][4], b[2][4];
#pragma unroll
        for (int r = 0; r < 2; ++r) { const GAS v2u* xr = (const GAS v2u*)((const bf16*)xio + (size_t)(r ? m1 : m0) * pg8::XRP) + F.lane;
            const GAS v2u* y0 = (const GAS v2u*)(Y + (size_t)prow[2 * r] * DM) + F.lane; const GAS v2u* y1 = (const GAS v2u*)(Y + (size_t)prow[2 * r + 1] * DM) + F.lane;
#pragma unroll
            for (int j = 0; j < 4; ++j) { xv[r][j] = xr[64 * j]; a[r][j] = __builtin_nontemporal_load(y0 + 64 * j); b[r][j] = __builtin_nontemporal_load(y1 + 64 * j); } }
#pragma unroll
        for (int k = 0; k < 4; ++k) if (prow[k] >= 65536) {
            const GAS v2u* y2 = (const GAS v2u*)(Y2 + (size_t)(prow[k] - 65536) * DM) + F.lane;
#pragma unroll
            for (int j = 0; j < 4; ++j) { const v2u w = y2[64 * j]; v2u& t = (k & 1) ? b[k >> 1][j] : a[k >> 1][j];
                t.x = pk2(bflo(t.x) + bflo(w.x), bfhi(t.x) + bfhi(w.x)); t.y = pk2(bflo(t.y) + bflo(w.y), bfhi(t.y) + bfhi(w.y)); } }
        asm volatile("s_waitcnt vmcnt(0)" ::: "memory");
#pragma unroll
        for (int r = 0; r < 2; ++r) { if (r == 1 && m1 == m0) break; GAS f32x4* orow = (GAS f32x4*)(xio + (size_t)(r ? m1 : m0) * DM) + F.lane;
#pragma unroll
            for (int j = 0; j < 4; ++j) { const v2u xx = xv[r][j], aa = a[r][j], bb = b[r][j]; f32x4 o;
                o.x = bflo(xx.x) + (bflo(aa.x) + bflo(bb.x)); o.y = bfhi(xx.x) + (bfhi(aa.x) + bfhi(bb.x)); o.z = bflo(xx.y) + (bflo(aa.y) + bflo(bb.y)); o.w = bfhi(xx.y) + (bfhi(aa.y) + bfhi(bb.y)); __builtin_nontemporal_store(o, orow + 64 * j); } }
    }
}

__device__ __forceinline__ void qkv_prep(const Frame& F, bf16* cq, bf16* ckv, const float* gq, const float* gkv) {
    for (int m = F.gw; m < NTOK; m += F.ngw) {
        { GAS v2u* p = (GAS v2u*)(cq + (size_t)m * 256) + F.lane; const v2u w = *p;
          float a = bflo(w.x), b = bfhi(w.x), c = bflo(w.y), d = bfhi(w.y);
          const float rstd = 1.0f / sqrtf(wave_sum((a * a + b * b) + (c * c + d * d)) * (1.0f / 256.0f) + EPS);
          const f32x4 gg = *((const GAS f32x4*)gq + F.lane);
          v2u o; o.x = pk2(a * rstd * gg.x, b * rstd * gg.y); o.y = pk2(c * rstd * gg.z, d * rstd * gg.w); *p = o; }
        { GAS v2u* p = (GAS v2u*)(ckv + (size_t)m * 256) + (F.lane & 31); const v2u w = *p;
          float a = bflo(w.x), b = bfhi(w.x), c = bflo(w.y), d = bfhi(w.y);
          const float ss = (F.lane < 32) ? (a * a + b * b) + (c * c + d * d) : 0.f;
          const float rstd = 1.0f / sqrtf(wave_sum(ss) * (1.0f / 128.0f) + EPS);
          const f32x4 gg = *((const GAS f32x4*)gkv + (F.lane & 31));
          v2u o; o.x = pk2(a * rstd * gg.x, b * rstd * gg.y); o.y = pk2(c * rstd * gg.z, d * rstd * gg.w); if (F.lane < 32) *p = o; }
    }
}

template <class Ld> __device__ __forceinline__ void head_process(Ld ld, const float* g, const float* cs, float scale, bf16* dst) {
    float f[12][8];
#pragma unroll
    for (int c = 0; c < 12; ++c) ld(c, f[c]);
    float ss = 0.f;
#pragma unroll
    for (int c = 0; c < 12; ++c)
#pragma unroll
        for (int j = 0; j < 8; ++j) ss += f[c][j] * f[c][j];
    const float rstd = scale / sqrtf(ss * (1.0f / 96.0f) + EPS);
#pragma unroll
    for (int c = 0; c < 8; ++c) {
#pragma unroll
        for (int j = 0; j < 8; ++j) f[c][j] = f[c][j] * rstd * g[8 * c + j];
        v4u o; o.x = pk2(f[c][0], f[c][1]); o.y = pk2(f[c][2], f[c][3]); o.z = pk2(f[c][4], f[c][5]); o.w = pk2(f[c][6], f[c][7]); *(GAS v4u*)(dst + 8 * c) = o; }
#pragma unroll
    for (int c2 = 0; c2 < 2; ++c2) { float oa[8], ob[8];
#pragma unroll
        for (int j = 0; j < 8; ++j) { const float x1 = f[8 + c2][j] * rstd * g[64 + 8 * c2 + j], x2 = f[10 + c2][j] * rstd * g[80 + 8 * c2 + j], cc = cs[8 * c2 + j], sn = cs[16 + 8 * c2 + j];
            oa[j] = x1 * cc - x2 * sn; ob[j] = x2 * cc + x1 * sn; }
        v4u o; o.x = pk2(oa[0], oa[1]); o.y = pk2(oa[2], oa[3]); o.z = pk2(oa[4], oa[5]); o.w = pk2(oa[6], oa[7]); *(GAS v4u*)(dst + 64 + 8 * c2) = o;
        o.x = pk2(ob[0], ob[1]); o.y = pk2(ob[2], ob[3]); o.z = pk2(ob[4], ob[5]); o.w = pk2(ob[6], ob[7]); *(GAS v4u*)(dst + 80 + 8 * c2) = o; }
}
__device__ __forceinline__ void unpack8(const v4u w, float* f) { f[0] = bflo(w.x); f[1] = bfhi(w.x); f[2] = bflo(w.y); f[3] = bfhi(w.y); f[4] = bflo(w.z); f[5] = bfhi(w.z); f[6] = bflo(w.w); f[7] = bfhi(w.w); }
template <int WHICH> __device__ __forceinline__ void qk_post_tile(const Frame& F, int pm, int pn, const bf16* src, const bf16* ckv, const float* rope, const float* g, bf16* dst, const pg8::stat_t* ss) {
    constexpr int NHT = WHICH == 0 ? 2 : 4;
#pragma unroll 1
    for (int item = F.tid; item < 256 * NHT; item += NWAVES * 64) {
        const int tok = pm * 256 + (item & 255), h = pn * NHT + (item >> 8), b = tok >> 12, s = tok & (SEQ - 1);
        const float* cs = rope + (size_t)tok * 32;
        bf16* d = dst + ((size_t)(b * NH + h) * SEQ + s) * DQK;
        if (WHICH == 0) { const float rq = pg8::rstd_of(ss, tok, 1.0f / 256.0f); const bf16* qp = src + (size_t)tok * 1024 + 128 * h;
            head_process([&](int c, float* f) { unpack8(*(const GAS v4u*)(qp + 8 * c), f);
#pragma unroll
                    for (int j = 0; j < 8; ++j) f[j] *= rq; }, g, cs, QSCALE, d);
        } else { const float rk = pg8::rstd_of(ss, tok, 1.0f / 128.0f); const bf16* kp = src + (size_t)tok * 512 + 64 * h; const bf16* rp = ckv + (size_t)tok * 256 + 128;
            head_process([&](int c, float* f) { if (c < 8) { unpack8(*(const GAS v4u*)(kp + 8 * c), f);
#pragma unroll
                        for (int j = 0; j < 8; ++j) f[j] *= rk; } else unpack8(*(const GAS v4u*)(rp + 8 * (c - 8)), f); }, g, cs, 1.0f, d);
        }
    }
}
namespace att {
typedef short bf16x8 __attribute__((ext_vector_type(8)));
typedef float f32x16 __attribute__((ext_vector_type(16)));
constexpr int KP = 208, VP = 144, KBUF = 64 * KP, VBUF = 64 * VP;
constexpr int OFF_K = 0, OFF_V = 2 * KBUF, OFF_L = OFF_V + 2 * VBUF, LDS_NEED = OFF_L + NWAVES * 64 * 4;
static_assert(LDS_NEED <= RING_BYTES, "attention LDS");
__device__ __forceinline__ void attn_unit(LAS unsigned char* lds, const bf16* Qh, const bf16* Kh, const bf16* Vt, bf16* O, int bh, int qb, int tid) {
    const int lane = tid & 63, wid = __builtin_amdgcn_readfirstlane(tid >> 6), i32 = lane & 31, hi = lane >> 5;
    const int b = bh >> 3, h = bh & 7, q0 = qb * 256, qw0 = q0 + wid * 32;
    bf16x8 qf[6];
    { const bf16* Qp = Qh + ((size_t)bh * SEQ + qw0 + i32) * DQK + hi * 8;
#pragma unroll
      for (int d0 = 0; d0 < 6; ++d0) qf[d0] = *(const GAS bf16x8*)(Qp + 16 * d0); }
    const unsigned char* Kb = (const unsigned char*)(Kh + (size_t)bh * SEQ * DQK);
    const bf16* Vb = Vt + (size_t)bh * 64 * 4096 + tid * 8;
    const int kl0 = (tid / 12) * KP + (tid % 12) * 16, kl1 = ((512 + tid) / 12) * KP + ((512 + tid) % 12) * 16, vl = (tid >> 3) * VP + (tid & 7) * 16;
    const int ntiles = 4 * (qb + 1);
    const int krow = (i32 & ~12) | ((i32 & 4) << 1) | ((i32 & 8) >> 1);
    const int koff = OFF_K + krow * KP + hi * 16, voff = OFF_V + i32 * VP + hi * 16;
    f32x16 o0, o1;
#pragma unroll
    for (int r = 0; r < 16; ++r) { o0[r] = 0.f; o1[r] = 0.f; }
    float lsum = 0.f;
    v4u r0, r1, rv;
    r0 = *(const GAS v4u*)(Kb + tid * 16); r1 = (tid < 256) ? *(const GAS v4u*)(Kb + (512 + tid) * 16) : (v4u){0u, 0u, 0u, 0u}; rv = *(const GAS v4u*)(Vb);
    *(LAS v4u*)(lds + OFF_K + kl0) = r0; if (tid < 256) *(LAS v4u*)(lds + OFF_K + kl1) = r1; *(LAS v4u*)(lds + OFF_V + vl) = rv;
    __syncthreads();
    for (int t = 0; t < ntiles; ++t) {
        const int cur = t & 1; const bool more = (t + 1 < ntiles);
        if (more) { const unsigned char* kt_ = Kb + (size_t)(t + 1) * (64 * DQK * 2);
            r0 = *(const GAS v4u*)(kt_ + tid * 16); if (tid < 256) r1 = *(const GAS v4u*)(kt_ + (512 + tid) * 16); rv = *(const GAS v4u*)(Vb + (t + 1) * 4096); }
        if (64 * t <= qw0 + 31) {
            const bool diag = (64 * t + 63 > qw0);
#pragma unroll
            for (int kt = 0; kt < 2; ++kt) {
                f32x16 s;
#pragma unroll
                for (int r = 0; r < 16; ++r) s[r] = 0.f;
#pragma unroll
                for (int d0 = 0; d0 < 6; ++d0) { const bf16x8 kf = *(const LAS bf16x8*)(lds + cur * KBUF + kt * 32 * KP + koff + d0 * 32);
                    s = __builtin_amdgcn_mfma_f32_32x32x16_bf16(kf, qf[d0], s, 0, 0, 0); }
                float p[16];
#pragma unroll
                for (int r = 0; r < 16; ++r) p[r] = __builtin_amdgcn_exp2f(s[r]);
                if (diag) { const int q = qw0 + i32, kb_ = 64 * t + 32 * kt + 8 * hi;
#pragma unroll
                    for (int r = 0; r < 16; ++r) { const int key = kb_ + 16 * (r >> 3) + (r & 7); if (key > q) p[r] = 0.f; } }
                float ps = 0.f;
#pragma unroll
                for (int r = 0; r < 16; ++r) ps += p[r];
                lsum += ps;
#pragma unroll
                for (int k = 0; k < 2; ++k) { v4u pw; pw.x = pg8::cvt_pk_bf16(p[8 * k], p[8 * k + 1]); pw.y = pg8::cvt_pk_bf16(p[8 * k + 2], p[8 * k + 3]); pw.z = pg8::cvt_pk_bf16(p[8 * k + 4], p[8 * k + 5]); pw.w = pg8::cvt_pk_bf16(p[8 * k + 6], p[8 * k + 7]);
                    const bf16x8 pa = __builtin_bit_cast(bf16x8, pw);
                    const bf16x8 vf0 = *(const LAS bf16x8*)(lds + cur * VBUF + voff + (kt * 32 + k * 16) * 2);
                    const bf16x8 vf1 = *(const LAS bf16x8*)(lds + cur * VBUF + voff + 32 * VP + (kt * 32 + k * 16) * 2);
                    o0 = __builtin_amdgcn_mfma_f32_32x32x16_bf16(pa, vf0, o0, 0, 0, 0); o1 = __builtin_amdgcn_mfma_f32_32x32x16_bf16(pa, vf1, o1, 0, 0, 0); }
            }
        }
        if (more) { const int nb = cur ^ 1; *(LAS v4u*)(lds + OFF_K + nb * KBUF + kl0) = r0; if (tid < 256) *(LAS v4u*)(lds + OFF_K + nb * KBUF + kl1) = r1; *(LAS v4u*)(lds + OFF_V + nb * VBUF + vl) = rv; }
        __syncthreads();
    }
    lsum = pg8::xsum32(lsum);
    LAS float* lsc = (LAS float*)(lds + OFF_L) + wid * 32;
    if (hi == 0) lsc[i32] = lsum;
    LDS_WAIT(); asm volatile("" ::: "memory");
    bf16* Op = O + ((size_t)b * SEQ + qw0) * 512 + h * 64 + i32;
#pragma unroll
    for (int r = 0; r < 16; ++r) { const int qr = (r & 3) + 8 * (r >> 2) + 4 * hi; const float inv = 1.0f / lsc[qr];
        Op[(size_t)qr * 512] = (bf16)f2bf(o0[r] * inv); Op[(size_t)qr * 512 + 32] = (bf16)f2bf(o1[r] * inv); }
    LDS_WAIT(); asm volatile("" ::: "memory");
}
#define ATT_SBAR() __builtin_amdgcn_sched_barrier(0)
__device__ __forceinline__ void attn_slice(const int j, const f32x16& c0, const f32x16& c1, v4u (&pw)[4], float& ps) {
    const int rr = (4 * j) & 15; float e[4];
#pragma unroll
    for (int k = 0; k < 4; ++k) e[k] = __builtin_amdgcn_exp2f(j < 4 ? c0[rr + k] : c1[rr + k]);
    ps += (e[0] + e[1]) + (e[2] + e[3]);
    const unsigned w0 = pg8::cvt_pk_bf16(e[0], e[1]), w1 = pg8::cvt_pk_bf16(e[2], e[3]);
    if (j & 1) { pw[j >> 1].z = w0; pw[j >> 1].w = w1; } else { pw[j >> 1].x = w0; pw[j >> 1].y = w1; }
    asm volatile("" : "+v"(pw[j >> 1]), "+v"(ps));
}
__device__ __forceinline__ void attn_qk_softmax(LAS unsigned char* lds, const int kbase  , const bf16x8 (&qf)[6],
        const f32x16& c0, const f32x16& c1, f32x16& n0, f32x16& n1, v4u (&pw)[4], float& ps) {
#pragma unroll
    for (int r = 0; r < 16; ++r) { n0[r] = 0.f; n1[r] = 0.f; }
    bf16x8 ka0 = *(const LAS bf16x8*)(lds + kbase), ka1 = *(const LAS bf16x8*)(lds + kbase + 32 * KP);
#pragma unroll
    for (int i = 0; i < 6; ++i) {
        bf16x8 kb0 = ka0, kb1 = ka1;
        if (i < 5) { kb0 = *(const LAS bf16x8*)(lds + kbase + (i + 1) * 32); kb1 = *(const LAS bf16x8*)(lds + kbase + 32 * KP + (i + 1) * 32); }
        n0 = __builtin_amdgcn_mfma_f32_32x32x16_bf16(ka0, qf[i], n0, 0, 0, 0);
        if (2 * i < 8) attn_slice(2 * i, c0, c1, pw, ps);
        ATT_SBAR();
        n1 = __builtin_amdgcn_mfma_f32_32x32x16_bf16(ka1, qf[i], n1, 0, 0, 0);
        if (2 * i + 1 < 8) attn_slice(2 * i + 1, c0, c1, pw, ps);
        ATT_SBAR();
        ka0 = kb0; ka1 = kb1;
    }
}
__device__ __forceinline__ void attn_unit2(LAS unsigned char* lds, const bf16* Qh, const bf16* Kh, const bf16* Vt, bf16* O, int bh, int qb, int tid) {
    const int lane = tid & 63, wid = __builtin_amdgcn_readfirstlane(tid >> 6), i32 = lane & 31, hi = lane >> 5;
    const int b = bh >> 3, h = bh & 7, q0 = qb * 256, qw0 = q0 + wid * 32;
    bf16x8 qf[6];
    { const bf16* Qp = Qh + ((size_t)bh * SEQ + qw0 + i32) * DQK + hi * 8;
#pragma unroll
      for (int d0 = 0; d0 < 6; ++d0) qf[d0] = *(const GAS bf16x8*)(Qp + 16 * d0); }
    const unsigned char* Kb = (const unsigned char*)(Kh + (size_t)bh * SEQ * DQK);
    const bf16* Vb = Vt + (size_t)bh * 64 * 4096 + tid * 8;
    const int kl0 = (tid / 12) * KP + (tid % 12) * 16, kl1 = ((512 + tid) / 12) * KP + ((512 + tid) % 12) * 16, vl = (tid >> 3) * VP + (tid & 7) * 16;
    const int ntiles = 4 * (qb + 1);
    const int krow = (i32 & ~12) | ((i32 & 4) << 1) | ((i32 & 8) >> 1);
    const int koff = OFF_K + krow * KP + hi * 16, voff = OFF_V + i32 * VP + hi * 16;
    const int q = qw0 + i32;
    f32x16 o0, o1;
#pragma unroll
    for (int r = 0; r < 16; ++r) { o0[r] = 0.f; o1[r] = 0.f; }
    float lsum = 0.f;
    v4u rk0, rk1 = (v4u){0u, 0u, 0u, 0u}, rvv;
#define ATT_LDK(T) do { const unsigned char* kt_ = Kb + (size_t)(T) * (64 * DQK * 2); rk0 = *(const GAS v4u*)(kt_ + tid * 16); if (tid < 256) rk1 = *(const GAS v4u*)(kt_ + (512 + tid) * 16); } while (0)
#define ATT_STK(NB) do { *(LAS v4u*)(lds + OFF_K + (NB) * KBUF + kl0) = rk0; if (tid < 256) *(LAS v4u*)(lds + OFF_K + (NB) * KBUF + kl1) = rk1; } while (0)
    ATT_LDK(0); rvv = *(const GAS v4u*)(Vb); ATT_STK(0); *(LAS v4u*)(lds + OFF_V + vl) = rvv;
    ATT_LDK(1); ATT_STK(1);
    __syncthreads();
    f32x16 sA0, sA1, sB0, sB1;
    {
#pragma unroll
        for (int r = 0; r < 16; ++r) { sA0[r] = 0.f; sA1[r] = 0.f; }
#pragma unroll
        for (int d0 = 0; d0 < 6; ++d0) { const bf16x8 kf0 = *(const LAS bf16x8*)(lds + koff + d0 * 32), kf1 = *(const LAS bf16x8*)(lds + 32 * KP + koff + d0 * 32);
            sA0 = __builtin_amdgcn_mfma_f32_32x32x16_bf16(kf0, qf[d0], sA0, 0, 0, 0); sA1 = __builtin_amdgcn_mfma_f32_32x32x16_bf16(kf1, qf[d0], sA1, 0, 0, 0); }
    }
    __syncthreads();
    auto step = [&](f32x16& c0, f32x16& c1, f32x16& n0, f32x16& n1, const int t, const int par) {
        if (t + 2 < ntiles) ATT_LDK(t + 2);
        if (t + 1 < ntiles) rvv = *(const GAS v4u*)(Vb + (t + 1) * 4096);
        v4u pw[4]; float ps = 0.f;
        const int kbase = (par ^ 1) * KBUF + koff, keyb = 64 * t + 8 * hi;
        if (t >= ntiles - 4) {
#pragma unroll
            for (int r = 0; r < 16; ++r) { const int key = keyb + 16 * (r >> 3) + (r & 7); if (key > q) c0[r] = -INFINITY; if (key + 32 > q) c1[r] = -INFINITY; } }
        attn_qk_softmax(lds, kbase, qf, c0, c1, n0, n1, pw, ps);
        lsum += ps;
#pragma unroll
        for (int f = 0; f < 4; ++f) { const bf16x8 pa = __builtin_bit_cast(bf16x8, pw[f]);
            const bf16x8 vf0 = *(const LAS bf16x8*)(lds + par * VBUF + voff + f * 32), vf1 = *(const LAS bf16x8*)(lds + par * VBUF + voff + 32 * VP + f * 32);
            o0 = __builtin_amdgcn_mfma_f32_32x32x16_bf16(pa, vf0, o0, 0, 0, 0); o1 = __builtin_amdgcn_mfma_f32_32x32x16_bf16(pa, vf1, o1, 0, 0, 0); }
        if (t + 2 < ntiles) ATT_STK(par);
        if (t + 1 < ntiles) *(LAS v4u*)(lds + OFF_V + (par ^ 1) * VBUF + vl) = rvv;
        __syncthreads();
    };
    for (int t = 0; t < ntiles; t += 2) { step(sA0, sA1, sB0, sB1, t, 0); step(sB0, sB1, sA0, sA1, t + 1, 1); }
#undef ATT_LDK
#undef ATT_STK
    lsum = pg8::xsum32(lsum);
    LAS float* lsc = (LAS float*)(lds + OFF_L) + wid * 32;
    if (hi == 0) lsc[i32] = lsum;
    LDS_WAIT(); asm volatile("" ::: "memory");
    bf16* Op = O + ((size_t)b * SEQ + qw0) * 512 + h * 64 + i32;
#pragma unroll
    for (int r = 0; r < 16; ++r) { const int qr = (r & 3) + 8 * (r >> 2) + 4 * hi; const float inv = 1.0f / lsc[qr];
        Op[(size_t)qr * 512] = (bf16)f2bf(o0[r] * inv); Op[(size_t)qr * 512 + 32] = (bf16)f2bf(o1[r] * inv); }
    LDS_WAIT(); asm volatile("" ::: "memory");
}
__device__ __forceinline__ void attn_softmax_pack(f32x16& s0, f32x16& s1, const bool diag, const int q, const int keyb, float& lsum, v4u (&pa)[4]) {
    float p0[16], p1[16];
#pragma unroll
    for (int r = 0; r < 16; ++r) { p0[r] = __builtin_amdgcn_exp2f(s0[r]); p1[r] = __builtin_amdgcn_exp2f(s1[r]); }
    if (diag) { asm volatile("" ::: "memory");
#pragma unroll
        for (int r = 0; r < 16; ++r) { const int key = keyb + 16 * (r >> 3) + (r & 7); if (key > q) p0[r] = 0.f; if (key + 32 > q) p1[r] = 0.f; } }
    float ps = 0.f;
#pragma unroll
    for (int r = 0; r < 16; ++r) ps += p0[r] + p1[r];
    lsum += ps;
#pragma unroll
    for (int k = 0; k < 2; ++k) {
        pa[k].x = pg8::cvt_pk_bf16(p0[8 * k], p0[8 * k + 1]); pa[k].y = pg8::cvt_pk_bf16(p0[8 * k + 2], p0[8 * k + 3]); pa[k].z = pg8::cvt_pk_bf16(p0[8 * k + 4], p0[8 * k + 5]); pa[k].w = pg8::cvt_pk_bf16(p0[8 * k + 6], p0[8 * k + 7]);
        pa[2 + k].x = pg8::cvt_pk_bf16(p1[8 * k], p1[8 * k + 1]); pa[2 + k].y = pg8::cvt_pk_bf16(p1[8 * k + 2], p1[8 * k + 3]); pa[2 + k].z = pg8::cvt_pk_bf16(p1[8 * k + 4], p1[8 * k + 5]); pa[2 + k].w = pg8::cvt_pk_bf16(p1[8 * k + 6], p1[8 * k + 7]); }
}
__device__ __forceinline__ void attn_unit3(LAS unsigned char* lds, const bf16* Qh, const bf16* Kh, const bf16* Vt, bf16* O, int bh, int qb, int tid_in) {
    int tid = tid_in; asm volatile("" : "+v"(tid));
    const int lane = tid & 63, wid = __builtin_amdgcn_readfirstlane(tid >> 6), i32 = lane & 31, hi = lane >> 5;
    const int b = bh >> 3, h = bh & 7, q0 = qb * 512, qA0 = q0 + wid * 32, qB0 = q0 + (15 - wid) * 32;
    bf16x8 qa[6], qb_[6];
    { const bf16* Qp = Qh + ((size_t)bh * SEQ + qA0 + i32) * DQK + hi * 8; const bf16* Qq = Qh + ((size_t)bh * SEQ + qB0 + i32) * DQK + hi * 8;
#pragma unroll
      for (int d0 = 0; d0 < 6; ++d0) { qa[d0] = *(const GAS bf16x8*)(Qp + 16 * d0); qb_[d0] = *(const GAS bf16x8*)(Qq + 16 * d0); } }
    const unsigned char* Kb = (const unsigned char*)(Kh + (size_t)bh * SEQ * DQK);
    const unsigned char* Vb = (const unsigned char*)(Vt + (size_t)bh * 64 * 4096);
    const unsigned go0 = (unsigned)tid * 16u, go1 = (unsigned)(512 + tid) * 16u;
    const int kl0 = (tid / 12) * KP + (tid % 12) * 16, kl1 = ((512 + tid) / 12) * KP + ((512 + tid) % 12) * 16, vl = (tid >> 3) * VP + (tid & 7) * 16;
    const int ntiles = 8 * (qb + 1);
    const int krow = (i32 & ~12) | ((i32 & 4) << 1) | ((i32 & 8) >> 1);
    const int koff = OFF_K + krow * KP + hi * 16, voff = OFF_V + i32 * VP + hi * 16;
    f32x16 oa0, oa1, ob0, ob1;
#pragma unroll
    for (int r = 0; r < 16; ++r) { oa0[r] = 0.f; oa1[r] = 0.f; ob0[r] = 0.f; ob1[r] = 0.f; }
    float lsa = 0.f, lsb = 0.f;
    v4u r0, r1 = (v4u){0u, 0u, 0u, 0u}, rv;
    r0 = *(const GAS v4u*)(Kb + go0); if (tid < 256) r1 = *(const GAS v4u*)(Kb + go1); rv = *(const GAS v4u*)(Vb + go0);
    *(LAS v4u*)(lds + OFF_K + kl0) = r0; if (tid < 256) *(LAS v4u*)(lds + OFF_K + kl1) = r1; *(LAS v4u*)(lds + OFF_V + vl) = rv;
    __syncthreads();
    for (int t = 0; t < ntiles; ++t) {
        const int cur = t & 1; const bool more = (t + 1 < ntiles);
        if (more) { const unsigned char* kt_ = Kb + (size_t)(t + 1) * (64 * DQK * 2);
            r0 = *(const GAS v4u*)(kt_ + go0); if (tid < 256) r1 = *(const GAS v4u*)(kt_ + go1); rv = *(const GAS v4u*)(Vb + (size_t)(t + 1) * 8192 + go0); }
#define ATT3_BLOCK(QF, O0, O1, LS, QBASE) do { if (64 * t <= (QBASE) + 31) { \
            f32x16 s0, s1; _Pragma("unroll") for (int r = 0; r < 16; ++r) { s0[r] = 0.f; s1[r] = 0.f; } \
            _Pragma("unroll") for (int d0 = 0; d0 < 6; ++d0) { const bf16x8 kf0 = *(const LAS bf16x8*)(lds + cur * KBUF + koff + d0 * 32), kf1 = *(const LAS bf16x8*)(lds + cur * KBUF + 32 * KP + koff + d0 * 32); \
                s0 = __builtin_amdgcn_mfma_f32_32x32x16_bf16(kf0, QF[d0], s0, 0, 0, 0); s1 = __builtin_amdgcn_mfma_f32_32x32x16_bf16(kf1, QF[d0], s1, 0, 0, 0); } \
            v4u pw[4]; attn_softmax_pack(s0, s1, 64 * t + 63 > (QBASE), (QBASE) + i32, 64 * t + 8 * hi, LS, pw); \
            _Pragma("unroll") for (int f = 0; f < 4; ++f) { \
                const bf16x8 vf0 = *(const LAS bf16x8*)(lds + cur * VBUF + voff + f * 32), vf1 = *(const LAS bf16x8*)(lds + cur * VBUF + voff + 32 * VP + f * 32); \
                const bf16x8 fp = __builtin_bit_cast(bf16x8, pw[f]); \
                O0 = __builtin_amdgcn_mfma_f32_32x32x16_bf16(fp, vf0, O0, 0, 0, 0); O1 = __builtin_amdgcn_mfma_f32_32x32x16_bf16(fp, vf1, O1, 0, 0, 0); } } \
            __builtin_amdgcn_sched_barrier(0); } while (0)
        ATT3_BLOCK(qa, oa0, oa1, lsa, qA0);
        ATT3_BLOCK(qb_, ob0, ob1, lsb, qB0);
#undef ATT3_BLOCK
        if (more) { const int nb = cur ^ 1; *(LAS v4u*)(lds + OFF_K + nb * KBUF + kl0) = r0; if (tid < 256) *(LAS v4u*)(lds + OFF_K + nb * KBUF + kl1) = r1; *(LAS v4u*)(lds + OFF_V + nb * VBUF + vl) = rv; }
        __syncthreads();
    }
    lsa = pg8::xsum32(lsa); lsb = pg8::xsum32(lsb);
    LAS float* lsc = (LAS float*)(lds + OFF_L) + wid * 64;
    if (hi == 0) { lsc[i32] = lsa; lsc[32 + i32] = lsb; }
    LDS_WAIT(); asm volatile("" ::: "memory");
    bf16* Op = O + ((size_t)b * SEQ + qA0) * 512 + h * 64 + i32; bf16* Oq = O + ((size_t)b * SEQ + qB0) * 512 + h * 64 + i32;
#pragma unroll
    for (int r = 0; r < 16; ++r) { const int qr = (r & 3) + 8 * (r >> 2) + 4 * hi; const float ia = 1.0f / lsc[qr], ib = 1.0f / lsc[32 + qr];
        Op[(size_t)qr * 512] = (bf16)f2bf(oa0[r] * ia); Op[(size_t)qr * 512 + 32] = (bf16)f2bf(oa1[r] * ia);
        Oq[(size_t)qr * 512] = (bf16)f2bf(ob0[r] * ib); Oq[(size_t)qr * 512 + 32] = (bf16)f2bf(ob1[r] * ib); }
    LDS_WAIT(); asm volatile("" ::: "memory");
}
constexpr int STB = 24576, STV = 16384, OFF_L4 = 3 * STB, LDS_NEED4 = OFF_L4 + NWAVES * 64 * 4;
static_assert(LDS_NEED4 <= RING_BYTES, "attention LDS (DMA ring)");
__device__ __forceinline__ void attn_unit4(LAS unsigned char* lds, const bf16* Qh, const bf16* Kh, const bf16* Vt, bf16* O, int bh, int qb, int tid_in) {
    int tid = tid_in; asm volatile("" : "+v"(tid));
    const int lane = tid & 63, wid = __builtin_amdgcn_readfirstlane(tid >> 6), i32 = lane & 31, hi = lane >> 5;
    const int b = bh >> 3, h = bh & 7, q0 = qb * 512, qA0 = q0 + wid * 32, qB0 = q0 + (15 - wid) * 32;
    bf16x8 qa[6], qb_[6];
    { const bf16* Qp = Qh + ((size_t)bh * SEQ + qA0 + i32) * DQK + hi * 8; const bf16* Qq = Qh + ((size_t)bh * SEQ + qB0 + i32) * DQK + hi * 8;
#pragma unroll
      for (int d0 = 0; d0 < 6; ++d0) { qa[d0] = *(const GAS bf16x8*)(Qp + 16 * d0); qb_[d0] = *(const GAS bf16x8*)(Qq + 16 * d0); } }
    const unsigned char* Kb = (const unsigned char*)(Kh + (size_t)bh * SEQ * DQK);
    const unsigned char* Vb = (const unsigned char*)(Vt + (size_t)bh * 64 * 4096);
    unsigned gk0, gk1, gv;
    { int s = 64 * wid + lane, row = s >> 4, c = (s & 15) ^ (row & 15); if (c >= 12) c -= 4; gk0 = (unsigned)(row * 192 + c * 16);
      s += 512; row = s >> 4; c = (s & 15) ^ (row & 15); if (c >= 12) c -= 4; gk1 = (unsigned)(row * 192 + c * 16);
      s = 64 * wid + lane; row = s >> 3; c = (s & 7) ^ ((row >> 1) & 7); gv = (unsigned)(row * 128 + c * 16); }
    const unsigned ldsb = (unsigned)(uintptr_t)lds, ldsw = (unsigned)wid * 1024u;
#define ATT4_DMA(T, ST) do { const unsigned char* kt_ = Kb + (size_t)(T) * 12288; const unsigned sb_ = ldsb + (unsigned)(ST) * STB + ldsw; \
        pg8::glds16_s(kt_, gk0, sb_); pg8::glds16_s(kt_, gk1, sb_ + 8192u); pg8::glds16_s(Vb + (size_t)(T) * 8192, gv, sb_ + STV); } while (0)
    const int ntiles = 8 * (qb + 1);
    const int krow = (i32 & ~12) | ((i32 & 4) << 1) | ((i32 & 8) >> 1);
    const int kx = krow * 256, lxk = 16 * (hi ^ (krow & 15)), vx = STV + i32 * 128, lxv = 16 * (hi ^ ((i32 >> 1) & 7));
    f32x16 oa0, oa1, ob0, ob1;
#pragma unroll
    for (int r = 0; r < 16; ++r) { oa0[r] = 0.f; oa1[r] = 0.f; ob0[r] = 0.f; ob1[r] = 0.f; }
    float lsa = 0.f, lsb = 0.f;
    __syncthreads();
    ATT4_DMA(0, 0); ATT4_DMA(1, 1);
    int st = 0;
#define ATT4_STEP_HEAD() \
        if (t + 1 < ntiles) asm volatile("s_waitcnt vmcnt(3)" ::: "memory"); else asm volatile("s_waitcnt vmcnt(0)" ::: "memory"); \
        __syncthreads();        \
        if (t + 2 < ntiles) { const int s2 = st == 0 ? 2 : st - 1; ATT4_DMA(t + 2, s2); } \
        LAS unsigned char* sp = lds + st * STB
    for (int t = 0; t < ntiles - 8; ++t) {
        ATT4_STEP_HEAD();
#define KFR(d, hh) (*(const LAS bf16x8*)(sp + kx + ((32 * (d)) ^ lxk) + (hh) * 8192))
#define VFR(f, hh) (*(const LAS bf16x8*)(sp + vx + ((32 * (f)) ^ lxv) + (hh) * 4096))
#define ATT4_BLOCK(QF, O0, O1, LS, QBASE) do { if (64 * t <= (QBASE) + 31) { \
            f32x16 s0, s1; _Pragma("unroll") for (int r = 0; r < 16; ++r) { s0[r] = 0.f; s1[r] = 0.f; } \
            _Pragma("unroll") for (int d0 = 0; d0 < 6; ++d0) { const bf16x8 kf0 = KFR(d0, 0), kf1 = KFR(d0, 1); \
                s0 = __builtin_amdgcn_mfma_f32_32x32x16_bf16(kf0, QF[d0], s0, 0, 0, 0); s1 = __builtin_amdgcn_mfma_f32_32x32x16_bf16(kf1, QF[d0], s1, 0, 0, 0); } \
            v4u pw[4]; attn_softmax_pack(s0, s1, 64 * t + 63 > (QBASE), (QBASE) + i32, 64 * t + 8 * hi, LS, pw); \
            _Pragma("unroll") for (int f = 0; f < 4; ++f) { const bf16x8 vf0 = VFR(f, 0), vf1 = VFR(f, 1); const bf16x8 fp = __builtin_bit_cast(bf16x8, pw[f]); \
                O0 = __builtin_amdgcn_mfma_f32_32x32x16_bf16(fp, vf0, O0, 0, 0, 0); O1 = __builtin_amdgcn_mfma_f32_32x32x16_bf16(fp, vf1, O1, 0, 0, 0); } } \
            __builtin_amdgcn_sched_barrier(0); } while (0)
        {
            f32x16 sA, sB; v4u pwA[4], pwB[4]; float psA = 0.f, psB = 0.f;
            bf16x8 k1[6], k2[6], k3[6], k4[6], vf[4][2], vg[4][2];
#define ATT4_Z(v) f32x16 v; _Pragma("unroll") for (int r = 0; r < 16; ++r) v[r] = 0.f
            k1[0] = KFR(0, 0);
            ATT_SBAR();
#pragma unroll
            for (int d0 = 0; d0 < 6; ++d0) {
                if (d0 + 1 < 6) k1[d0 + 1] = KFR(d0 + 1, 0); else k2[0] = KFR(0, 0);
                if (d0 == 0) { ATT4_Z(z); sA = __builtin_amdgcn_mfma_f32_32x32x16_bf16(k1[0], qa[0], z, 0, 0, 0); } else sA = __builtin_amdgcn_mfma_f32_32x32x16_bf16(k1[d0], qa[d0], sA, 0, 0, 0);
                ATT_SBAR(); }
#pragma unroll
            for (int d0 = 0; d0 < 6; ++d0) {
                if (d0 + 1 < 6) k2[d0 + 1] = KFR(d0 + 1, 0); else k3[0] = KFR(0, 1);
                if (d0 == 0) { ATT4_Z(z); sB = __builtin_amdgcn_mfma_f32_32x32x16_bf16(k2[0], qb_[0], z, 0, 0, 0); } else sB = __builtin_amdgcn_mfma_f32_32x32x16_bf16(k2[d0], qb_[d0], sB, 0, 0, 0);
                if (d0 < 4) attn_slice(d0, sA, sA, pwA, psA);
                ATT_SBAR(); }
#pragma unroll
            for (int d0 = 0; d0 < 6; ++d0) {
                if (d0 + 1 < 6) k3[d0 + 1] = KFR(d0 + 1, 1); else k4[0] = KFR(0, 1);
                if (d0 == 0) { ATT4_Z(z); sA = __builtin_amdgcn_mfma_f32_32x32x16_bf16(k3[0], qa[0], z, 0, 0, 0); } else sA = __builtin_amdgcn_mfma_f32_32x32x16_bf16(k3[d0], qa[d0], sA, 0, 0, 0);
                if (d0 < 4) attn_slice(d0, sB, sB, pwB, psB);
                ATT_SBAR(); }
#pragma unroll
            for (int d0 = 0; d0 < 6; ++d0) {
                if (d0 + 1 < 6) k4[d0 + 1] = KFR(d0 + 1, 1); else { vf[0][0] = VFR(0, 0); vf[0][1] = VFR(0, 1); }
                if (d0 == 0) { ATT4_Z(z); sB = __builtin_amdgcn_mfma_f32_32x32x16_bf16(k4[0], qb_[0], z, 0, 0, 0); } else sB = __builtin_amdgcn_mfma_f32_32x32x16_bf16(k4[d0], qb_[d0], sB, 0, 0, 0);
                if (d0 < 4) attn_slice(4 + d0, sA, sA, pwA, psA);
                ATT_SBAR(); }
#undef ATT4_Z
#pragma unroll
            for (int f = 0; f < 4; ++f) {
                if (f + 1 < 4) { vf[f + 1][0] = VFR(f + 1, 0); vf[f + 1][1] = VFR(f + 1, 1); } else { vg[0][0] = VFR(0, 0); vg[0][1] = VFR(0, 1); }
                const bf16x8 fp = __builtin_bit_cast(bf16x8, pwA[f]);
                oa0 = __builtin_amdgcn_mfma_f32_32x32x16_bf16(fp, vf[f][0], oa0, 0, 0, 0);
                attn_slice(4 + f, sB, sB, pwB, psB);
                ATT_SBAR();
                oa1 = __builtin_amdgcn_mfma_f32_32x32x16_bf16(fp, vf[f][1], oa1, 0, 0, 0);
                ATT_SBAR(); }
#pragma unroll
            for (int f = 0; f < 4; ++f) {
                if (f + 1 < 4) { vg[f + 1][0] = VFR(f + 1, 0); vg[f + 1][1] = VFR(f + 1, 1); }
                const bf16x8 fp = __builtin_bit_cast(bf16x8, pwB[f]);
                ob0 = __builtin_amdgcn_mfma_f32_32x32x16_bf16(fp, vg[f][0], ob0, 0, 0, 0); ob1 = __builtin_amdgcn_mfma_f32_32x32x16_bf16(fp, vg[f][1], ob1, 0, 0, 0);
                ATT_SBAR(); }
            lsa += psA; lsb += psB;
        }
        st = st == 2 ? 0 : st + 1;
    }
    for (int t = ntiles - 8; t < ntiles; ++t) {
        ATT4_STEP_HEAD();
        ATT4_BLOCK(qa, oa0, oa1, lsa, qA0);
        ATT4_BLOCK(qb_, ob0, ob1, lsb, qB0);
        st = st == 2 ? 0 : st + 1;
    }
#undef KFR
#undef VFR
#undef ATT4_BLOCK
#undef ATT4_STEP_HEAD
#undef ATT4_DMA
    lsa = pg8::xsum32(lsa); lsb = pg8::xsum32(lsb);
    LAS float* lsc = (LAS float*)(lds + OFF_L4) + wid * 64;
    if (hi == 0) { lsc[i32] = lsa; lsc[32 + i32] = lsb; }
    LDS_WAIT(); asm volatile("" ::: "memory");
    bf16* Op = O + ((size_t)b * SEQ + qA0) * 512 + h * 64 + i32; bf16* Oq = O + ((size_t)b * SEQ + qB0) * 512 + h * 64 + i32;
#pragma unroll
    for (int r = 0; r < 16; ++r) { const int qr = (r & 3) + 8 * (r >> 2) + 4 * hi; const float ia = 1.0f / lsc[qr], ib = 1.0f / lsc[32 + qr];
        Op[(size_t)qr * 512] = (bf16)f2bf(oa0[r] * ia); Op[(size_t)qr * 512 + 32] = (bf16)f2bf(oa1[r] * ia);
        Oq[(size_t)qr * 512] = (bf16)f2bf(ob0[r] * ib); Oq[(size_t)qr * 512 + 32] = (bf16)f2bf(ob1[r] * ib); }
    LDS_WAIT(); asm volatile("" ::: "memory");
}
__device__ __forceinline__ void attn_phase(const Frame& F, const bf16* Qh, const bf16* Kh, const bf16* Vt, bf16* O) {
    for (int P = F.vcu; P < BATCH * NH * 4; P += F.G) { const int bh = P >> 2, s = P & 3;
        attn_unit4(F.lds, Qh, Kh, Vt, O, bh, s, F.tid); attn_unit4(F.lds, Qh, Kh, Vt, O, bh, 7 - s, F.tid); }
    __syncthreads();
}
}
namespace lru {
__device__ __forceinline__ float neg_expm1(float x) {
    const float t = x * (1.0f + x * (0.5f + x * (0.16666667f + x * (0.041666668f + x * (0.0083333338f + x * 0.0013888889f)))));
    const float e = 1.0f - __builtin_amdgcn_exp2f(1.4426950408889634f * x);
    return (x > -0.25f) ? -t : e;
}
typedef short bf16x8 __attribute__((ext_vector_type(8)));
typedef float f32x16 __attribute__((ext_vector_type(16)));
constexpr int CHUNK = 128, NCHUNK = SEQ / CHUNK, XP = 144;
constexpr int WAVE_LDS = 2 * 32 * XP;
__device__ __forceinline__ void tile_store(LAS unsigned char* T, int lane, const unsigned (&pk)[2][8], bf16* dst  ) {
    const int i32 = lane & 31, hi = lane >> 5;
#pragma unroll
    for (int cb = 0; cb < 2; ++cb)
#pragma unroll
        for (int q = 0; q < 8; ++q) { const int r = 2 * q; LAS unsigned short* p = (LAS unsigned short*)(T + ((r & 3) + 8 * (r >> 2) + 4 * hi) * XP + (32 * cb + i32) * 2);
            p[0] = (unsigned short)pk[cb][q]; p[XP / 2] = (unsigned short)(pk[cb][q] >> 16); }
    LDS_WAIT(); asm volatile("" ::: "memory");
#pragma unroll
    for (int i = 0; i < 4; ++i) { const int tok = (lane >> 3) + 8 * i, cc = lane & 7; __builtin_nontemporal_store(*(const LAS v4u*)(T + tok * XP + cc * 16), (GAS v4u*)(dst + (size_t)tok * LW + 8 * cc)); }
    LDS_WAIT(); asm volatile("" ::: "memory");
}
__device__ __forceinline__ void tile_fetch(int lane, const bf16* src, v4u (&ld)[4]) {
#pragma unroll
    for (int i = 0; i < 4; ++i) { const int tok = (lane >> 3) + 8 * i, cc = lane & 7; ld[i] = __builtin_nontemporal_load((const GAS v4u*)(src + (size_t)tok * LW + 8 * cc)); }
}
__device__ __forceinline__ void tile_unpack(LAS unsigned char* T, int lane, const v4u (&ld)[4], float (&out)[2][16]) {
    const int i32 = lane & 31, hi = lane >> 5;
#pragma unroll
    for (int i = 0; i < 4; ++i) { const int tok = (lane >> 3) + 8 * i, cc = lane & 7; *(LAS v4u*)(T + tok * XP + cc * 16) = ld[i]; }
    LDS_WAIT(); asm volatile("" ::: "memory");
#pragma unroll
    for (int cb = 0; cb < 2; ++cb)
#pragma unroll
        for (int r = 0; r < 16; ++r) out[cb][r] = bf2f(*(const LAS unsigned short*)(T + ((r & 3) + 8 * (r >> 2) + 4 * hi) * XP + (32 * cb + i32) * 2));
    LDS_WAIT(); asm volatile("" ::: "memory");
}
__device__ __forceinline__ void lru_xrows(v4u (&xq)[7], const bf16* xl, const bf16* halo, int b, int chunk, int t0, int s0, int col) {
#pragma unroll
    for (int j = 0; j < 7; ++j) { const int sj = s0 - 3 + j;
        if (sj >= 0) { const bf16* src = (sj < t0) ? halo + ((size_t)((b * NCHUNK + chunk - 1) * 3 + (sj - (t0 - 3)))) * LW : xl + ((size_t)b * SEQ + sj) * LW; xq[j] = __builtin_nontemporal_load((const GAS v4u*)(src + col)); }
        else xq[j] = (v4u){0u, 0u, 0u, 0u}; }
}
template <int PASS> __device__ __forceinline__ void lru_unit(LAS unsigned char* wl, int lane, int b, int chunk, int head, const bf16* xl, const bf16* gl, const float* convw, const float* convb,
        const bf16* wgt  , const float* brg, const float* big, const float* lam, float* carry, bf16* y, bf16* apark  , bf16* xb_  , const bf16* halo  ) {
    const int i32 = lane & 31, hi = lane >> 5;
    const int t0 = chunk * CHUNK; const size_t row0 = (size_t)b * SEQ + t0; const int c0 = head * 64;
    float cbrg[2], cbig[2], csp8[2], hcar[2], ptot[2];
#pragma unroll
    for (int cb = 0; cb < 2; ++cb) { const int c = c0 + 32 * cb + i32; cbrg[cb] = -1.4426950408889634f * brg[c]; cbig[cb] = -1.4426950408889634f * big[c];
        const float l = -lam[c]; csp8[cb] = -1.4426950408889634f * 8.0f * (fmaxf(l, 0.f) + log1pf(expf(-fabsf(l))));
        hcar[cb] = 0.f; ptot[cb] = 1.f; }
    if (PASS == 2) {
#pragma unroll
        for (int cb = 0; cb < 2; ++cb) { const int c = c0 + 32 * cb + i32; float hh = 0.f;
            const float* cp = carry + ((size_t)b * NCHUNK * LW + c) * 2;
            for (int j0 = 0; j0 < chunk; j0 += 8) { f32x2v pc[8];
#pragma unroll
                for (int k = 0; k < 8; ++k) { const int j = (j0 + k < chunk) ? j0 + k : chunk - 1; pc[k] = *(const GAS f32x2v*)(cp + (size_t)j * LW * 2); }
#pragma unroll
                for (int k = 0; k < 8; ++k) if (j0 + k < chunk) hh = pc[k].x * hh + pc[k].y; }
            hcar[cb] = hh; }
    }
    const int cc = lane & 7;
    LAS unsigned char* T = wl + 32 * XP;
    v4u xq[7];
    if (PASS == 1) lru_xrows(xq, xl, halo, b, chunk, t0, t0 + 4 * (lane >> 3), c0 + 8 * (lane & 7));
    unsigned bst[2][8];
    for (int mb = 0; mb < CHUNK / 32; ++mb) {
        f32x16 acc[4]; float A_[2][16], B_[2][16], G_[2][16];
        if constexpr (PASS == 1) {
        int zc = 0; asm volatile("" : "+v"(zc));
        const float* cwp = convw + c0 + 8 * cc + zc; const float* cbp = convb + c0 + 8 * cc + zc;
        { const int tk0 = 4 * (lane >> 3);
          float xr[7][8];
#pragma unroll
          for (int j = 0; j < 7; ++j) unpack8(xq[j], xr[j]);
          if (mb + 1 < CHUNK / 32) lru_xrows(xq, xl, halo, b, chunk, t0, t0 + 32 * (mb + 1) + tk0, c0 + 8 * cc);
          float cwv[4][8], cbv[8];
          { const f32x4 b0 = *(const GAS f32x4*)cbp, b1 = *(const GAS f32x4*)(cbp + 4); cbv[0] = b0.x; cbv[1] = b0.y; cbv[2] = b0.z; cbv[3] = b0.w; cbv[4] = b1.x; cbv[5] = b1.y; cbv[6] = b1.z; cbv[7] = b1.w; }
#pragma unroll
          for (int j = 0; j < 4; ++j) { const f32x4 w0 = *(const GAS f32x4*)(cwp + j * LW), w1 = *(const GAS f32x4*)(cwp + j * LW + 4);
              cwv[j][0] = w0.x; cwv[j][1] = w0.y; cwv[j][2] = w0.z; cwv[j][3] = w0.w; cwv[j][4] = w1.x; cwv[j][5] = w1.y; cwv[j][6] = w1.z; cwv[j][7] = w1.w; }
#pragma unroll
          for (int i = 0; i < 4; ++i) { float a8[8];
#pragma unroll
              for (int e = 0; e < 8; ++e) a8[e] = cbv[e] + cwv[0][e] * xr[i][e] + cwv[1][e] * xr[i + 1][e] + cwv[2][e] * xr[i + 2][e] + cwv[3][e] * xr[i + 3][e];
              v4u o; o.x = pk2(a8[0], a8[1]); o.y = pk2(a8[2], a8[3]); o.z = pk2(a8[4], a8[5]); o.w = pk2(a8[6], a8[7]);
              *(LAS v4u*)(wl + (tk0 + i) * XP + cc * 16) = o; } }
        LDS_WAIT(); asm volatile("" ::: "memory");
        if (mb > 0) tile_store(T, lane, bst, xb_ + (row0 + 32 * (mb - 1)) * LW + c0);
#pragma unroll
        for (int nb = 0; nb < 4; ++nb)
#pragma unroll
            for (int r = 0; r < 16; ++r) acc[nb][r] = 0.f;
        int zo = 0; asm volatile("" : "+v"(zo));
        const bf16* wrow = wgt + ((size_t)head * 128 + i32) * 64 + 8 * hi + zo;
#pragma unroll
        for (int kk = 0; kk < 4; ++kk) { const bf16x8 af = *(const LAS bf16x8*)(wl + i32 * XP + (16 * kk + 8 * hi) * 2);
#pragma unroll
            for (int nb = 0; nb < 4; ++nb) { const bf16x8 wf = *(const GAS bf16x8*)(wrow + ((nb >> 1) * 64 + (nb & 1) * 32) * 64 + 16 * kk);
                acc[nb] = __builtin_amdgcn_mfma_f32_32x32x16_bf16(af, wf, acc[nb], 0, 0, 0); } }
        } else {
            v4u la[4], lb[4], lg[4];
            tile_fetch(lane, apark + (row0 + 32 * mb) * LW + c0, la); tile_fetch(lane, xb_ + (row0 + 32 * mb) * LW + c0, lb); tile_fetch(lane, gl + (row0 + 32 * mb) * LW + c0, lg);
            tile_unpack(T, lane, la, A_); tile_unpack(T, lane, lb, B_); tile_unpack(T, lane, lg, G_);
        }
        unsigned ow[2][8];
#pragma unroll
        for (int cb = 0; cb < 2; ++cb) {
            float av[16], bv[16];
            if constexpr (PASS == 1) {
#pragma unroll
            for (int r = 0; r < 16; ++r) { const int tok = (r & 3) + 8 * (r >> 2) + 4 * hi;
                const float rg = __builtin_amdgcn_rcpf(1.0f + __builtin_amdgcn_exp2f(__builtin_fmaf(acc[cb][r], -1.4426950408889634f, cbrg[cb]))), ig = __builtin_amdgcn_rcpf(1.0f + __builtin_amdgcn_exp2f(__builtin_fmaf(acc[2 + cb][r], -1.4426950408889634f, cbig[cb])));
                const float a = __builtin_amdgcn_exp2f(rg * csp8[cb]); const float mult = __builtin_amdgcn_sqrtf(__builtin_fmaf(-a, a, 1.0f));
                const float xc = bf2f(*(const LAS unsigned short*)(wl + tok * XP + (32 * cb + i32) * 2));
                av[r] = a; bv[r] = mult * ig * xc; }
#pragma unroll
            for (int q = 0; q < 8; ++q) { ow[cb][q] = pg8::cvt_pk_bf16(1.0f - av[2 * q], 1.0f - av[2 * q + 1]); bst[cb][q] = pg8::cvt_pk_bf16(bv[2 * q], bv[2 * q + 1]); }
            } else {
#pragma unroll
            for (int r = 0; r < 16; ++r) { av[r] = 1.0f - A_[cb][r]; bv[r] = B_[cb][r]; }
            }
            float gA[4], gB[4];
#pragma unroll
            for (int g = 0; g < 4; ++g) { float P = av[4 * g], Hl = bv[4 * g];
#pragma unroll
                for (int i = 1; i < 4; ++i) { Hl = av[4 * g + i] * Hl + bv[4 * g + i]; P *= av[4 * g + i]; bv[4 * g + i] = Hl; av[4 * g + i] = P; }
                gA[g] = P; gB[g] = Hl; }
            float hin[4]; float hh = hcar[cb], pp = ptot[cb];
#pragma unroll
            for (int g = 0; g < 4; ++g) { const float oA = pg8::xother32(gA[g], hi), oB = pg8::xother32(gB[g], hi);
                const float fA = hi ? oA : gA[g], fB = hi ? oB : gB[g], sA = hi ? gA[g] : oA, sB = hi ? gB[g] : oB;
                const float h_first = hh; hh = fA * hh + fB; const float h_second = hh; hh = sA * hh + sB; pp *= fA * sA;
                hin[g] = hi ? h_second : h_first; }
            hcar[cb] = hh; ptot[cb] = pp;
            if (PASS == 2) {
#pragma unroll
                for (int q = 0; q < 8; ++q) { float o2[2];
#pragma unroll
                    for (int k = 0; k < 2; ++k) { const int r = 2 * q + k; const float hv = __builtin_fmaf(av[r], hin[r >> 2], bv[r]);
                        const float gx = G_[cb][r];
                        const float t2 = gx * gx, u2 = gx * __builtin_fmaf(t2, -0.10294324f, -2.3022082f);
                        o2[k] = hv * gx * __builtin_amdgcn_rcpf(1.0f + __builtin_amdgcn_exp2f(u2)); }
                    ow[cb][q] = pg8::cvt_pk_bf16(o2[0], o2[1]); }
            }
        }
        tile_store(T, lane, ow, (PASS == 1 ? apark : y) + (row0 + 32 * mb) * LW + c0);
    }
    if (PASS == 1) tile_store(T, lane, bst, xb_ + (row0 + 32 * (CHUNK / 32 - 1)) * LW + c0);
    if (PASS == 1 && hi == 0) {
#pragma unroll
        for (int cb = 0; cb < 2; ++cb) { const int c = c0 + 32 * cb + i32; *(GAS f32x2v*)(carry + (((size_t)b * NCHUNK + chunk) * LW + c) * 2) = (f32x2v){ptot[cb], hcar[cb]}; }
    }
}
template <int PASS> __device__ __forceinline__ void lru_phase(const Frame& F, const bf16* xl, const bf16* gl, const float* convw, const float* convb, const bf16* wgt,
        const float* brg, const float* big, const float* lam, float* carry, bf16* y, bf16* apark, bf16* xb_, const bf16* halo) {
    LAS unsigned char* wl = F.lds + 49152 + F.wave * WAVE_LDS;
    static_assert(49152 + NWAVES * WAVE_LDS <= RING_BYTES, "RG-LRU LDS tiles");
    for (int U = F.gw; U < BATCH * NCHUNK * 8; U += F.ngw) { const int head = U & 7, chunk = (U >> 3) & (NCHUNK - 1), b = U >> 8;
        lru_unit<PASS>(wl, F.lane, b, chunk, head, xl, gl, convw, convb, wgt, brg, big, lam, carry, y, apark, xb_, halo); }
}
}
struct Args { const void* in[28]; float* out; unsigned char* ws; int ph_lo, ph_hi; };
constexpr int PH_PRO = 0, PH_L0 = 1, PH_PER_LAYER = 9, PH_MOE = PH_L0 + 2 * PH_PER_LAYER  , N_MOE_CHUNKS = 1, N_PHASES = PH_MOE + 2 * N_MOE_CHUNKS + 1;
enum { P_PROJ = 0, P_QKV = 1, P_QKPOST = 2, P_ATTN = 3, P_MERGE = 4, P_WO = 5, P_NORM2 = 6  , P_FGU = 7, P_FDN = 8   };

static_assert(sizeof(Args) == 248, "Args layout: in[28] @0, out @224, ws @232, ph_lo @240, ph_hi @244");
#define KAS __attribute__((address_space(4)))
typedef KAS const unsigned char* kptr_t;
__device__ __forceinline__ kptr_t kargs_base() { kptr_t p = (kptr_t)__builtin_amdgcn_kernarg_segment_ptr(); asm volatile("" : "+s"(p)); return p; }
#define PHASE_BASES() const kptr_t ka_ = kargs_base(); unsigned char* const ws = *(unsigned char* const KAS*)(ka_ + 232)
#define KIN(k) (*(const float* const KAS*)(ka_ + 8 * (k)))
#define KOUT() (*(float* const KAS*)(ka_ + 224))
__global__ void __launch_bounds__(NWAVES * 64, 2) fwd_kernel(Args args) {
    extern __shared__ __attribute__((aligned(16))) unsigned char lds_raw[];
    LAS unsigned char* const lds0 = (LAS unsigned char*)lds_raw;
    const int wave0 = __builtin_amdgcn_readfirstlane((int)threadIdx.x >> 6);
#define MAKE_FRAME() Frame F; { const int t_ = wave0 * 64 + pg8::fresh_lane_id(); F.lds = lds0; F.tid = t_; F.lane = t_ & 63; F.wave = wave0; \
        F.G = gridDim.x; const int bx_ = blockIdx.x; F.vcu = (F.G % 8 == 0) ? (bx_ % 8) * (F.G / 8) + bx_ / 8 : bx_; F.gw = F.vcu * NWAVES + F.wave; F.ngw = F.G * NWAVES; }
    volatile LAS unsigned* MISC = (volatile LAS unsigned*)(lds0 + MISC_OFF);
    for (int u = threadIdx.x; u < (LDS_BYTES - RING_BYTES) / 4; u += NWAVES * 64) ((LAS unsigned*)(lds0 + RING_BYTES))[u] = 0u;
    __syncthreads();
    XcdBarrier bar; bar.bar = (unsigned*)(args.ws + WS_CTL) + CW_BAR; bar.x = 0; bar.st = nullptr;
#if !MK_PER_PHASE
    bar = xcd_barrier_post((unsigned*)(args.ws + WS_CTL) + CW_BAR, MISC + 8);
#endif
    const int lo = args.ph_lo, hi = args.ph_hi;
#ifdef DIAG_WAIT
    unsigned wacc_ = 0u;
#endif
#ifndef PMASK
#define PMASK 0xFFFFFFFFu
#endif
#define EN(id) (((PMASK) >> (id)) & 1u)
#ifndef DUPMASK
#define DUPMASK 0u
#endif
#define NREP(id) (1 + (int)(((DUPMASK) >> (id)) & 1u))
#define IN(k) (lo <= (k) && (k) < hi)
#if MK_PER_PHASE
#define SEAM(k) do { } while (0)
#else
#ifdef DIAG_WAIT
#define SEAM(k) do { if (IN((k) + 1)) { const unsigned long long t0_ = __builtin_amdgcn_s_memrealtime(); xcd_barrier(bar, wave0 == 0 && pg8::fresh_lane_id() == 0); if (DIAG_SEL(k)) wacc_ += (unsigned)(__builtin_amdgcn_s_memrealtime() - t0_); } } while (0)
#else
#define SEAM(k) do { if (IN((k) + 1)) xcd_barrier(bar, wave0 == 0 && pg8::fresh_lane_id() == 0); } while (0)
#endif
#endif
    LAS unsigned char* const ring = lds0;
#define WLP(L) (ws + WS_W + (size_t)(L) * WL_STRIDE)
#define STAT(i) ((pg8::stat_t*)(ws + WS_STAT) + (size_t)(i) * NTOK)
    if (EN(0) && IN(PH_PRO)) {
        PHASE_BASES(); MAKE_FRAME(); int rot = 0;
        for (int rep_ = 0; rep_ < NREP(0); ++rep_) {
#pragma unroll 1
        for (int L = 0; L < DEPTH; ++L) {
            unsigned char* wl = WLP(L);
            bf16* w_in_t = (bf16*)(wl + WL_IN);
            convert_matrix<PROJ_F8>(F, rot, KIN(3) + (size_t)L * DM * DIN, DIN, DM, DIN / 32, w_in_t, DM, [](int cb) { return cb < 45 ? 32 * (cb + (cb >= 13 ? 3 : 0)) : -1; }, KIN(2) + (size_t)L * DM, PROJ_F8 ? 64.0f : 1.0f);
            convert_matrix<PROJ_F8>(F, rot, KIN(3) + (size_t)L * DM * DIN, DIN, DM, DIN / 32, w_in_t, DM, [](int cb) { return cb >= 45 ? 32 * (cb + 3) : -1; }, KIN(2) + (size_t)L * DM, (PROJ_F8 ? 64.0f : 1.0f) * 1.4426950408889634f);
            zero_rows(F, w_in_t, PROJ_F8 ? DM / 2 : DM, 416, 96);
            bf16* w_uq_t = (bf16*)(wl + WL_UQ);
            convert_matrix(F, rot, KIN(5) + (size_t)L * QLR * 768, 768, QLR, 24, w_uq_t, QLR, [](int cb) { return 32 * ((cb / 3) * 4 + cb % 3); }, KIN(4) + (size_t)L * QLR);
#pragma unroll 1
            for (int h = 0; h < NH; ++h) zero_rows(F, w_uq_t, QLR, 128 * h + 96, 32);
            convert_matrix(F, rot, KIN(7) + (size_t)L * KVLR * 1024, 1024, KVLR, 32, (bf16*)(wl + WL_UK), KVLR, [](int cb) { return (cb & 3) < 2 ? 32 * ((cb >> 2) * 2 + (cb & 3)) : -1; }, KIN(6) + (size_t)L * KVLR);
            convert_matrix(F, rot, KIN(7) + (size_t)L * KVLR * 1024, 1024, KVLR, 32, (bf16*)(wl + WL_UV), KVLR, [](int cb) { return (cb & 3) >= 2 ? 32 * ((cb >> 2) * 2 + (cb & 3) - 2) : -1; }, KIN(6) + (size_t)L * KVLR);
            convert_matrix(F, rot, KIN(10) + (size_t)L * 512 * DM, DM, 512, DM / 32, (bf16*)(wl + WL_UPA), 512, [](int cb) { return 32 * cb; });
            convert_matrix(F, rot, KIN(18) + (size_t)L * 512 * DM, DM, 512, DM / 32, (bf16*)(wl + WL_UPL), 512, [](int cb) { return 32 * cb; });
            convert_matrix(F, rot, KIN(19) + (size_t)L * DM * DM, DM, DM, DM / 32, (bf16*)(wl + WL_O), DM, [](int cb) { return 32 * cb; });
#pragma unroll 1
            for (int h = 0; h < 8; ++h) {
                convert_matrix(F, rot, KIN(13) + ((size_t)L * 8 + h) * 4096, 64, 64, 2, (bf16*)(wl + WL_GT) + (size_t)h * 128 * 64, 64, [](int cb) { return 32 * cb; });
                convert_matrix(F, rot, KIN(15) + ((size_t)L * 8 + h) * 4096, 64, 64, 2, (bf16*)(wl + WL_GT) + (size_t)h * 128 * 64 + 64 * 64, 64, [](int cb) { return 32 * cb; });
            }
        }
        convert_matrix<FFN_F8>(F, rot, KIN(21), DFF, DM, DFF / 32, (bf16*)(ws + WS_FGU), DM, [](int cb) { return 32 * ((cb >> 2) * 8 + (cb & 3)); }, KIN(20), (FFN_F8 ? 64.0f : 1.0f) * 1.4426950408889634f);
        convert_matrix<FFN_F8>(F, rot, KIN(22), DFF, DM, DFF / 32, (bf16*)(ws + WS_FGU), DM, [](int cb) { return 32 * ((cb >> 2) * 8 + 4 + (cb & 3)); }, KIN(20), (FFN_F8 ? 64.0f : 1.0f) * 0.6931471805599453f);
        convert_matrix<FFN_DN_F8>(F, rot, KIN(23), DM, DFF, DM / 32, (bf16*)(ws + WS_FD), DFF, [](int cb) { return 32 * cb; }, nullptr, FFN_DN_F8 ? 256.0f : 1.0f);
        xcast_rows<PROJ_F8>(F, KIN(0), (bf16*)(ws + WS_R1), STAT(0));
        { const int* pos = (const int*)KIN(1); float* rope = (float*)(ws + WS_ROPE); const int nthr = F.G * NWAVES * 64;
          for (int idx = blockIdx.x * (NWAVES * 64) + F.tid; idx < NTOK * 16; idx += nthr) { const int tok = idx >> 4, i = idx & 15;
              const double a = (double)pos[tok] * ROPE_INVF[i] * 0.15915494309189535; const double fr = a - rint(a);
              rope[(size_t)tok * 32 + i] = __builtin_amdgcn_cosf((float)fr); rope[(size_t)tok * 32 + 16 + i] = __builtin_amdgcn_sinf((float)fr); } }
        }
    }
#if !MK_PER_PHASE
    {
      if (wave0 == 0 && pg8::fresh_lane_id() == 0) xcd_barrier_census(bar);
      if (IN(PH_PRO)) SEAM(PH_PRO); }
#endif

#pragma unroll 1
    for (int L = 0; L < DEPTH; ++L) {
        const int pb = PH_L0 + L * PH_PER_LAYER;

        if (EN(2) && IN(pb + P_PROJ)) { PHASE_BASES(); MAKE_FRAME();
            for (int rep_ = 0; rep_ < NREP(2); ++rep_) { if (rep_) __syncthreads();
            pg8::Gemm g{(L == 1 && !PROJ_F8) ? (const bf16*)KOUT() : (const bf16*)(ws + (L == 0 ? WS_R1 : WS_R3 + 64 * MiB)), (const bf16*)(WLP(L) + WL_IN), NTOK, DINP, DM, (L == 1 && !PROJ_F8) ? pg8::XRP : DM, DM, 127 - 3}; pg8::StaticOrder S; S.init(NTOK, DINP, F.G, (int)blockIdx.x);
            pg8::EpiProj E{(bf16*)(ws + WS_R2), STAT(L == 0 ? 0 : 2), STAT(3 + L), STAT(5 + L), (bf16*)(ws + WS_HALO), ring};
            pg8::gemm_phase<pg8::EpiProj, pg8::StaticOrder, true, false, PROJ_F8 ? 1 : 2>(ring, g, S, E, F.wave);
            }
            SEAM(pb + P_PROJ);
        }
        if ((EN(4) || EN(14)) && IN(pb + P_QKV)) { PHASE_BASES(); MAKE_FRAME();
            for (int rep_ = 0; rep_ < NREP(4); ++rep_) { if (rep_) __syncthreads();
            bf16* cq = (bf16*)(ws + WS_R2 + R2_CQ); bf16* ckv = (bf16*)(ws + WS_R2 + R2_CKV);
            {
                pg8::Gemm g{cq, (const bf16*)(WLP(L) + WL_UQ), NTOK, 1024, QLR, QLR, QLR}; pg8::EpiQ E{STAT(3 + L), (const float*)(ws + WS_ROPE), KIN(8) + (size_t)L * DQK, (bf16*)(ws + WS_R3 + R3_Q), ring};
                pg8::StaticOrder S; S.init(NTOK, 1024, F.G, (int)blockIdx.x);
                pg8::gemm_phase<pg8::EpiQ, pg8::StaticOrder, true, false>(ring, g, S, E, F.wave);
                __syncthreads();
            }
            {
                pg8::Gemm g{ckv, (const bf16*)(WLP(L) + WL_UK), NTOK, 512, KVLR, 256, KVLR}; pg8::EpiK E{STAT(5 + L), ckv, (const float*)(ws + WS_ROPE), KIN(9) + (size_t)L * DQK, (bf16*)(ws + WS_R3 + R3_K), ring};
                pg8::StaticOrder S; S.init(NTOK, 512, F.G, (int)blockIdx.x);
                pg8::gemm_phase<pg8::EpiK, pg8::StaticOrder, true, false>(ring, g, S, E, F.wave);
                __syncthreads();
            }
            {
                pg8::Gemm g{(const bf16*)(WLP(L) + WL_UV), ckv, 512, NTOK, KVLR, KVLR, 256}; pg8::StaticOrder S; S.init(512, NTOK, F.G, (int)blockIdx.x);
                pg8::EpiStoreVt E{(bf16*)(ws + WS_R3 + R3_VT), STAT(5 + L), 1.0f / 128.0f};
                pg8::gemm_phase<pg8::EpiStoreVt, pg8::StaticOrder, true, false>(ring, g, S, E, F.wave);
                __syncthreads();
            }
            }
            for (int rep_ = 0; rep_ < NREP(14); ++rep_)
            if (EN(14)) lru::lru_phase<1>(F, (const bf16*)(ws + WS_R2 + R2_XL), (const bf16*)(ws + WS_R2 + R2_GL), KIN(11) + (size_t)L * 4 * LW, KIN(12) + (size_t)L * LW, (const bf16*)(WLP(L) + WL_GT),
                              KIN(14) + (size_t)L * LW, KIN(16) + (size_t)L * LW, KIN(17) + (size_t)L * LW, (float*)(ws + WS_CARRY), (bf16*)(ws + WS_R4 + R4_Y), (bf16*)(ws + WS_R1 + 32 * MiB), (bf16*)(ws + WS_R2 + R2_XL), (const bf16*)(ws + WS_HALO));
            SEAM(pb + P_QKV);
        }
        if ((EN(6) || EN(15)) && IN(pb + P_ATTN)) { PHASE_BASES(); MAKE_FRAME();
            for (int rep_ = 0; rep_ < NREP(6); ++rep_) { if (rep_) __syncthreads();
            if (EN(6)) att::attn_phase(F, (const bf16*)(ws + WS_R3 + R3_Q), (const bf16*)(ws + WS_R3 + R3_K), (const bf16*)(ws + WS_R3 + R3_VT), (bf16*)(ws + WS_R4 + R4_O)); }
            for (int rep_ = 0; rep_ < NREP(15); ++rep_)
            if (EN(15)) lru::lru_phase<2>(F, (const bf16*)(ws + WS_R2 + R2_XL), (const bf16*)(ws + WS_R2 + R2_GL), KIN(11) + (size_t)L * 4 * LW, KIN(12) + (size_t)L * LW, (const bf16*)(WLP(L) + WL_GT),
                              KIN(14) + (size_t)L * LW, KIN(16) + (size_t)L * LW, KIN(17) + (size_t)L * LW, (float*)(ws + WS_CARRY), (bf16*)(ws + WS_R4 + R4_Y), (bf16*)(ws + WS_R1 + 32 * MiB), (bf16*)(ws + WS_R2 + R2_XL), (const bf16*)(ws + WS_HALO));
            SEAM(pb + P_ATTN);
        }
        if (EN(7) && IN(pb + P_MERGE)) { PHASE_BASES(); MAKE_FRAME();
            for (int rep_ = 0; rep_ < NREP(7); ++rep_) { if (rep_) __syncthreads();
            {
                pg8::Gemm g{(const bf16*)(ws + WS_R4 + R4_O), (const bf16*)(WLP(L) + WL_UPA), NTOK, DM, 512, 512, 512};
                pg8::MergeOrder S; S.S.init(NTOK, DM, F.G, (int)blockIdx.x); S.aoff1 = R4_Y - R4_O; S.boff1 = WL_UPL - WL_UPA;
                pg8::EpiMerge E{(const bf16*)(ws + WS_R2 + R2_GA), (const bf16*)(ws + WS_R2 + R2_GB), (bf16*)(ws + WS_R1)};
                pg8::gemm_phase<pg8::EpiMerge, pg8::MergeOrder, true, false>(ring, g, S, E, F.wave);
                __syncthreads();
            }
            }
            SEAM(pb + P_MERGE);
        }
        if (EN(8) && IN(pb + P_WO)) { PHASE_BASES(); MAKE_FRAME();
            pg8::Gemm g{(const bf16*)(ws + WS_R1), (const bf16*)(WLP(L) + WL_O), NTOK, DM, DM, DM, DM}; pg8::StaticOrder S; S.init(NTOK, DM, F.G, (int)blockIdx.x);
            pg8::EpiResid E{L == 0 ? KIN(0) : nullptr, (bf16*)KOUT(), nullptr, L == 0 ? STAT(1) : nullptr};
            pg8::gemm_phase<pg8::EpiResid, pg8::StaticOrder, true, false>(ring, g, S, E, F.wave);
            SEAM(pb + P_WO);
        }
        if (EN(9) && L == 1 && IN(pb + P_NORM2)) { PHASE_BASES(); MAKE_FRAME();
            {
                router_rows(F, (const bf16*)KOUT(), KIN(20) + (size_t)L * DM, (unsigned char*)(ws + MOE_X8), KIN(24), RouterOut{(unsigned*)(ws + WS_CTL) + CW_CNT, (int*)(ws + WS_LTOK), (float*)(ws + WS_LW), (int*)(ws + WS_SLOT)});
                int rot = 0;
                for (int rep_ = 0; rep_ < NREP(16); ++rep_)
#pragma unroll 1
                for (int e = 0; e < NEXP; ++e) {
                    bf16* wgu = (bf16*)(ws + MOE_WGU + (size_t)e * 2 * DFE * DM);
                    convert_matrix<true>(F, rot, KIN(25) + (size_t)e * DM * DFE, DFE, DM, DFE / 32, wgu, DM, [](int cb) { return 32 * ((cb >> 2) * 8 + (cb & 3)); }, nullptr, 64.0f * 1.4426950408889634f);
                    convert_matrix<true>(F, rot, KIN(26) + (size_t)e * DM * DFE, DFE, DM, DFE / 32, wgu, DM, [](int cb) { return 32 * ((cb >> 2) * 8 + 4 + (cb & 3)); }, nullptr, 64.0f * 0.6931471805599453f);
                    convert_matrix<MOE_DN_F8>(F, rot, KIN(27) + (size_t)e * DFE * DM, DM, DFE, DM / 32, (bf16*)(ws + MOE_WD + (size_t)e * DM * DFE * (MOE_DN_F8 ? 1 : 2)), DFE, [](int cb) { return 32 * cb; }, nullptr, MOE_DN_F8 ? 256.0f : 1.0f);
                }
            }
            SEAM(pb + P_NORM2);
        }
        if (L == 0) {
            if (EN(10) && IN(pb + P_FGU)) { PHASE_BASES(); MAKE_FRAME();
            for (int rep_ = 0; rep_ < NREP(10); ++rep_) { if (rep_) __syncthreads();
                pg8::Gemm g{(const bf16*)KOUT(), (const bf16*)(ws + WS_FGU), NTOK, 2 * DFF, DM, pg8::XRP, DM, 127 - 3};   pg8::StaticOrder S; S.init(NTOK, 2 * DFF, F.G, (int)blockIdx.x);
                pg8::EpiSwiglu E{(bf16*)(ws + WS_R2), DFF, STAT(1), FFN_DN_F8 ? 1 : 0, ring};
                pg8::gemm_phase<pg8::EpiSwiglu, pg8::StaticOrder, true, false, FFN_F8 ? 1 : 2>(ring, g, S, E, F.wave);
                }
            SEAM(pb + P_FGU);
            }
            if (EN(11) && IN(pb + P_FDN)) { PHASE_BASES(); MAKE_FRAME();
                pg8::Gemm g{(const bf16*)(ws + WS_R2), (const bf16*)(ws + WS_FD), NTOK, DM, DFF, DFF, DFF, 127 - 4}; pg8::StaticOrder S; S.init(NTOK, DM, F.G, (int)blockIdx.x);
                pg8::EpiResid E{nullptr, (bf16*)KOUT(), PROJ_F8 ? (unsigned char*)(ws + WS_R3 + 64 * MiB) : nullptr, STAT(2)};
                pg8::gemm_phase<pg8::EpiResid, pg8::StaticOrder, true, false, FFN_DN_F8 ? 1 : 2>(ring, g, S, E, F.wave);
                SEAM(pb + P_FDN);
            }
        }
    }
#pragma unroll 1
    for (int ch = 0; ch < N_MOE_CHUNKS; ++ch) {
        if (EN(12) && IN(PH_MOE + 2 * ch)) { PHASE_BASES(); MAKE_FRAME();
            for (int rep_ = 0; rep_ < NREP(12); ++rep_) { if (rep_) __syncthreads();
            pg8::Gemm g{(const bf16*)(ws + MOE_X8), (const bf16*)(ws + MOE_WGU), NTOK, 2 * DFE, DM, DM, DM, 127 - 3};
            pg8::MoeOrder<true> S; S.init((const unsigned*)(ws + WS_CTL) + CW_CNT, N_MOE_CHUNKS == 1 ? -1 : ch, 2 * DFE / 256, F.G, (int)blockIdx.x, (const int*)(ws + WS_LTOK), (size_t)2 * DFE * DM, NTOK);
            pg8::EpiSwiglu E{(bf16*)(ws + MOE_ACT), DFE, nullptr, MOE_DN_F8 ? 1 : 0, ring};
            pg8::gemm_phase<pg8::EpiSwiglu, pg8::MoeOrder<true>, true, false, 1>(ring, g, S, E, F.wave);
            }
            SEAM(PH_MOE + 2 * ch);
        }
        if (EN(13) && IN(PH_MOE + 2 * ch + 1)) { PHASE_BASES(); MAKE_FRAME();
            for (int rep_ = 0; rep_ < NREP(13); ++rep_) { if (rep_) __syncthreads();
            pg8::Gemm g{(const bf16*)(ws + MOE_ACT), (const bf16*)(ws + MOE_WD), 264 * 256, DM, DFE, DFE, DFE, 127 - 4};
            pg8::MoeOrder<false> S; S.init((const unsigned*)(ws + WS_CTL) + CW_CNT, N_MOE_CHUNKS == 1 ? -1 : ch, DM / 256, F.G, (int)blockIdx.x, (const int*)(ws + WS_LTOK), (size_t)DM * DFE * (MOE_DN_F8 ? 1 : 2), NTOK, DFE * (MOE_DN_F8 ? 1 : 2) / 256, (size_t)DFE * (MOE_DN_F8 ? 1 : 2) / 2);
            pg8::EpiMoeDown E{(bf16*)(ws + MOE_Y), (const float*)(ws + WS_LW), (bf16*)(ws + MOE_Y2), ring};
            pg8::gemm_phase<pg8::EpiMoeDown, pg8::MoeOrder<false>, true, false, MOE_DN_F8 ? 1 : 2>(ring, g, S, E, F.wave);
            }
            SEAM(PH_MOE + 2 * ch + 1);
        }
    }
    if (EN(12) && IN(PH_MOE + 2 * N_MOE_CHUNKS)) { PHASE_BASES(); MAKE_FRAME();
        moe_combine(F, KOUT(), (const bf16*)(ws + MOE_Y), (const bf16*)(ws + MOE_Y2), (const int*)(ws + WS_SLOT), (const unsigned*)(ws + WS_CTL) + CW_CNT);
    }
#if defined(DIAG_WAIT) && !MK_PER_PHASE
    {
        unsigned* dg = (unsigned*)(args.ws + WS_CTL) + 128;
        if (wave0 == 0 && pg8::fresh_lane_id() == 0) atomicAdd(dg, wacc_ / 16u);
        xcd_barrier(bar, wave0 == 0 && pg8::fresh_lane_id() == 0);
        if (blockIdx.x == 0 && wave0 == 0 && pg8::fresh_lane_id() == 0) { const unsigned s = __hip_atomic_load(dg, __ATOMIC_RELAXED, __HIP_MEMORY_SCOPE_AGENT); args.out[0] += (float)(s / gridDim.x) * 16.0f * (1.0f / 1000.0f); }
    }
#endif
#if defined(EXTRA_BARRIERS) && !MK_PER_PHASE
    for (int xb_ = 0; xb_ < EXTRA_BARRIERS; ++xb_) xcd_barrier(bar, threadIdx.x == 0);
#endif
#undef IN
#undef SEAM
}

extern "C" void kernel_launch(void* const* d_in, const int* in_sizes, int n_in, void* d_out, int out_size, void* d_ws, size_t ws_size, hipStream_t stream) {
    static int grid = 0;
    if (grid == 0) {
        if (n_in != 28 || in_sizes[0] != NTOK * DM || out_size != NTOK * DM || ws_size < WS_END) { fprintf(stderr, "kernel_launch: unexpected problem (n_in %d, ws %zu < %zu)\n", n_in, ws_size, (size_t)WS_END); grid = -1; return; }
        int dev = 0, cus = 0, per_cu = 0;
        if (hipGetDevice(&dev) != hipSuccess || hipDeviceGetAttribute(&cus, hipDeviceAttributeMultiprocessorCount, dev) != hipSuccess) { grid = -1; return; }
        if (hipFuncSetAttribute((const void*)fwd_kernel, hipFuncAttributeMaxDynamicSharedMemorySize, LDS_BYTES) != hipSuccess) { fprintf(stderr, "kernel_launch: hipFuncSetAttribute failed\n"); grid = -1; return; }
        if (hipOccupancyMaxActiveBlocksPerMultiprocessor(&per_cu, (const void*)fwd_kernel, NWAVES * 64, LDS_BYTES) != hipSuccess || per_cu < 1) fprintf(stderr, "kernel_launch: occupancy query reports %d\n", per_cu);
        (void)hipGetLastError();
        grid = cus;
    }
    if (grid < 0) return;
    if (hipMemsetAsync((char*)d_ws + WS_CTL, 0, CTL_ZERO_BYTES, stream) != hipSuccess) return;
    Args a{};
    for (int i = 0; i < 28; ++i) a.in[i] = d_in[i];
    a.out = (float*)d_out; a.ws = (unsigned char*)d_ws;
#if MK_PER_PHASE
    for (int p = 0; p < N_PHASES; ++p) { a.ph_lo = p; a.ph_hi = p + 1; hipLaunchKernelGGL(fwd_kernel, dim3(grid), dim3(NWAVES * 64), LDS_BYTES, stream, a); }
#else
    a.ph_lo = 0; a.ph_hi = N_PHASES; hipLaunchKernelGGL(fwd_kernel, dim3(grid), dim3(NWAVES * 64), LDS_BYTES, stream, a);
#endif
}
```
